# Optimizing an MI355X kernel written in HIP

```python
import jax, jax.numpy as jnp
from jax import lax
import numpy as np

D_MODEL = 2048
BATCH = 4
SEQ = 2048
DEPTH = 4

GRID_W = 64
CTX_LEN = 256
N_MIXERS = 2
N_GM_LAYERS = (DEPTH + 1) // 2
N_ML_LAYERS = DEPTH // 2

GM_CHUNK = 128
GM_WIDTH = D_MODEL
GM_GROUPS = 8
GM_GROUP_W = GM_WIDTH // GM_GROUPS

ML_HEADS = 4
ML_DQK = D_MODEL // 8
ML_DV = D_MODEL // 4
ML_QK_W = ML_HEADS * ML_DQK
ML_V_W = ML_HEADS * ML_DV
ML_IN_W = 2 * ML_QK_W + 2 * ML_V_W + 4 * ML_HEADS
ML_CONV_K = 3
ML_CHUNK = 128

N_EXPERTS = 16
N_EXPERT_GROUPS = 4
EXPERTS_PER_GROUP = N_EXPERTS // N_EXPERT_GROUPS
TOP_K = 2
D_EXPERT = D_MODEL // 4

DEEPNORM_ALPHA = (2 * DEPTH) ** 0.25
DEEPNORM_BETA = (8 * DEPTH) ** -0.25
LN_EPS = 1e-5
RMS_EPS = 1e-6

kernel_name = 'hybrid_gmlp_mlstm_groupmoe_deepnorm_dit'


def _layer_norm(x, g, b):
    xf = x.astype(jnp.float32)
    mu = jnp.mean(xf, axis=-1, keepdims=True)
    var = jnp.mean(jnp.square(xf - mu), axis=-1, keepdims=True)
    y = (xf - mu) * lax.rsqrt(var + LN_EPS) * g.astype(jnp.float32) + b.astype(jnp.float32)
    return y.astype(x.dtype)


def _gmlp_mixer(h, w_in, ln_g, ln_b, w_s, b_s, w_out):
    bsz, seq, _ = h.shape
    u, v = jnp.split(jax.nn.gelu(h @ w_in), 2, axis=-1)
    v = _layer_norm(v, ln_g, ln_b).reshape(bsz, seq // GM_CHUNK, GM_CHUNK, GM_GROUPS, GM_GROUP_W)
    s = jnp.einsum('gpq,bnqgc->bnpgc', w_s, v) + b_s.T[:, :, None]
    return (u * s.reshape(bsz, seq, GM_WIDTH)) @ w_out


def _short_conv(x, w):
    pad = ML_CONV_K // 2
    return lax.conv_general_dilated(x, w[:, None, :].astype(x.dtype), window_strides=(1,),
                                    padding=[(pad, pad)], dimension_numbers=('NWC', 'WIO', 'NWC'),
                                    feature_group_count=x.shape[-1])


def _to_heads(t, n_heads):
    bsz, seq, width = t.shape
    return t.reshape(bsz, seq, n_heads, width // n_heads).transpose(0, 2, 1, 3)


def _mlstm_project(h, w_in, conv_w, gate_b):
    f32 = jnp.float32
    p = h @ w_in
    qk = jax.nn.silu(_short_conv(p[..., :2 * ML_QK_W], conv_w))
    v = p[..., 2 * ML_QK_W:2 * ML_QK_W + ML_V_W]
    o = p[..., 2 * ML_QK_W + ML_V_W:2 * ML_QK_W + 2 * ML_V_W]
    g = (p[..., 2 * ML_QK_W + 2 * ML_V_W:].astype(f32) + gate_b.astype(f32)).transpose(0, 2, 1)
    q = _to_heads(qk[..., :ML_QK_W], ML_HEADS).astype(f32)
    k = _to_heads(qk[..., ML_QK_W:], ML_HEADS).astype(f32) * (ML_DQK ** -0.5)
    v = _to_heads(v, ML_HEADS).astype(f32)
    i_fw, f_fw, i_bw, f_bw = jnp.split(g, 4, axis=1)
    gates = ((i_fw, jax.nn.log_sigmoid(f_fw)), (i_bw, jax.nn.log_sigmoid(f_bw)))
    return q, k, v, o, gates


def _mlstm_scan(q, k, v, log_i, log_f, state):
    bsz, nh, seq, _ = q.shape
    dv = v.shape[-1]
    n_chunks = seq // ML_CHUNK

    def chunks(t):
        return jnp.moveaxis(t.reshape(bsz, nh, n_chunks, ML_CHUNK, *t.shape[3:]), 2, 0)

    lower = jnp.tril(jnp.ones((ML_CHUNK, ML_CHUNK), dtype=bool))

    def step(carry, inp):
        c_mat, n_vec, m_prev = carry
        qc, kc, vc, ic, fc = inp
        b = jnp.cumsum(fc, axis=-1)
        d = jnp.where(lower, b[..., :, None] - b[..., None, :] + ic[..., None, :], -jnp.inf)
        inter = b + m_prev[..., None]
        m_t = jnp.maximum(inter, jnp.max(d, axis=-1))
        decay = jnp.exp(inter - m_t)
        s = jnp.einsum('bhtd,bhsd->bhts', qc, kc) * jnp.exp(d - m_t[..., None])
        num = decay[..., None] * jnp.einsum('bhtd,bhde->bhte', qc, c_mat) + jnp.einsum('bhts,bhse->bhte', s, vc)
        den = decay * jnp.einsum('bhtd,bhd->bht', qc, n_vec) + jnp.sum(s, axis=-1)
        h = num / jnp.maximum(jnp.abs(den), jnp.exp(-m_t))[..., None]
        b_last = b[..., -1]
        g = b_last[..., None] - b + ic
        m_new = jnp.maximum(b_last + m_prev, jnp.max(g, axis=-1))
        a = jnp.exp(b_last + m_prev - m_new)
        kw = kc * jnp.exp(g - m_new[..., None])[..., None]
        c_new = a[..., None, None] * c_mat + jnp.einsum('bhsd,bhse->bhde', kw, vc)
        n_new = a[..., None] * n_vec + jnp.sum(kw, axis=2)
        return (c_new, n_new, m_new), h

    state, h = lax.scan(step, state, (chunks(q), chunks(k), chunks(v), chunks(log_i), chunks(log_f)))
    return state, jnp.moveaxis(h, 0, 2).reshape(bsz, nh, seq, dv)


def _mlstm_output(h, o, norm_g, w_out):
    h = h * lax.rsqrt(jnp.mean(jnp.square(h), axis=-1, keepdims=True) + RMS_EPS)
    h = h * norm_g.astype(jnp.float32).reshape(ML_HEADS, 1, ML_DV)
    bsz, nh, seq, dv = h.shape
    h = h.transpose(0, 2, 1, 3).reshape(bsz, seq, nh * dv).astype(o.dtype)
    return (jax.nn.sigmoid(o) * h) @ w_out


def _mlstm_mixer(h_lat, h_ctx, w_in, conv_w, gate_b, norm_g, w_out, col_major, need_ctx):
    bsz, seq, dm = h_lat.shape
    rows = seq // GRID_W
    if col_major:
        h_lat = h_lat.reshape(bsz, rows, GRID_W, dm).transpose(0, 2, 1, 3).reshape(bsz, seq, dm)
    q_l, k_l, v_l, o_l, gates_l = _mlstm_project(h_lat, w_in, conv_w, gate_b)
    q_c, k_c, v_c, o_c, gates_c = _mlstm_project(h_ctx, w_in, conv_w, gate_b)
    zero = (jnp.zeros((bsz, ML_HEADS, ML_DQK, ML_DV), jnp.float32),
            jnp.zeros((bsz, ML_HEADS, ML_DQK), jnp.float32),
            jnp.zeros((bsz, ML_HEADS), jnp.float32))
    h_l, h_c = [], []
    for direction in range(2):
        rev = (lambda t: jnp.flip(t, axis=2)) if direction == 1 else (lambda t: t)
        (i_c, f_c), (i_l, f_l) = gates_c[direction], gates_l[direction]
        ctx_state, hc = _mlstm_scan(rev(q_c), rev(k_c), rev(v_c), rev(i_c), rev(f_c), zero)
        _, hl = _mlstm_scan(rev(q_l), rev(k_l), rev(v_l), rev(i_l), rev(f_l), ctx_state)
        h_l.append(rev(hl))
        h_c.append(rev(hc))
    y_lat = _mlstm_output(h_l[0] + h_l[1], o_l, norm_g, w_out)
    if col_major:
        y_lat = y_lat.reshape(bsz, GRID_W, rows, dm).transpose(0, 2, 1, 3).reshape(bsz, seq, dm)
    y_ctx = _mlstm_output(h_c[0] + h_c[1], o_c, norm_g, w_out) if need_ctx else None
    return y_lat, y_ctx


def _moe(h, router_w, router_b, w_gate, w_up, w_down):
    f32 = jnp.float32
    shape = h.shape
    t = h.reshape(-1, shape[-1])
    logits = (t @ router_w).astype(f32) + router_b.astype(f32)
    probs = jax.nn.softmax(logits, axis=-1)
    pg = probs.reshape(-1, N_EXPERT_GROUPS, EXPERTS_PER_GROUP)
    group_score = jnp.sum(lax.top_k(pg, TOP_K)[0], axis=-1)
    g_sel = jnp.argmax(group_score, axis=-1)
    in_group = jnp.einsum('tge,tg->te', pg, jax.nn.one_hot(g_sel, N_EXPERT_GROUPS, dtype=f32))
    top_p, top_i = lax.top_k(in_group, TOP_K)
    weights = top_p / jnp.sum(top_p, axis=-1, keepdims=True)
    expert_id = g_sel[:, None] * EXPERTS_PER_GROUP + top_i
    gate = jnp.einsum('tke,tk->te', jax.nn.one_hot(expert_id, N_EXPERTS, dtype=f32), weights).astype(h.dtype)
    a = jnp.einsum('td,edf->tef', t, w_gate)
    u = jnp.einsum('td,edf->tef', t, w_up)
    y = jnp.einsum('tef,efd->td', jax.nn.silu(a) * u * gate[:, :, None], w_down)
    return y.reshape(shape)


def setup_inputs(seed: int = 0) -> dict:
    key = jax.random.key(seed)
    ks = jax.random.split(key, 26)

    def nrm(k, shape, scale):
        return jax.random.normal(k, shape, jnp.float32) * scale

    d = D_MODEL
    f_bias = jnp.linspace(3.0, 6.0, ML_HEADS, dtype=jnp.float32)
    f_mask = jnp.array([0.0, 1.0, 0.0, 1.0], jnp.float32)[None, :, None]
    ml_gate_b = (nrm(ks[14], (N_ML_LAYERS, 4, ML_HEADS), 0.1) + f_mask * f_bias[None, None, :]).reshape(N_ML_LAYERS, 4 * ML_HEADS)
    return {
        'x': nrm(ks[0], (BATCH, SEQ, d), 1.0),
        'c': nrm(ks[1], (BATCH, d), 1.0),
        'ctx': nrm(ks[2], (BATCH, CTX_LEN, d), 1.0),
        'c_ctx': nrm(ks[3], (d,), 1.0),
        'ada_w': nrm(ks[4], (DEPTH, d, 6 * d), 0.5 * d ** -0.5),
        'ada_b': nrm(ks[5], (DEPTH, 6 * d), 0.01),
        'gm_w_in': nrm(ks[6], (N_GM_LAYERS, d, 2 * GM_WIDTH), d ** -0.5),
        'gm_ln_g': 1.0 + nrm(ks[7], (N_GM_LAYERS, GM_WIDTH), 0.02),
        'gm_ln_b': nrm(ks[8], (N_GM_LAYERS, GM_WIDTH), 0.02),
        'gm_ws': nrm(ks[9], (N_GM_LAYERS, GM_GROUPS, GM_CHUNK, GM_CHUNK), GM_CHUNK ** -0.5),
        'gm_bs': 1.0 + nrm(ks[10], (N_GM_LAYERS, GM_GROUPS, GM_CHUNK), 0.02),
        'gm_w_out': nrm(ks[11], (N_GM_LAYERS, GM_WIDTH, d), GM_WIDTH ** -0.5 * DEEPNORM_BETA),
        'ml_w_in': nrm(ks[12], (N_ML_LAYERS, d, ML_IN_W), d ** -0.5),
        'ml_conv': nrm(ks[13], (N_ML_LAYERS, ML_CONV_K, 2 * ML_QK_W), ML_CONV_K ** -0.5),
        'ml_gate_b': ml_gate_b,
        'ml_norm_g': 1.0 + nrm(ks[15], (N_ML_LAYERS, ML_V_W), 0.02),
        'ml_w_out': nrm(ks[16], (N_ML_LAYERS, ML_V_W, d), ML_V_W ** -0.5 * DEEPNORM_BETA),
        'ln1_g': 1.0 + nrm(ks[17], (DEPTH, d), 0.02),
        'ln1_b': nrm(ks[18], (DEPTH, d), 0.02),
        'ln2_g': 1.0 + nrm(ks[19], (DEPTH, d), 0.02),
        'ln2_b': nrm(ks[20], (DEPTH, d), 0.02),
        'router_w': nrm(ks[21], (d, N_EXPERTS), d ** -0.5),
        'router_b': nrm(ks[22], (N_EXPERTS,), 0.01),
        'ex_w_gate': nrm(ks[23], (DEPTH, N_EXPERTS, d, D_EXPERT), d ** -0.5),
        'ex_w_up': nrm(ks[24], (DEPTH, N_EXPERTS, d, D_EXPERT), d ** -0.5),
        'ex_w_down': nrm(ks[25], (DEPTH, N_EXPERTS, D_EXPERT, d), D_EXPERT ** -0.5 * DEEPNORM_BETA),
    }


def reference(x, c, ctx, c_ctx, ada_w, ada_b, gm_w_in, gm_ln_g, gm_ln_b, gm_ws, gm_bs, gm_w_out,
              ml_w_in, ml_conv, ml_gate_b, ml_norm_g, ml_w_out, ln1_g, ln1_b, ln2_g, ln2_b,
              router_w, router_b, ex_w_gate, ex_w_up, ex_w_down):
    cond_lat = jax.nn.silu(c)
    cond_ctx = jax.nn.silu(c_ctx)[None, :]
    for layer in range(DEPTH):
        last = layer == DEPTH - 1
        kind = layer % N_MIXERS
        idx = layer // N_MIXERS
        mod_l = (cond_lat @ ada_w[layer] + ada_b[layer])[:, None, :]
        mod_c = (cond_ctx @ ada_w[layer] + ada_b[layer])[:, None, :]
        sh1, sc1, g1, sh2, sc2, g2 = jnp.split(mod_l, 6, axis=-1)
        sh1c, sc1c, g1c, sh2c, sc2c, g2c = jnp.split(mod_c, 6, axis=-1)
        h_lat = x * (1.0 + sc1) + sh1
        if kind == 0:
            gm = (gm_w_in[idx], gm_ln_g[idx], gm_ln_b[idx], gm_ws[idx], gm_bs[idx], gm_w_out[idx])
            y_lat = _gmlp_mixer(h_lat, *gm)
            y_ctx = None if last else _gmlp_mixer(ctx * (1.0 + sc1c) + sh1c, *gm)
        else:
            y_lat, y_ctx = _mlstm_mixer(h_lat, ctx * (1.0 + sc1c) + sh1c, ml_w_in[idx], ml_conv[idx],
                                        ml_gate_b[idx], ml_norm_g[idx], ml_w_out[idx],
                                        col_major=(idx % 2 == 1), need_ctx=not last)
        moe_w = (router_w, router_b, ex_w_gate[layer], ex_w_up[layer], ex_w_down[layer])
        x = _layer_norm(DEEPNORM_ALPHA * x + g1 * y_lat, ln1_g[layer], ln1_b[layer])
        x = _layer_norm(DEEPNORM_ALPHA * x + g2 * _moe(x * (1.0 + sc2) + sh2, *moe_w), ln2_g[layer], ln2_b[layer])
        if not last:
            ctx = _layer_norm(DEEPNORM_ALPHA * ctx + g1c * y_ctx, ln1_g[layer], ln1_b[layer])
            ctx = _layer_norm(DEEPNORM_ALPHA * ctx + g2c * _moe(ctx * (1.0 + sc2c) + sh2c, *moe_w), ln2_g[layer], ln2_b[layer])
    return x
```

```cpp
#include <hip/hip_runtime.h>
#include <cstdio>
#include <cstdint>

#ifndef ONLY
#define ONLY -1
#endif
#define PHON(x) (ONLY < 0 || ONLY == (x))
#ifndef MK_ONE_LAUNCH
#define MK_ONE_LAUNCH 1
#endif

#define GAS __attribute__((address_space(1)))
#define LAS __attribute__((address_space(3)))
typedef unsigned short bf16;
typedef float f32x4 __attribute__((ext_vector_type(4)));
struct __attribute__((packed, aligned(4))) f32x3 { float x, y, z; };
typedef float f32x2 __attribute__((ext_vector_type(2)));
typedef short bf16x8 __attribute__((ext_vector_type(8)));
typedef unsigned u32x4 __attribute__((ext_vector_type(4)));
typedef unsigned u32x2 __attribute__((ext_vector_type(2)));

constexpr int D = 2048, NLAT = 8192, NCTX = 1024, NTOK = NLAT + NCTX, DEPTH = 4;
constexpr int LCAP = 9216;
constexpr float ALPHA = 1.681792830507429f;
constexpr float LN_EPS = 1e-5f, RMS_EPS = 1e-6f;
constexpr int MLIN = 6160;
constexpr int NWAVES = 8;

__device__ __forceinline__ unsigned f2bf(float f) { unsigned u = __builtin_bit_cast(unsigned, f); return (u + 0x7fffu + ((u >> 16) & 1u)) >> 16; }
__device__ __forceinline__ unsigned pk2(float lo, float hi) { unsigned r; asm volatile("v_cvt_pk_bf16_f32 %0, %1, %2" : "=v"(r) : "v"(lo), "v"(hi)); return r; }
__device__ __forceinline__ float bf2f(unsigned short b) { return __builtin_bit_cast(float, ((unsigned)b) << 16); }
__device__ __forceinline__ float bflo(unsigned w) { return __builtin_bit_cast(float, w << 16); }
__device__ __forceinline__ float bfhi(unsigned w) { return __builtin_bit_cast(float, w & 0xffff0000u); }
__device__ __forceinline__ float sigm(float x) { return __builtin_amdgcn_rcpf(1.f + __expf(-x)); }
__device__ __forceinline__ float siluf(float x) { return x * sigm(x); }
__device__ __forceinline__ float gelu_tanh(float x) { return x * sigm(1.5957691216057308f * (x + 0.044715f * x * x * x)); }
__device__ __forceinline__ float wave_sum(float v) {
#pragma unroll
    for (int o = 1; o < 64; o <<= 1) v += __shfl_xor(v, o);
    return v;
}
__device__ __forceinline__ int permrow(int r) {
    if (r >= NLAT) return r; const int b = r & ~2047, s = r & 2047; return b + ((s & 63) << 5) + (s >> 6);
}
__device__ __forceinline__ int invpermrow(int r) {
    if (r >= NLAT) return r; const int b = r & ~2047, p = r & 2047; return b + ((p & 31) << 6) + (p >> 5);
}
__device__ __forceinline__ LAS unsigned char* vopq(LAS unsigned char* p) { asm volatile("" : "+v"(p)); return p; }
__device__ __forceinline__ int vopqi(int v) { asm volatile("" : "+v"(v)); return v; }
__device__ __forceinline__ int sopqi(int v) { asm volatile("" : "+s"(v)); return v; }
__device__ __forceinline__ int lane_id() { int l; asm volatile("v_mbcnt_lo_u32_b32 %0, -1, 0\n\tv_mbcnt_hi_u32_b32 %0, -1, %0" : "=v"(l)); return l; }
#define VM_WAIT() asm volatile("s_waitcnt vmcnt(0)" ::: "memory")
#define LDS_WAIT() asm volatile("s_waitcnt lgkmcnt(0)" ::: "memory")

namespace pg8 {
#define PG8_LAS __attribute__((address_space(3)))
constexpr int BM = 256, BK = 64, HALF = 128, HTB = HALF * BK * 2, STAGE_BYTES = 8 * HTB, NXCD = 8, WGM = 8;
__host__ __device__ __forceinline__ int lds_byte(int r, int c) { const int st = (r >> 4) * 2 + (c >> 5), rr = r & 15, cc = c & 31, ob = rr * 64 + cc * 2; return st * 1024 + (ob ^ (((ob >> 9) & 1) << 5)); }
__host__ __device__ __forceinline__ void stage_rc(int b, int& R, int& C) { const int st = b / 1024, sb = b % 1024, swz = sb ^ (((sb >> 9) & 1) << 5); R = (st >> 1) * 16 + swz / 64; C = (st & 1) * 32 + (swz % 64) / 2; }
__host__ __device__ __forceinline__ int perm32(int rho) { const int n = rho >> 4, i = rho & 15; return 8 * (i >> 2) + 4 * n + (i & 3); }

struct Unit { int pm, pn, e, rt, nv; };
struct Gemm { const bf16* A; const bf16* Bt; int K; size_t estride; const int* lst; };

struct StaticOrder {
    int nM, nN, nwg, G, c;
    __device__ void init(int M, int N, int G_, int c_) { nM = M / BM; nN = N / BM; nwg = nM * nN; G = G_; c = c_; }
    __device__ bool next(int i, Unit& u) const {
        const long L = (long)i * G + c; if (L >= nwg) return false;
        int wgid = (int)L; { const int q = nwg / NXCD, r = nwg % NXCD, xcd = wgid % NXCD, off = wgid / NXCD; wgid = (xcd < r ? xcd * (q + 1) : r * (q + 1) + (xcd - r) * q) + off; }
        const int nig = WGM * nN, gid = wgid / nig, fm = gid * WGM, gsz = (nM - fm) < WGM ? (nM - fm) : WGM;
        u.pm = fm + ((wgid % nig) % gsz); u.pn = (wgid % nig) / gsz; u.e = 0; u.rt = 0; u.nv = 256; return true;
    }
};
struct MoeOrder {
    const unsigned* cnt; int ncol, G, c;
    __device__ bool next(int i, Unit& u) const {
        int L = i * G + c, tile0 = 0; bool found = false;
#pragma unroll
        for (int e = 0; e < 16; ++e) {
            const int n = (int)__builtin_amdgcn_readfirstlane(__hip_atomic_load(cnt + e, __ATOMIC_RELAXED, __HIP_MEMORY_SCOPE_AGENT));
            const int rte = (n + 255) >> 8, nu = rte * ncol;
            if (!found) { if (L < nu) { found = true; const int rt = L % rte; u.e = e; u.rt = rt; u.pn = L / rte; u.pm = tile0 + rt; u.nv = (n - rt * 256) < 256 ? (n - rt * 256) : 256; } else { L -= nu; tile0 += rte; } }
        }
        return found;
    }
};
template <int AMODE> __device__ __forceinline__ void a_off(const Gemm& g, const Unit& u, int R0, int C0, int R1, int C1, unsigned (&h0)[2], unsigned (&h1)[2]) {
    const int K = g.K;
    if constexpr (AMODE == 0) {
        h0[0] = (unsigned)(R0 * K + C0) * 2u; h0[1] = (unsigned)(R1 * K + C1) * 2u;
        h1[0] = (unsigned)((R0 + HALF) * K + C0) * 2u; h1[1] = (unsigned)((R1 + HALF) * K + C1) * 2u;
    } else {
        const int* l = g.lst + u.e * LCAP + u.rt * 256;
        const int t00 = R0 < u.nv ? (l[R0] >> 1) : 0, t01 = R1 < u.nv ? (l[R1] >> 1) : 0;
        const int t10 = (R0 + HALF) < u.nv ? (l[R0 + HALF] >> 1) : 0, t11 = (R1 + HALF) < u.nv ? (l[R1 + HALF] >> 1) : 0;
        h0[0] = (unsigned)(t00 * K + C0) * 2u; h0[1] = (unsigned)(t01 * K + C1) * 2u;
        h1[0] = (unsigned)(t10 * K + C0) * 2u; h1[1] = (unsigned)(t11 * K + C1) * 2u;
    }
}

template <class Epi, class Sched, int AMODE>
__device__ __forceinline__ void gemm_phase(PG8_LAS unsigned char* lds, const Gemm g, const Sched& S, const Epi& E, int wave_id) {
    const int wid = sopqi(wave_id), lane = vopqi(lane_id()), tid = wid * 64 + lane, wr = wid >> 2, wc = wid & 3, fr = lane & 15, fq = lane >> 4;
    const int K = g.K, nt = K / BK;
    int R0, C0, R1, C1; stage_rc(tid * 16, R0, C0); stage_rc(tid * 16 + 8192, R1, C1);
    unsigned voffB[2];
    { const int Rb0 = Epi::PERM ? ((R0 & ~31) + perm32(R0 & 31)) : R0, Rb1 = Epi::PERM ? ((R1 & ~31) + perm32(R1 & 31)) : R1;
      voffB[0] = (unsigned)(Rb0 * K + C0) * 2u; voffB[1] = (unsigned)(Rb1 * K + C1) * 2u; }
    const size_t kstep = (size_t)(BK * 2);
    const size_t hstep = (size_t)HALF * K * 2;
    const size_t tstep = 2 * hstep;
    const unsigned ldsw = (unsigned)wid * 1024u;
    const int aoff = lds_byte(wr * 64 + fr, fq * 8), boff = lds_byte(wc * 32 + fr, fq * 8);
#define PG8_SA(b, h) (((b) * 2 + (h)) * HTB)
#define PG8_SB(b, h) ((4 + (b) * 2 + (h)) * HTB)
#define PG8_STAGE(bufoff, gbase, voff) do { _Pragma("unroll") for (int _i = 0; _i < 2; ++_i) \
        __builtin_amdgcn_global_load_lds((const unsigned*)((const char*)(gbase) + (voff)[_i]), (PG8_LAS unsigned*)(lds + (bufoff) + ldsw + _i * 8192), 16, 0, 0); } while (0)
#define PG8_LDA(dst, b, h) do { _Pragma("unroll") for (int m = 0; m < 4; ++m) _Pragma("unroll") for (int k = 0; k < 2; ++k) dst[m][k] = *(const PG8_LAS bf16x8*)(lds + PG8_SA(b, h) + aoff + m * 2048 + k * 1024); } while (0)
#define PG8_LDB(dst, b, h) do { _Pragma("unroll") for (int n = 0; n < 2; ++n) _Pragma("unroll") for (int k = 0; k < 2; ++k) dst[n][k] = *(const PG8_LAS bf16x8*)(lds + PG8_SB(b, h) + boff + n * 2048 + k * 1024); } while (0)
#define PG8_MMA(ai, bj, At, Bt) do { __builtin_amdgcn_s_setprio(1); _Pragma("unroll") for (int m = 0; m < 4; ++m) _Pragma("unroll") for (int n = 0; n < 2; ++n) _Pragma("unroll") for (int k = 0; k < 2; ++k) \
        acc[ai][bj][m][n] = __builtin_amdgcn_mfma_f32_16x16x32_bf16(Bt[n][k], At[m][k], acc[ai][bj][m][n], 0, 0, 0); __builtin_amdgcn_s_setprio(0); } while (0)
#define PG8_WAIT_V(n) asm volatile("s_waitcnt vmcnt(" #n ")" ::: "memory")
#define PG8_WAIT_L(n) asm volatile("s_waitcnt lgkmcnt(" #n ")" ::: "memory")
#define PG8_BAR __builtin_amdgcn_s_barrier()
#define PG8_SCHED __builtin_amdgcn_sched_barrier(0)
    Unit cur, nxt; int ui = 0;
    if (!S.next(0, cur)) return;
    f32x4 acc[2][2][4][2];
#pragma unroll
    for (int a = 0; a < 2; ++a)
#pragma unroll
        for (int b = 0; b < 2; ++b)
#pragma unroll
            for (int m = 0; m < 4; ++m)
#pragma unroll
                for (int n = 0; n < 2; ++n) acc[a][b][m][n] = (f32x4){0.f, 0.f, 0.f, 0.f};
    bf16x8 At[4][2], B0[2][2], B1[2][2];
    unsigned vh0[2], vh1[2], nh0[2], nh1[2];
    a_off<AMODE>(g, cur, R0, C0, R1, C1, vh0, vh1);
    const char* cA = AMODE ? (const char*)g.A : (const char*)g.A + (size_t)cur.pm * tstep;
    const char* cB = (const char*)g.Bt + (size_t)cur.e * g.estride + (size_t)cur.pn * tstep;
    PG8_STAGE(PG8_SB(0, 0), cB, voffB); PG8_STAGE(PG8_SB(0, 1), cB + hstep, voffB); PG8_STAGE(PG8_SA(0, 0), cA, vh0); PG8_STAGE(PG8_SA(0, 1), cA, vh1);
    if (wr == 1) PG8_BAR;
    PG8_WAIT_V(2); PG8_BAR;
    PG8_STAGE(PG8_SB(1, 0), cB + kstep, voffB); PG8_STAGE(PG8_SA(1, 0), cA + kstep, vh0); PG8_STAGE(PG8_SB(1, 1), cB + hstep + kstep, voffB);
    PG8_WAIT_V(6); PG8_BAR;
    for (;;) {
        const bool has_next = S.next(ui + 1, nxt);
        const char* nA = cA; const char* nB = cB;
        nh0[0] = vh0[0]; nh0[1] = vh0[1]; nh1[0] = vh1[0]; nh1[1] = vh1[1];
        if (has_next) {
            nA = AMODE ? (const char*)g.A : (const char*)g.A + (size_t)nxt.pm * tstep;
            nB = (const char*)g.Bt + (size_t)nxt.e * g.estride + (size_t)nxt.pn * tstep;
            if constexpr (AMODE != 0) a_off<AMODE>(g, nxt, R0, C0, R1, C1, nh0, nh1);
        }
        for (int t = 0; t < nt; t += 2) {
            const bool last = (t == nt - 2);
            const char* a1 = cA + (size_t)(t + 1) * kstep;
            const char* a2 = last ? nA : cA + (size_t)(t + 2) * kstep; const char* b2 = last ? nB : cB + (size_t)(t + 2) * kstep;
            const char* a3 = a2 + kstep; const char* b3 = b2 + kstep;
            unsigned w0[2], w1[2];
            if constexpr (AMODE != 0) { w0[0] = last ? nh0[0] : vh0[0]; w0[1] = last ? nh0[1] : vh0[1]; w1[0] = last ? nh1[0] : vh1[0]; w1[1] = last ? nh1[1] : vh1[1]; }
            else { w0[0] = vh0[0]; w0[1] = vh0[1]; w1[0] = vh1[0]; w1[1] = vh1[1]; }
            PG8_LDB(B0, 0, 0); PG8_LDB(B1, 0, 1); PG8_SCHED; PG8_LDA(At, 0, 0); PG8_STAGE(PG8_SA(1, 1), a1, vh1);
            PG8_WAIT_V(8); PG8_WAIT_L(0); PG8_BAR; PG8_MMA(0, 0, At, B0); PG8_MMA(0, 1, At, B1); PG8_BAR; PG8_SCHED;
            PG8_LDA(At, 0, 1); PG8_STAGE(PG8_SB(0, 0), b2, voffB); PG8_STAGE(PG8_SB(0, 1), b2 + hstep, voffB); PG8_STAGE(PG8_SA(0, 0), a2, w0);
            PG8_WAIT_V(8); PG8_WAIT_L(0); PG8_BAR; PG8_MMA(1, 0, At, B0); PG8_MMA(1, 1, At, B1); PG8_BAR; PG8_SCHED;
            PG8_LDB(B0, 1, 0); PG8_LDB(B1, 1, 1); PG8_SCHED; PG8_LDA(At, 1, 0); PG8_STAGE(PG8_SA(0, 1), a2, w1);
            PG8_WAIT_V(8); PG8_WAIT_L(0); PG8_BAR; PG8_MMA(0, 0, At, B0); PG8_MMA(0, 1, At, B1); PG8_BAR; PG8_SCHED;
            PG8_LDA(At, 1, 1); PG8_STAGE(PG8_SB(1, 0), b3, voffB); PG8_STAGE(PG8_SB(1, 1), b3 + hstep, voffB); PG8_STAGE(PG8_SA(1, 0), a3, w0);
            PG8_WAIT_V(8); PG8_WAIT_L(0); PG8_BAR; PG8_MMA(1, 0, At, B0); PG8_MMA(1, 1, At, B1); PG8_BAR; PG8_SCHED;
        }
        if (wr == 0) PG8_BAR;
        E(acc, cur, wr, wc, fr, fq);
        if (!has_next) break;
#pragma unroll
        for (int a = 0; a < 2; ++a)
#pragma unroll
            for (int b = 0; b < 2; ++b)
#pragma unroll
                for (int m = 0; m < 4; ++m)
#pragma unroll
                    for (int n = 0; n < 2; ++n) acc[a][b][m][n] = (f32x4){0.f, 0.f, 0.f, 0.f};
        cur = nxt; cA = nA; cB = nB; ++ui;
        vh0[0] = nh0[0]; vh0[1] = nh0[1]; vh1[0] = nh1[0]; vh1[1] = nh1[1];
        if (wr == 1) PG8_BAR;
    }
    PG8_WAIT_V(0);
    PG8_BAR;
#undef PG8_SA
#undef PG8_SB
#undef PG8_STAGE
#undef PG8_LDA
#undef PG8_LDB
#undef PG8_MMA
#undef PG8_WAIT_V
#undef PG8_WAIT_L
#undef PG8_BAR
#undef PG8_SCHED
}
}
using pg8::Unit;

constexpr size_t MiB = 1u << 20;
constexpr size_t WS_CTL = 0, CTL_ZERO_BYTES = 1 * MiB;
constexpr size_t WS_MOD = 1 * MiB;
constexpr size_t WS_VST = 2 * MiB;
constexpr size_t WS_G = 5 * MiB;
constexpr size_t WS_TOKL = 6 * MiB;
constexpr size_t WS_WL = 7 * MiB;
constexpr size_t WS_WSB = 8 * MiB;
constexpr size_t WS_WGIN = 16 * MiB;
constexpr size_t WS_WGOUT = 48 * MiB;
constexpr size_t WS_WMIN = 64 * MiB;
constexpr size_t WS_WMOUT = 112 * MiB;
constexpr size_t WS_WEGU = 128 * MiB;
constexpr size_t WS_WED = 384 * MiB;
constexpr size_t WS_X = 512 * MiB;
constexpr size_t WS_HT = 584 * MiB;
constexpr size_t WS_A1 = 620 * MiB;
constexpr size_t WS_A2 = 656 * MiB;
constexpr size_t WS_A3 = 692 * MiB;
constexpr size_t WS_A4 = 728 * MiB;
constexpr size_t WS_HSF = 764 * MiB;
constexpr size_t WS_HSB = 800 * MiB;
constexpr size_t WS_ZL = 836 * MiB;
constexpr size_t WS_HM = 872 * MiB;
constexpr size_t WS_YM = 894 * MiB;
constexpr size_t WS_END = 966 * MiB;
constexpr int CW_BAR = 4096;
constexpr int CW_CNT = 16384;

struct EpiGA {
    static constexpr bool PERM = true;
    bf16* U; bf16* V; float* vst;
    __device__ __forceinline__ void operator()(const f32x4 (&acc)[2][2][4][2], const Unit& u, int wr, int wc, int fr, int fq) const {
        const bool isv = u.pn >= 8; bf16* base = isv ? V : U;
        const int col0 = (u.pn & 7) * 256 + wc * 32 + 8 * fq, row0 = u.pm * 256 + wr * 64 + fr;
#pragma unroll
        for (int ai = 0; ai < 2; ++ai)
#pragma unroll
            for (int m = 0; m < 4; ++m) {
                const int row = row0 + ai * 128 + m * 16; float s = 0.f, q = 0.f; bf16* rp = base + (size_t)row * D + col0;
#pragma unroll
                for (int bj = 0; bj < 2; ++bj) {
                    f32x4 a = acc[ai][bj][m][0], b = acc[ai][bj][m][1];
#pragma unroll
                    for (int j = 0; j < 4; ++j) { a[j] = gelu_tanh(a[j]); b[j] = gelu_tanh(b[j]); s += a[j] + b[j]; q += a[j] * a[j] + b[j] * b[j]; }
                    u32x4 w; w.x = pk2(a[0], a[1]); w.y = pk2(a[2], a[3]); w.z = pk2(b[0], b[1]); w.w = pk2(b[2], b[3]);
                    *(u32x4*)(rp + bj * 128) = w;
                }
                if (isv) { s += __shfl_xor(s, 16); s += __shfl_xor(s, 32); q += __shfl_xor(q, 16); q += __shfl_xor(q, 32);
                    if (fq == 0) *(f32x2*)(vst + ((size_t)row * 32 + (u.pn - 8) * 4 + wc) * 2) = (f32x2){s, q}; }
            }
    }
};
struct EpiLA {
    static constexpr bool PERM = true;
    unsigned char* ws; int perm;
    __device__ __forceinline__ void operator()(const f32x4 (&acc)[2][2][4][2], const Unit& u, int wr, int wc, int fr, int fq) const {
        const int seg = u.pn >> 3; bf16* base = (bf16*)(ws + WS_A1 + (size_t)seg * (WS_A3 - WS_A1) - (seg == 2 ? (WS_A3 - WS_A1) - (WS_A4 - WS_A3) : 0));
        const int col0 = (u.pn & 7) * 256 + wc * 32 + 8 * fq, row0 = u.pm * 256 + wr * 64 + fr;
#pragma unroll
        for (int ai = 0; ai < 2; ++ai)
#pragma unroll
            for (int m = 0; m < 4; ++m) {
                const int row = row0 + ai * 128 + m * 16, drow = perm ? permrow(row) : row; bf16* rp = base + (size_t)drow * D + col0;
#pragma unroll
                for (int bj = 0; bj < 2; ++bj) {
                    f32x4 a = acc[ai][bj][m][0], b = acc[ai][bj][m][1];
                    if (seg == 2) {
#pragma unroll
                        for (int j = 0; j < 4; ++j) { a[j] = sigm(a[j]); b[j] = sigm(b[j]); } }
                    u32x4 w; w.x = pk2(a[0], a[1]); w.y = pk2(a[2], a[3]); w.z = pk2(b[0], b[1]); w.w = pk2(b[2], b[3]);
                    *(u32x4*)(rp + bj * 128) = w;
                }
            }
    }
};
struct EpiRes {
    static constexpr bool PERM = false;
    const float* xlat; const float* xctx; float* X; const float* g1base; int unperm;
    __device__ __forceinline__ void operator()(const f32x4 (&acc)[2][2][4][2], const Unit& u, int wr, int wc, int fr, int fq) const {
        const int mi = u.pm < 32 ? (u.pm >> 3) : 4; const float* g1 = g1base + (size_t)mi * 12288;
        const int col0 = u.pn * 256 + wc * 32 + 4 * fq, row0 = u.pm * 256 + wr * 64 + fr;
        f32x4 gv[2][2];
#pragma unroll
        for (int bj = 0; bj < 2; ++bj)
#pragma unroll
            for (int n = 0; n < 2; ++n) gv[bj][n] = *(const f32x4*)(g1 + col0 + bj * 128 + n * 16);
#pragma unroll
        for (int ai = 0; ai < 2; ++ai)
#pragma unroll
            for (int m = 0; m < 4; ++m) {
                const int row = row0 + ai * 128 + m * 16, r2 = unperm ? invpermrow(row) : row;
                const float* ip = (r2 < NLAT ? xlat + (size_t)r2 * D : xctx + (size_t)(r2 - NLAT) * D) + col0; float* op = X + (size_t)r2 * D + col0;
#pragma unroll
                for (int bj = 0; bj < 2; ++bj)
#pragma unroll
                    for (int n = 0; n < 2; ++n) { const f32x4 xin = *(const f32x4*)(ip + bj * 128 + n * 16); *(f32x4*)(op + bj * 128 + n * 16) = xin * ALPHA + gv[bj][n] * acc[ai][bj][m][n]; }
            }
    }
};
struct EpiMoE1 {
    static constexpr bool PERM = true;
    bf16* Hm; const float* wl;
    __device__ __forceinline__ void operator()(const f32x4 (&acc)[2][2][4][2], const Unit& u, int wr, int wc, int fr, int fq) const {
        const int col0 = u.pn * 128 + wc * 32 + 8 * fq; const float* wp = wl + u.e * LCAP + u.rt * 256;
#pragma unroll
        for (int ai = 0; ai < 2; ++ai)
#pragma unroll
            for (int m = 0; m < 4; ++m) {
                const int rl = ai * 128 + wr * 64 + m * 16 + fr;
                if (rl < u.nv) {
                    const float w = wp[rl]; f32x4 g0 = acc[ai][0][m][0], g1 = acc[ai][0][m][1]; const f32x4 u0 = acc[ai][1][m][0], u1 = acc[ai][1][m][1];
#pragma unroll
                    for (int j = 0; j < 4; ++j) { g0[j] = siluf(g0[j]) * u0[j] * w; g1[j] = siluf(g1[j]) * u1[j] * w; }
                    u32x4 o; o.x = pk2(g0[0], g0[1]); o.y = pk2(g0[2], g0[3]); o.z = pk2(g1[0], g1[1]); o.w = pk2(g1[2], g1[3]);
                    *(u32x4*)(Hm + (size_t)(u.pm * 256 + rl) * 512 + col0) = o;
                }
            }
    }
};
struct EpiMoE2 {
    static constexpr bool PERM = true;
    bf16* YM; const int* lst;
    __device__ __forceinline__ void operator()(const f32x4 (&acc)[2][2][4][2], const Unit& u, int wr, int wc, int fr, int fq) const {
        const int col0 = u.pn * 256 + wc * 32 + 8 * fq; const int* lp = lst + u.e * LCAP + u.rt * 256;
#pragma unroll
        for (int ai = 0; ai < 2; ++ai)
#pragma unroll
            for (int m = 0; m < 4; ++m) {
                const int rl = ai * 128 + wr * 64 + m * 16 + fr;
                if (rl < u.nv) {
                    const int tk = lp[rl]; bf16* rp = YM + (size_t)tk * D + col0;
#pragma unroll
                    for (int bj = 0; bj < 2; ++bj) { const f32x4 a = acc[ai][bj][m][0], b = acc[ai][bj][m][1];
                        u32x4 o; o.x = pk2(a[0], a[1]); o.y = pk2(a[2], a[3]); o.z = pk2(b[0], b[1]); o.w = pk2(b[2], b[3]);
                        *(u32x4*)(rp + bj * 128) = o; }
                }
            }
    }
};

constexpr int LDS_BYTES = 155648, MISC_OFF = LDS_BYTES - 512, PTAB_OFF = LDS_BYTES - 256;

#define XB_TMO      128
#define XB_XCNT(j)  (256  + 64 * (j))
#define XB_XSUB(j)  (1280 + 64 * (j))
#define XB_XGEN(j)  (2304 + 64 * (j))
#define XB_TOP      3328
#define XB_TOPGEN   3392
#define XCD_BAR_WORDS 3456
#define XB_SPIN_CAP (1u << 18)
__device__ __forceinline__ unsigned xb_ld(unsigned* p)              { return __hip_atomic_load(p, __ATOMIC_RELAXED, __HIP_MEMORY_SCOPE_AGENT); }
__device__ __forceinline__ unsigned xb_add(unsigned* p, unsigned v) { return __hip_atomic_fetch_add(p, v, __ATOMIC_RELAXED, __HIP_MEMORY_SCOPE_AGENT); }
__device__ __forceinline__ unsigned xb_xcc_id() { return (unsigned)__builtin_amdgcn_s_getreg((3 << 11) | 20) & 0xFu; }
#define XB_SPIN(cond, bar) do { unsigned _sp = 0; while (cond) { __builtin_amdgcn_s_sleep(1); \
    if ((++_sp & 255u) == 0u) { if (xb_ld(&(bar)[XB_TMO])) break; if (_sp > XB_SPIN_CAP) { atomicAdd(&(bar)[XB_TMO], 1u); break; } } } } while (0)
struct XcdBarrier { unsigned* bar; unsigned x; volatile LAS unsigned* st; };
__device__ __forceinline__ XcdBarrier xcd_barrier_post(unsigned* bar, volatile LAS unsigned* st, bool t0) {
    XcdBarrier b; b.bar = bar; b.x = xb_xcc_id(); b.st = st;
    if (t0) (void)xb_add(&bar[XB_XCNT(b.x)], 1u);
    return b;
}
__device__ __forceinline__ void xcd_barrier_complete(unsigned* bar, unsigned x, unsigned& nloc, unsigned& nx) {
    const unsigned G = gridDim.x * gridDim.y * gridDim.z;
    unsigned sum, cnt, mine, sp = 0u;
    for (;;) {
        sum = 0u; cnt = 0u; mine = 0u;
#pragma unroll
        for (unsigned j = 0; j < 16; ++j) { const unsigned c = xb_ld(&bar[XB_XCNT(j)]); sum += c; cnt += (c > 0u) ? 1u : 0u; mine = (j == x) ? c : mine; }
        if (sum == G) break;
        __builtin_amdgcn_s_sleep(1);
        if ((++sp & 255u) == 0u) { if (xb_ld(&bar[XB_TMO])) break; if (sp > XB_SPIN_CAP) { atomicAdd(&bar[XB_TMO], 1u); break; } }
    }
    nloc = mine > 0u ? mine : 1u; nx = cnt > 0u ? cnt : 1u;
}
__device__ __forceinline__ void xcd_barrier(const XcdBarrier& b, bool t0) {
    asm volatile("s_waitcnt vmcnt(0)" ::: "memory");
    __syncthreads();
    if (t0) {
        unsigned* bar = b.bar;
        __builtin_amdgcn_s_waitcnt(0);
        unsigned nloc = b.st[0], nx = b.st[1];
        if (nloc == 0u) { xcd_barrier_complete(bar, b.x, nloc, nx); b.st[0] = nloc; b.st[1] = nx; }
        const unsigned old = xb_add(&bar[XB_XSUB(b.x)], 1u);
        const unsigned gen = old / nloc;
        if (old + 1u == (gen + 1u) * nloc) {
            __builtin_amdgcn_fence(__ATOMIC_RELEASE, "agent");
            asm volatile("s_waitcnt vmcnt(0)" ::: "memory");
            const unsigned og = xb_add(&bar[XB_TOP], 1u);
            const unsigned tg = og / nx;
            if (og + 1u == (tg + 1u) * nx) xb_add(&bar[XB_TOPGEN], 1u);
            else XB_SPIN(xb_ld(&bar[XB_TOPGEN]) == tg, bar);
            __builtin_amdgcn_fence(__ATOMIC_ACQUIRE, "agent");
            xb_add(&bar[XB_XGEN(b.x)], 1u);
            asm volatile("s_waitcnt vmcnt(0)" ::: "memory");
        } else {
            XB_SPIN(xb_ld(&bar[XB_XGEN(b.x)]) == gen, bar);
            __builtin_amdgcn_fence(__ATOMIC_ACQUIRE, "agent");
            asm volatile("s_waitcnt vmcnt(0)" ::: "memory");
        }
    }
    __syncthreads();
}

struct Args { const float* in[26]; float* out; unsigned char* ws; int ph_lo, ph_hi; };
struct Frame {
    LAS unsigned char* lds; int tid, lane, wave, G, bid;
    unsigned char* ws; float* out;
};
__device__ __forceinline__ const float* inp(const Frame& F, int i) {
    const LAS unsigned* t = (const LAS unsigned*)(F.lds + PTAB_OFF) + 2 * i;
    const unsigned lo = (unsigned)__builtin_amdgcn_readfirstlane((int)t[0]), hi = (unsigned)__builtin_amdgcn_readfirstlane((int)t[1]);
    return (const float*)(const GAS float*)(((unsigned long long)hi << 32) | lo);
}
__device__ __forceinline__ unsigned char* opq(unsigned char* p) { GAS unsigned char* g = (GAS unsigned char*)p; asm volatile("" : "+s"(g)); return (unsigned char*)g; }

enum { I_X = 0, I_C, I_CTX, I_CCTX, I_ADAW, I_ADAB, I_GMWIN, I_GMLNG, I_GMLNB, I_GMWS, I_GMBS, I_GMWOUT, I_MLWIN, I_MLCONV, I_MLGB, I_MLNG, I_MLWOUT,
       I_LN1G, I_LN1B, I_LN2G, I_LN2B, I_RW, I_RB, I_EXG, I_EXU, I_EXD };

__device__ __forceinline__ void p0_transpose_item(const float* W, int ldw, int Kout, bf16* WT, int out_row0, LAS float* scr, int k0, int n0, int lane) {
#pragma unroll 8
    for (int i = 0; i < 32; ++i) { const int kk = 2 * i + (lane >> 5); scr[kk * 33 + (lane & 31)] = W[(size_t)(k0 + kk) * ldw + n0 + (lane & 31)]; }
    LDS_WAIT(); asm volatile("" ::: "memory");
    const int c = lane & 7;
#pragma unroll
    for (int j = 0; j < 4; ++j) { const int n = (lane >> 3) + 8 * j; const LAS float* s = scr + (8 * c) * 33 + n;
        u32x4 o; o.x = pk2(s[0 * 33], s[1 * 33]); o.y = pk2(s[2 * 33], s[3 * 33]); o.z = pk2(s[4 * 33], s[5 * 33]); o.w = pk2(s[6 * 33], s[7 * 33]);
        *(u32x4*)(WT + (size_t)(out_row0 + n) * Kout + k0 + 8 * c) = o; }
    LDS_WAIT(); asm volatile("" ::: "memory");
}
__device__ __forceinline__ void p0_prologue(const Frame& F0) {
    Frame F = F0; F.wave = sopqi(F0.wave); F.lane = vopqi(lane_id()); F.tid = F.wave * 64 + F.lane; F.bid = sopqi(F0.bid);
    unsigned char* const ws = opq(F.ws);
    LAS float* cs = (LAS float*)F.lds;
    LAS float* red = (LAS float*)(F.lds + 65536);
    { const float* pc = inp(F, I_C); const float* pcc = inp(F, I_CCTX);
    for (int i = F.tid; i < 2048 * 8; i += 512) { const int k = i >> 3, j = i & 7; float v = 0.f;
        if (j < 4) v = siluf(pc[j * D + k]); else if (j == 4) v = siluf(pcc[k]); cs[i] = v; } }
    const float* adaw = inp(F, I_ADAW); const float* adab = inp(F, I_ADAB);
    __syncthreads();
    for (int u = F.bid; u < 256; u += F.G) {
        const int l = u >> 6, n0 = (u & 63) * 192;
        const float* W = adaw + (size_t)l * D * 12288 + n0 + 3 * F.lane;
        float acc[5][3];
#pragma unroll
        for (int j = 0; j < 5; ++j) { acc[j][0] = 0.f; acc[j][1] = 0.f; acc[j][2] = 0.f; }
        const int kb = F.wave * 256;
        for (int k0 = 0; k0 < 256; k0 += 8) {
            f32x3 w[8];
#pragma unroll
            for (int i = 0; i < 8; ++i) w[i] = *(const f32x3*)(W + (size_t)(kb + k0 + i) * 12288);
#pragma unroll
            for (int i = 0; i < 8; ++i) { const f32x4 c0 = *(const LAS f32x4*)(cs + (kb + k0 + i) * 8); const float c4 = cs[(kb + k0 + i) * 8 + 4];
                acc[0][0] += c0.x * w[i].x; acc[0][1] += c0.x * w[i].y; acc[0][2] += c0.x * w[i].z;
                acc[1][0] += c0.y * w[i].x; acc[1][1] += c0.y * w[i].y; acc[1][2] += c0.y * w[i].z;
                acc[2][0] += c0.z * w[i].x; acc[2][1] += c0.z * w[i].y; acc[2][2] += c0.z * w[i].z;
                acc[3][0] += c0.w * w[i].x; acc[3][1] += c0.w * w[i].y; acc[3][2] += c0.w * w[i].z;
                acc[4][0] += c4 * w[i].x;   acc[4][1] += c4 * w[i].y;   acc[4][2] += c4 * w[i].z; }
        }
#pragma unroll
        for (int j = 0; j < 5; ++j)
#pragma unroll
            for (int c = 0; c < 3; ++c) red[(F.wave * 64 + F.lane) * 15 + j * 3 + c] = acc[j][c];
        __syncthreads();
        for (int idx = F.tid; idx < 960; idx += 512) { const int ln = idx / 15, q = idx % 15, j = q / 3, cc = q % 3; float s = 0.f;
#pragma unroll
            for (int w = 0; w < 8; ++w) s += red[(w * 64 + ln) * 15 + q];
            const int n = n0 + 3 * ln + cc; ((float*)(ws + WS_MOD))[(size_t)(l * 5 + j) * 12288 + n] = s + adab[l * 12288 + n]; }
        __syncthreads();
    }
    LAS float* scr = (LAS float*)(F.lds + F.wave * 8448);
    const int gw = F.bid * NWAVES + F.wave, NGW = F.G * NWAVES;
    constexpr int NITEMS = 8192 + 4096 + 12288 + 4096 + 3 * 32768;
    const float* p_gmwin = inp(F, I_GMWIN); const float* p_gmwout = inp(F, I_GMWOUT); const float* p_mlwin = inp(F, I_MLWIN); const float* p_mlwout = inp(F, I_MLWOUT);
    const float* p_exg = inp(F, I_EXG); const float* p_exu = inp(F, I_EXU); const float* p_exd = inp(F, I_EXD);
    for (int it0 = gw; it0 < NITEMS; it0 += NGW) {
        int it = it0;
        if (it < 8192) { const int l = it >> 12, r = it & 4095; p0_transpose_item(p_gmwin + (size_t)l * D * 4096, 4096, D, (bf16*)(ws + WS_WGIN) + (size_t)l * 4096 * D, (r & 127) * 32, scr, (r >> 7) * 64, (r & 127) * 32, F.lane); continue; } it -= 8192;
        if (it < 4096) { const int l = it >> 11, r = it & 2047; p0_transpose_item(p_gmwout + (size_t)l * D * D, D, D, (bf16*)(ws + WS_WGOUT) + (size_t)l * D * D, (r & 63) * 32, scr, (r >> 6) * 64, (r & 63) * 32, F.lane); continue; } it -= 4096;
        if (it < 12288) { const int l = it / 6144, r = it % 6144; p0_transpose_item(p_mlwin + (size_t)l * D * MLIN, MLIN, D, (bf16*)(ws + WS_WMIN) + (size_t)l * 6144 * D, (r % 192) * 32, scr, (r / 192) * 64, (r % 192) * 32, F.lane); continue; } it -= 12288;
        if (it < 4096) { const int l = it >> 11, r = it & 2047; p0_transpose_item(p_mlwout + (size_t)l * D * D, D, D, (bf16*)(ws + WS_WMOUT) + (size_t)l * D * D, (r & 63) * 32, scr, (r >> 6) * 64, (r & 63) * 32, F.lane); continue; } it -= 4096;
        if (it < 65536) { const int up = it >> 15, r2 = it & 32767, le = r2 >> 9, r = r2 & 511, n0 = (r & 15) * 32;
            p0_transpose_item((up ? p_exu : p_exg) + (size_t)le * D * 512, 512, D, (bf16*)(ws + WS_WEGU) + (size_t)le * 1024 * D, (n0 >> 7) * 256 + (n0 & 127) + up * 128, scr, (r >> 4) * 64, n0, F.lane); continue; } it -= 65536;
        { const int le = it >> 9, r = it & 511; p0_transpose_item(p_exd + (size_t)le * 512 * D, D, 512, (bf16*)(ws + WS_WED) + (size_t)le * D * 512, (r & 63) * 32, scr, (r >> 6) * 64, (r & 63) * 32, F.lane); }
    }
    { const float* src = inp(F, I_GMWS); bf16* dst = (bf16*)(ws + WS_WSB);
      for (int i = F.bid * 512 + F.tid; i < 2 * 8 * 128 * 128 / 2; i += F.G * 512) ((unsigned*)dst)[i] = pk2(src[2 * i], src[2 * i + 1]); }
}

__device__ __forceinline__ const float* modp(unsigned char* ws, int l, int mi, int chunk) { return (const float*)(ws + WS_MOD) + ((size_t)(l * 5 + mi) * 6 + chunk) * D; }
__device__ __forceinline__ void load_row(const float* p, int lane, f32x4 (&v)[8]) {
    const f32x4* q = (const f32x4*)p + lane;
#pragma unroll
    for (int j = 0; j < 8; ++j) v[j] = q[64 * j];
}
__device__ __forceinline__ void store_row(float* p, int lane, const f32x4 (&v)[8]) {
    f32x4* q = (f32x4*)p + lane;
#pragma unroll
    for (int j = 0; j < 8; ++j) q[64 * j] = v[j];
}
__device__ __forceinline__ void store_row_bf16(bf16* p, int lane, const f32x4 (&v)[8]) {
    u32x2* q = (u32x2*)p + lane;
#pragma unroll
    for (int j = 0; j < 8; ++j) { u32x2 o; o.x = pk2(v[j].x, v[j].y); o.y = pk2(v[j].z, v[j].w); q[64 * j] = o; }
}
__device__ __forceinline__ void layer_norm_row(f32x4 (&v)[8], const float* g, const float* b, int lane) {
    float s = 0.f;
#pragma unroll
    for (int j = 0; j < 8; ++j) s += (v[j].x + v[j].y) + (v[j].z + v[j].w);
    const float mean = wave_sum(s) * (1.f / D); float q = 0.f;
#pragma unroll
    for (int j = 0; j < 8; ++j) { v[j] = v[j] - mean; q += (v[j].x * v[j].x + v[j].y * v[j].y) + (v[j].z * v[j].z + v[j].w * v[j].w); }
    const float rstd = 1.f / sqrtf(wave_sum(q) * (1.f / D) + LN_EPS);
    const f32x4* gp = (const f32x4*)g + lane; const f32x4* bp = (const f32x4*)b + lane;
#pragma unroll
    for (int j = 0; j < 8; ++j) v[j] = v[j] * rstd * gp[64 * j] + bp[64 * j];
}
__device__ __forceinline__ void modulate_row(f32x4 (&v)[8], const float* sc, const float* sh, int lane) {
    const f32x4* cp = (const f32x4*)sc + lane; const f32x4* hp = (const f32x4*)sh + lane;
#pragma unroll
    for (int j = 0; j < 8; ++j) v[j] = v[j] * (cp[64 * j] + 1.0f) + hp[64 * j];
}
__device__ __forceinline__ void load_tab16(const Frame& F, const float* src, int ld) {
    LAS float* tab = (LAS float*)F.lds;
    for (int i = F.tid; i < 2048 * 4; i += 512) { const int k = i >> 2, e4 = (i & 3) * 4; const f32x4 w = *(const f32x4*)(src + (size_t)k * ld + e4);
        tab[(e4 + 0) * 2048 + k] = w.x; tab[(e4 + 1) * 2048 + k] = w.y; tab[(e4 + 2) * 2048 + k] = w.z; tab[(e4 + 3) * 2048 + k] = w.w; }
}
__device__ __forceinline__ void dot16(const Frame& F, const f32x4 (&v)[8], float (&out)[16]) {
    const LAS float* tab = (const LAS float*)F.lds;
#pragma unroll
    for (int e = 0; e < 16; ++e) { float s = 0.f;
#pragma unroll
        for (int j = 0; j < 8; ++j) { const f32x4 w = *(const LAS f32x4*)(tab + e * 2048 + 256 * j + 4 * F.lane); s += (v[j].x * w.x + v[j].y * w.y) + (v[j].z * w.z + v[j].w * w.w); }
        out[e] = wave_sum(s); }
}
__device__ __forceinline__ int mod_index(int r) { return r < NLAT ? (r >> 11) : 4; }

__device__ __forceinline__ void p1_modulate0(const Frame& F0) {
    Frame F = F0; F.wave = sopqi(F0.wave); F.lane = vopqi(lane_id()); F.tid = F.wave * 64 + F.lane; F.bid = sopqi(F0.bid);
    unsigned char* const ws = opq(F.ws);
    const int gw = F.bid * NWAVES + F.wave, NGW = F.G * NWAVES;
    const float* xl = inp(F, I_X); const float* xc = inp(F, I_CTX);
    for (int r = gw; r < NTOK; r += NGW) { f32x4 v[8]; load_row(r < NLAT ? xl + (size_t)r * D : xc + (size_t)(r - NLAT) * D, F.lane, v); const int mi = mod_index(r);
        modulate_row(v, modp(ws, 0, mi, 1), modp(ws, 0, mi, 0), F.lane); store_row_bf16((bf16*)(ws + WS_HT) + (size_t)r * D, F.lane, v); }
}
__device__ __forceinline__ void ln1_phase(const Frame& F0, int layer, int Mrows) {
    Frame F = F0; F.wave = sopqi(F0.wave); F.lane = vopqi(lane_id()); F.tid = F.wave * 64 + F.lane; F.bid = sopqi(F0.bid);
    unsigned char* const ws = opq(F.ws);
    load_tab16(F, inp(F, I_RW), 16);
    LAS unsigned* cntl = (LAS unsigned*)(F.lds + 131072); LAS unsigned* basel = cntl + 16;
    LAS int* rinfo = (LAS int*)(F.lds + 131072 + 256) + F.wave * 64;
    if (F.tid < 16) cntl[F.tid] = 0u;
    __syncthreads();
    const int gw = F.bid * NWAVES + F.wave, NGW = F.G * NWAVES;
    float* X = (float*)(ws + WS_X); bf16* T = (bf16*)(ws + WS_HT);
    const float* lng = inp(F, I_LN1G) + layer * D; const float* lnb = inp(F, I_LN1B) + layer * D; const float* rb = inp(F, I_RB);
#pragma unroll 1
    for (int i = 0; gw + i * NGW < Mrows; ++i) {
        const int r = gw + i * NGW;
        f32x4 v[8]; load_row(X + (size_t)r * D, F.lane, v);
        layer_norm_row(v, lng, lnb, F.lane);
        store_row(X + (size_t)r * D, F.lane, v);
        const int mi = mod_index(r); modulate_row(v, modp(ws, layer, mi, 4), modp(ws, layer, mi, 3), F.lane);
        store_row_bf16(T + (size_t)r * D, F.lane, v);
        float lg[16]; dot16(F, v, lg);
        float mx = -3.0e38f;
#pragma unroll
        for (int e = 0; e < 16; ++e) { lg[e] += rb[e]; mx = fmaxf(mx, lg[e]); }
#pragma unroll
        for (int e = 0; e < 16; ++e) lg[e] = __expf(lg[e] - mx);
        float best = -1.f; int gs = 0;
#pragma unroll
        for (int g = 0; g < 4; ++g) { const float a = lg[4 * g], b = lg[4 * g + 1], c = lg[4 * g + 2], d = lg[4 * g + 3];
            const float h1 = fmaxf(a, b), l1 = fminf(a, b), h2 = fmaxf(c, d), l2 = fminf(c, d);
            const float sc = fmaxf(h1, h2) + fmaxf(fminf(h1, h2), fmaxf(l1, l2)); if (sc > best) { best = sc; gs = g; } }
        float q0 = 0.f, q1 = 0.f, q2 = 0.f, q3 = 0.f;
#pragma unroll
        for (int g = 0; g < 4; ++g) if (g == gs) { q0 = lg[4 * g]; q1 = lg[4 * g + 1]; q2 = lg[4 * g + 2]; q3 = lg[4 * g + 3]; }
        int i1 = 0; float p1 = q0; if (q1 > p1) { p1 = q1; i1 = 1; } if (q2 > p1) { p1 = q2; i1 = 2; } if (q3 > p1) { p1 = q3; i1 = 3; }
        int i2 = 0; float p2 = -1.f;
        if (i1 != 0 && q0 > p2) { p2 = q0; i2 = 0; } if (i1 != 1 && q1 > p2) { p2 = q1; i2 = 1; } if (i1 != 2 && q2 > p2) { p2 = q2; i2 = 2; } if (i1 != 3 && q3 > p2) { p2 = q3; i2 = 3; }
        const float inv = 1.f / (p1 + p2);
        if (F.lane == 0) { const int e0 = 4 * gs + i1, e1 = 4 * gs + i2;
            rinfo[i * 6 + 0] = e0; rinfo[i * 6 + 1] = e1;
            rinfo[i * 6 + 2] = (int)atomicAdd((unsigned*)&cntl[e0], 1u); rinfo[i * 6 + 3] = (int)atomicAdd((unsigned*)&cntl[e1], 1u);
            rinfo[i * 6 + 4] = __builtin_bit_cast(int, p1 * inv); rinfo[i * 6 + 5] = __builtin_bit_cast(int, p2 * inv); }
    }
    __syncthreads();
    unsigned* gcnt = (unsigned*)(ws + WS_CTL) + CW_CNT + layer * 64;
    if (F.tid < 16) { const unsigned c = cntl[F.tid]; basel[F.tid] = c ? __hip_atomic_fetch_add(gcnt + F.tid, c, __ATOMIC_RELAXED, __HIP_MEMORY_SCOPE_AGENT) : 0u; }
    __syncthreads();
    int* tokl = (int*)(ws + WS_TOKL); float* wl = (float*)(ws + WS_WL);
    if (F.lane == 0) {
        for (int i = 0; gw + i * NGW < Mrows; ++i) {
            const int r = gw + i * NGW, e0 = rinfo[i * 6 + 0], e1 = rinfo[i * 6 + 1];
            const int p0 = (int)basel[e0] + rinfo[i * 6 + 2], p1 = (int)basel[e1] + rinfo[i * 6 + 3];
            tokl[e0 * LCAP + p0] = r * 2; wl[e0 * LCAP + p0] = __builtin_bit_cast(float, rinfo[i * 6 + 4]);
            tokl[e1 * LCAP + p1] = r * 2 + 1; wl[e1 * LCAP + p1] = __builtin_bit_cast(float, rinfo[i * 6 + 5]);
        }
    }
}
__device__ __forceinline__ void ln2_phase(const Frame& F0, int layer, int Mrows) {
    Frame F = F0; F.wave = sopqi(F0.wave); F.lane = vopqi(lane_id()); F.tid = F.wave * 64 + F.lane; F.bid = sopqi(F0.bid);
    unsigned char* const ws = opq(F.ws);
    const bool last = layer == DEPTH - 1; const int nl = layer + 1; const bool gates = !last && (nl & 1);
    if (gates) { load_tab16(F, inp(F, I_MLWIN) + (size_t)(nl >> 1) * D * MLIN + 6144, MLIN); __syncthreads(); }
    const int gw = F.bid * NWAVES + F.wave, NGW = F.G * NWAVES;
    float* X = (float*)(ws + WS_X); const bf16* YM = (const bf16*)(ws + WS_YM); bf16* H = (bf16*)(ws + WS_HT); float* G = (float*)(ws + WS_G);
    const float* lng = inp(F, I_LN2G) + layer * D; const float* lnb = inp(F, I_LN2B) + layer * D; const float* gbias = inp(F, I_MLGB) + (nl >> 1) * 16; float* const outp = F.out;
#pragma unroll 1
    for (int r = gw; r < Mrows; r += NGW) {
        f32x4 v[8]; load_row(X + (size_t)r * D, F.lane, v);
        const int mi = mod_index(r); const f32x4* g2 = (const f32x4*)modp(ws, layer, mi, 5) + F.lane;
        const u32x2* y0 = (const u32x2*)(YM + (size_t)(2 * r) * D) + F.lane; const u32x2* y1 = (const u32x2*)(YM + (size_t)(2 * r + 1) * D) + F.lane;
#pragma unroll
        for (int j = 0; j < 8; ++j) { const u32x2 a = y0[64 * j], b = y1[64 * j];
            const f32x4 y = (f32x4){bflo(a.x) + bflo(b.x), bfhi(a.x) + bfhi(b.x), bflo(a.y) + bflo(b.y), bfhi(a.y) + bfhi(b.y)};
            v[j] = v[j] * ALPHA + g2[64 * j] * y; }
        layer_norm_row(v, lng, lnb, F.lane);
        if (last) { store_row(outp + (size_t)r * D, F.lane, v); continue; }
        store_row(X + (size_t)r * D, F.lane, v);
        modulate_row(v, modp(ws, nl, mi, 1), modp(ws, nl, mi, 0), F.lane);
        store_row_bf16(H + (size_t)r * D, F.lane, v);
        if (gates) { float gv[16]; dot16(F, v, gv); const int rp = (nl == 3) ? permrow(r) : r;
            if (F.lane < 16) { float o = 0.f;
#pragma unroll
                for (int e = 0; e < 16; ++e) if (F.lane == e) o = gv[e];
                G[(size_t)rp * 16 + F.lane] = o + gbias[F.lane]; } }
    }
}
__device__ __forceinline__ void conv_phase(const Frame& F0, int idx) {
    Frame F = F0; F.wave = sopqi(F0.wave); F.lane = vopqi(lane_id()); F.tid = F.wave * 64 + F.lane; F.bid = sopqi(F0.bid);
    unsigned char* const ws = opq(F.ws);
    const bf16* P = (const bf16*)(ws + WS_A1); bf16* Q = (bf16*)(ws + WS_A2); const float* cw = inp(F, I_MLCONV) + (size_t)idx * 3 * D;
    for (int it = F.bid * 512 + F.tid; it < (NTOK / 8) * 256; it += F.G * 512) {
        const int cg = it & 255, r0 = (it >> 8) * 8, c0 = cg * 8;
        const int seqlen = r0 < NLAT ? 2048 : 256, p0 = r0 < NLAT ? (r0 & 2047) : ((r0 - NLAT) & 255);
        float w0[8], w1[8], w2[8];
#pragma unroll
        for (int j = 0; j < 8; ++j) { w0[j] = cw[c0 + j]; w1[j] = cw[D + c0 + j]; w2[j] = cw[2 * D + c0 + j]; }
        const float ksc = c0 >= 1024 ? 0.0625f : 1.0f;
        u32x4 prev = (u32x4){0u, 0u, 0u, 0u}, curv, nxtv;
        if (p0 > 0) prev = *(const u32x4*)(P + (size_t)(r0 - 1) * D + c0);
        curv = *(const u32x4*)(P + (size_t)r0 * D + c0);
#pragma unroll
        for (int i = 0; i < 8; ++i) {
            nxtv = (u32x4){0u, 0u, 0u, 0u};
            if (p0 + i + 1 < seqlen) nxtv = *(const u32x4*)(P + (size_t)(r0 + i + 1) * D + c0);
            float o[8];
#pragma unroll
            for (int j = 0; j < 4; ++j) {
                const float a0 = bflo(prev[j]), a1 = bfhi(prev[j]), b0 = bflo(curv[j]), b1 = bfhi(curv[j]), d0 = bflo(nxtv[j]), d1 = bfhi(nxtv[j]);
                o[2 * j] = siluf(w0[2 * j] * a0 + w1[2 * j] * b0 + w2[2 * j] * d0) * ksc;
                o[2 * j + 1] = siluf(w0[2 * j + 1] * a1 + w1[2 * j + 1] * b1 + w2[2 * j + 1] * d1) * ksc; }
            u32x4 ov; ov.x = pk2(o[0], o[1]); ov.y = pk2(o[2], o[3]); ov.z = pk2(o[4], o[5]); ov.w = pk2(o[6], o[7]);
            *(u32x4*)(Q + (size_t)(r0 + i) * D + c0) = ov;
            prev = curv; curv = nxtv;
        }
    }
}
__device__ __forceinline__ void comb_phase(const Frame& F0, int idx, int Mrows) {
    Frame F = F0; F.wave = sopqi(F0.wave); F.lane = vopqi(lane_id()); F.tid = F.wave * 64 + F.lane; F.bid = sopqi(F0.bid);
    unsigned char* const ws = opq(F.ws);
    const bf16* HF = (const bf16*)(ws + WS_HSF); const bf16* HB = (const bf16*)(ws + WS_HSB); const bf16* PO = (const bf16*)(ws + WS_A4); bf16* ZL = (bf16*)(ws + WS_ZL);
    const f32x4* ng = (const f32x4*)(inp(F, I_MLNG) + (size_t)idx * D) + F.lane;
    const int gw = F.bid * NWAVES + F.wave, NGW = F.G * NWAVES;
    for (int r = gw; r < Mrows; r += NGW) {
        const u32x2* hf = (const u32x2*)(HF + (size_t)r * D) + F.lane; const u32x2* hb = (const u32x2*)(HB + (size_t)r * D) + F.lane; const u32x2* po = (const u32x2*)(PO + (size_t)r * D) + F.lane;
        f32x4 v[8];
#pragma unroll
        for (int j = 0; j < 8; ++j) { const u32x2 a = hf[64 * j], b = hb[64 * j]; v[j] = (f32x4){bflo(a.x) + bflo(b.x), bfhi(a.x) + bfhi(b.x), bflo(a.y) + bflo(b.y), bfhi(a.y) + bfhi(b.y)}; }
#pragma unroll
        for (int h = 0; h < 4; ++h) { float q = 0.f;
#pragma unroll
            for (int jj = 0; jj < 2; ++jj) { const f32x4 x = v[2 * h + jj]; q += (x.x * x.x + x.y * x.y) + (x.z * x.z + x.w * x.w); }
            const float rs = 1.f / sqrtf(wave_sum(q) * (1.f / 512.f) + RMS_EPS);
#pragma unroll
            for (int jj = 0; jj < 2; ++jj) { const int j = 2 * h + jj; const u32x2 o = po[64 * j]; const f32x4 sg = (f32x4){bflo(o.x), bfhi(o.x), bflo(o.y), bfhi(o.y)}; v[j] = v[j] * rs * ng[64 * j] * sg; } }
        store_row_bf16(ZL + (size_t)r * D, F.lane, v);
    }
}
__device__ __forceinline__ void gate_phase(const Frame& F0, int idx) {
    Frame F = F0; F.wave = sopqi(F0.wave); F.lane = vopqi(lane_id()); F.tid = F.wave * 64 + F.lane; F.bid = sopqi(F0.bid);
    unsigned char* const ws = opq(F.ws);
    constexpr int VT_STRIDE = 272, SS_STRIDE = 132, VT_OFF = 0, SS_OFF = 34816;
    const bf16* U = (const bf16*)(ws + WS_A1); const bf16* V = (const bf16*)(ws + WS_A2); bf16* Z = (bf16*)(ws + WS_A3);
    const float* vst = (const float*)(ws + WS_VST); const bf16* Wsb = (const bf16*)(ws + WS_WSB) + (size_t)idx * 8 * 128 * 128;
    const float* lg = inp(F, I_GMLNG) + (size_t)idx * D; const float* lb = inp(F, I_GMLNB) + (size_t)idx * D; const float* bs = inp(F, I_GMBS) + (size_t)idx * 8 * 128;
    const int fr = F.lane & 15, fq = F.lane >> 4, w = F.wave;
    for (int un = F.bid; un < 72 * 16; un += F.G) {
        const int n = un >> 4, jb = un & 15, g = jb >> 1, R0 = n * 128, C0 = jb * 128;
        __syncthreads();
        {
            const int q = F.tid >> 2, seg = F.tid & 3; const float* sp = vst + (size_t)(R0 + q) * 64; float s = 0.f, ss = 0.f;
#pragma unroll
            for (int i = 0; i < 16; ++i) { const f32x4 t = *(const f32x4*)(sp + 4 * i); s += t.x + t.z; ss += t.y + t.w; }
            const float mean = s * (1.f / D), rstd = 1.f / sqrtf(ss * (1.f / D) - mean * mean + LN_EPS);
            const bf16* vp = V + (size_t)(R0 + q) * D + C0 + seg * 32;
#pragma unroll
            for (int i = 0; i < 4; ++i) { const u32x4 x = *(const u32x4*)(vp + 8 * i); const int c = seg * 32 + 8 * i;
#pragma unroll
                for (int j = 0; j < 4; ++j) { const float a = (bflo(x[j]) - mean) * rstd * lg[C0 + c + 2 * j] + lb[C0 + c + 2 * j], b = (bfhi(x[j]) - mean) * rstd * lg[C0 + c + 2 * j + 1] + lb[C0 + c + 2 * j + 1];
                    *(LAS bf16*)(F.lds + VT_OFF + (c + 2 * j) * VT_STRIDE + q * 2) = (bf16)f2bf(a); *(LAS bf16*)(F.lds + VT_OFF + (c + 2 * j + 1) * VT_STRIDE + q * 2) = (bf16)f2bf(b); } }
        }
        bf16x8 af[4];
#pragma unroll
        for (int ks = 0; ks < 4; ++ks) af[ks] = *(const bf16x8*)(Wsb + ((size_t)g * 128 + 16 * w + fr) * 128 + 32 * ks + 8 * fq);
        __syncthreads();
        f32x4 acc[8];
#pragma unroll
        for (int nt = 0; nt < 8; ++nt) { acc[nt] = (f32x4){0.f, 0.f, 0.f, 0.f};
#pragma unroll
            for (int ks = 0; ks < 4; ++ks) { const bf16x8 bfr = *(const LAS bf16x8*)(F.lds + VT_OFF + (16 * nt + fr) * VT_STRIDE + (32 * ks + 8 * fq) * 2);
                acc[nt] = __builtin_amdgcn_mfma_f32_16x16x32_bf16(af[ks], bfr, acc[nt], 0, 0, 0); } }
        LAS float* SS = (LAS float*)(F.lds + SS_OFF);
#pragma unroll
        for (int reg = 0; reg < 4; ++reg) { const int p = 16 * w + 4 * fq + reg; const float b = bs[g * 128 + p];
#pragma unroll
            for (int nt = 0; nt < 8; ++nt) SS[p * SS_STRIDE + 16 * nt + fr] = acc[nt][reg] + b; }
        LDS_WAIT(); asm volatile("" ::: "memory");
        {
            const int p = 16 * w + (F.lane >> 2), seg = F.lane & 3; const bf16* up = U + (size_t)(R0 + p) * D + C0 + seg * 32; bf16* zp = Z + (size_t)(R0 + p) * D + C0 + seg * 32;
#pragma unroll
            for (int i = 0; i < 4; ++i) { const u32x4 x = *(const u32x4*)(up + 8 * i); const LAS float* sp = SS + p * SS_STRIDE + seg * 32 + 8 * i;
                const f32x4 s0 = *(const LAS f32x4*)sp, s1 = *(const LAS f32x4*)(sp + 4);
                u32x4 o; o.x = pk2(bflo(x.x) * s0.x, bfhi(x.x) * s0.y); o.y = pk2(bflo(x.y) * s0.z, bfhi(x.y) * s0.w); o.z = pk2(bflo(x.z) * s1.x, bfhi(x.z) * s1.y); o.w = pk2(bflo(x.w) * s1.z, bfhi(x.w) * s1.w);
                *(u32x4*)(zp + 8 * i) = o; }
        }
    }
}
__device__ __forceinline__ float wave_incl_sum(float v, int lane) {
#pragma unroll
    for (int o = 1; o < 64; o <<= 1) { const float t = __shfl_up(v, o); if (lane >= o) v += t; }
    return v;
}
__device__ __forceinline__ float wave_incl_max(float v, int lane) {
#pragma unroll
    for (int o = 1; o < 64; o <<= 1) { const float t = __shfl_up(v, o); if (lane >= o) v = fmaxf(v, t); }
    return v;
}
__device__ __forceinline__ float log_sigmoid(float x) { return fminf(x, 0.f) - log1pf(__expf(-fabsf(x))); }
__device__ __forceinline__ void scan_phase(const Frame& F0, int write_ctx) {
    Frame F = F0; F.wave = sopqi(F0.wave); F.lane = vopqi(lane_id()); F.tid = F.wave * 64 + F.lane; F.bid = sopqi(F0.bid);
    unsigned char* const ws = opq(F.ws);
    constexpr int KS_OFF = 0, KS_STRIDE = 528, VT_OFF = 67584, VT_STRIDE = 272, R1_OFF = 89344, CT_STRIDE = 528, SP_STRIDE = 272, GU_OFF = 131584;
    const bf16* QK = (const bf16*)(ws + WS_A2); const bf16* PV = (const bf16*)(ws + WS_A3); const float* G = (const float*)(ws + WS_G);
    const int w = F.wave, tid0 = F.tid;
#define IDS const int tid = vopqi(tid0), lane = tid & 63, fr = lane & 15, fq = lane >> 4; (void)tid; (void)lane; (void)fr; (void)fq
    const int tau = w < 4 ? w : 11 - w;
    for (int uid = F.bid; uid < 256; uid += F.G) {
        const int sl = uid & 7, dir = (uid >> 3) & 1, h = (uid >> 4) & 3, b = uid >> 6;
        bf16* HS = (bf16*)(ws + (dir ? WS_HSB : WS_HSF));
        __syncthreads();
        { IDS;
        for (int i = tid; i < 16 * 128; i += 512) { const int e = 64 + (i >> 7), s = i & 127; *(LAS bf16*)(F.lds + VT_OFF + e * VT_STRIDE + s * 2) = (bf16)(e == 64 ? 0x3f80u : 0u); }
        for (int i = tid; i < 80 * 128; i += 512) { const int e = i >> 7, d4 = i & 127; *(LAS unsigned*)(F.lds + R1_OFF + e * CT_STRIDE + d4 * 4) = 0u; } }
        f32x4 Cst[2][5];
#pragma unroll
        for (int mt = 0; mt < 2; ++mt)
#pragma unroll
            for (int nt = 0; nt < 5; ++nt) Cst[mt][nt] = (f32x4){0.f, 0.f, 0.f, 0.f};
        float m_prev = 0.f;
#define CHUNK_BASE(ci) ((ci) < 2 ? (NLAT + b * 256 + (dir ? 1 - (ci) : (ci)) * 128) : (b * 2048 + (dir ? 17 - (ci) : (ci) - 2) * 128))
#define ROW_OF(base, j) ((base) + (dir ? 127 - (j) : (j)))
        u32x4 kpre[8], vpre[2]; float gi = 0.f, gf = 0.f; bf16x8 Qf[8];
        {   IDS; const int base = CHUNK_BASE(0);
#pragma unroll
            for (int i = 0; i < 8; ++i) { const int p = tid + 512 * i, j = p >> 5, c16 = p & 31; kpre[i] = *(const u32x4*)(QK + (unsigned)(ROW_OF(base, j) * D + 1024 + h * 256 + c16 * 8)); }
#pragma unroll
            for (int i = 0; i < 2; ++i) { const int p = tid + 512 * i, j = p >> 3, e8 = p & 7; vpre[i] = *(const u32x4*)(PV + (unsigned)(ROW_OF(base, j) * D + h * 512 + sl * 64 + e8 * 8)); }
            if (tid < 128) { const float* gp = G + (unsigned)(ROW_OF(base, tid) * 16 + dir * 8 + h); gi = gp[0]; gf = gp[4]; }
#pragma unroll
            for (int ks = 0; ks < 8; ++ks) Qf[ks] = *(const bf16x8*)(QK + (unsigned)(ROW_OF(base, 16 * tau + fr) * D + h * 256 + 32 * ks + 8 * fq));
        }
        for (int ci = 0; ci < 18; ++ci) {
            const int base = CHUNK_BASE(ci);
            { IDS; LAS unsigned char* const L = vopq(F.lds);
#pragma unroll
            for (int i = 0; i < 8; ++i) { const int p = tid + 512 * i, j = p >> 5, c16 = p & 31; *(LAS u32x4*)(L + KS_OFF + j * KS_STRIDE + c16 * 16) = kpre[i]; }
#pragma unroll
            for (int i = 0; i < 2; ++i) { const int p = tid + 512 * i, j = p >> 3, e8 = p & 7;
#pragma unroll
                for (int q = 0; q < 4; ++q) { *(LAS bf16*)(L + VT_OFF + (e8 * 8 + 2 * q) * VT_STRIDE + j * 2) = (bf16)(vpre[i][q] & 0xffffu); *(LAS bf16*)(L + VT_OFF + (e8 * 8 + 2 * q + 1) * VT_STRIDE + j * 2) = (bf16)(vpre[i][q] >> 16); } }
            if (tid < 128) { LAS float* tt = (LAS float*)(L + GU_OFF); tt[512 + tid] = gi; tt[640 + tid] = log_sigmoid(gf); } }
            __syncthreads();
            if (ci + 1 < 18) {
                IDS; const int nb = CHUNK_BASE(ci + 1);
#pragma unroll
                for (int i = 0; i < 8; ++i) { const int p = tid + 512 * i, j = p >> 5, c16 = p & 31; kpre[i] = *(const u32x4*)(QK + (unsigned)(ROW_OF(nb, j) * D + 1024 + h * 256 + c16 * 8)); }
#pragma unroll
                for (int i = 0; i < 2; ++i) { const int p = tid + 512 * i, j = p >> 3, e8 = p & 7; vpre[i] = *(const u32x4*)(PV + (unsigned)(ROW_OF(nb, j) * D + h * 512 + sl * 64 + e8 * 8)); }
                if (tid < 128) { const float* gp = G + (unsigned)(ROW_OF(nb, tid) * 16 + dir * 8 + h); gi = gp[0]; gf = gp[4]; }
            }
            if (w == 0) {
                IDS; LAS float* const gu = (LAS float*)(vopq(F.lds) + GU_OFF); LAS float* const gM = gu + 128; LAS float* const gb = gu + 256; LAS float* const gw_ = gu + 384; LAS float* const ti = gu + 512; LAS float* const tf = gu + 640; LAS float* const scal = gu + 768;
                const float f0 = tf[2 * lane], f1 = tf[2 * lane + 1], i0 = ti[2 * lane], i1 = ti[2 * lane + 1];
                const float incl = wave_incl_sum(f0 + f1, lane), b1 = incl, b0 = incl - f1;
                const float u0 = i0 - b0, u1 = i1 - b1;
                const float pin = wave_incl_max(fmaxf(u0, u1), lane); float pex = __shfl_up(pin, 1); if (lane == 0) pex = -3.0e38f;
                const float pm0 = fmaxf(pex, u0), pm1 = pin;
                const float M0 = fmaxf(m_prev, pm0), M1 = fmaxf(m_prev, pm1);
                const float M127 = __shfl(M1, 63), bL = __shfl(b1, 63);
                gu[2 * lane] = u0; gu[2 * lane + 1] = u1; gM[2 * lane] = M0; gM[2 * lane + 1] = M1; gb[2 * lane] = b0; gb[2 * lane + 1] = b1;
                gw_[2 * lane] = __expf(u0 - M127); gw_[2 * lane + 1] = __expf(u1 - M127);
                if (lane == 0) { scal[0] = bL + M127; scal[1] = __expf(m_prev - M127); }
            }
            f32x4 acc3[5];
#pragma unroll
            for (int nt = 0; nt < 5; ++nt) acc3[nt] = (f32x4){0.f, 0.f, 0.f, 0.f};
            { IDS; LAS unsigned char* L = vopq(F.lds) + R1_OFF + fr * CT_STRIDE + fq * 16;
#pragma unroll
            for (int ks = 0; ks < 8; ++ks)
            {
#pragma unroll
                for (int nt = 0; nt < 5; ++nt) { const bf16x8 bfr = *(const LAS bf16x8*)(L + 16 * nt * CT_STRIDE + 64 * ks);
                    acc3[nt] = __builtin_amdgcn_mfma_f32_16x16x32_bf16(Qf[ks], bfr, acc3[nt], 0, 0, 0);
                    if (nt == 0) asm volatile("" : "+v"(L) : "v"(acc3[0])); }
            } }
            __syncthreads();
            float m_new, a_dec, Mt[4], bt[4];
            { IDS; LAS float* const gu = (LAS float*)(vopq(F.lds) + GU_OFF); m_new = gu[768]; a_dec = gu[769];
#pragma unroll
            for (int reg = 0; reg < 4; ++reg) { Mt[reg] = gu[128 + 16 * tau + 4 * fq + reg]; bt[reg] = gu[256 + 16 * tau + 4 * fq + reg]; } }
#pragma unroll 1
            for (int nt = 0; nt < 8; ++nt) {
                IDS; const int s = 16 * nt + fr; LAS unsigned char* const L = vopq(F.lds);
                if (nt <= tau) {
                    f32x4 a = (f32x4){0.f, 0.f, 0.f, 0.f};
#pragma unroll
                    for (int ks = 0; ks < 8; ++ks) { const bf16x8 kf = *(const LAS bf16x8*)(L + KS_OFF + s * KS_STRIDE + (32 * ks + 8 * fq) * 2);
                        a = __builtin_amdgcn_mfma_f32_16x16x32_bf16(Qf[ks], kf, a, 0, 0, 0); }
                    const float us = ((const LAS float*)(L + GU_OFF))[s];
#pragma unroll
                    for (int reg = 0; reg < 4; ++reg) { const int t = 16 * tau + 4 * fq + reg; const float val = (s <= t) ? a[reg] * __expf(us - Mt[reg]) : 0.f;
                        *(LAS bf16*)(L + R1_OFF + t * SP_STRIDE + s * 2) = (bf16)f2bf(val); }
                } else {
#pragma unroll
                    for (int reg = 0; reg < 4; ++reg) { const int t = 16 * tau + 4 * fq + reg; *(LAS bf16*)(L + R1_OFF + t * SP_STRIDE + s * 2) = (bf16)0u; }
                }
            }
            if (ci + 1 < 18) { IDS; const int nb = CHUNK_BASE(ci + 1);
#pragma unroll
                for (int ks = 0; ks < 8; ++ks) Qf[ks] = *(const bf16x8*)(QK + (unsigned)(ROW_OF(nb, 16 * tau + fr) * D + h * 256 + 32 * ks + 8 * fq)); }
            LDS_WAIT(); asm volatile("" ::: "memory");
            f32x4 acc2[5];
#pragma unroll
            for (int nt = 0; nt < 5; ++nt) acc2[nt] = (f32x4){0.f, 0.f, 0.f, 0.f};
#pragma unroll 1
            for (int ks = 0; ks < 4; ++ks) if (2 * ks <= tau) {
                IDS; LAS unsigned char* const L = vopq(F.lds);
                const bf16x8 af = *(const LAS bf16x8*)(L + R1_OFF + (16 * tau + fr) * SP_STRIDE + (32 * ks + 8 * fq) * 2);
#pragma unroll
                for (int nt = 0; nt < 5; ++nt) { const bf16x8 bfr = *(const LAS bf16x8*)(L + VT_OFF + (16 * nt + fr) * VT_STRIDE + (32 * ks + 8 * fq) * 2);
                    acc2[nt] = __builtin_amdgcn_mfma_f32_16x16x32_bf16(af, bfr, acc2[nt], 0, 0, 0); } }
            {
                IDS; const bool wr_out = (ci >= 2) || write_ctx;
#pragma unroll
                for (int reg = 0; reg < 4; ++reg) {
                    const float dec = __expf(m_prev - Mt[reg]);
                    float den = dec * acc3[4][reg] + acc2[4][reg]; den = __shfl(den, lane & 48);
                    const float dn = fmaxf(fabsf(den), __expf(-(bt[reg] + Mt[reg]))), inv = 1.f / dn;
                    if (wr_out) { const int t = 16 * tau + 4 * fq + reg; bf16* hp = HS + (unsigned)(ROW_OF(base, t) * D + h * 512 + sl * 64 + fr);
#pragma unroll
                        for (int nt = 0; nt < 4; ++nt) hp[16 * nt] = (bf16)f2bf((dec * acc3[nt][reg] + acc2[nt][reg]) * inv); }
                }
            }
#pragma unroll
            for (int mt = 0; mt < 2; ++mt)
#pragma unroll
                for (int nt = 0; nt < 5; ++nt) Cst[mt][nt] = Cst[mt][nt] * a_dec;
#pragma unroll 1
            for (int ks = 0; ks < 4; ++ks) {
                IDS; LAS unsigned char* const L = vopq(F.lds);
                float wv8[8];
#pragma unroll
                for (int j = 0; j < 8; ++j) wv8[j] = ((const LAS float*)(L + GU_OFF))[384 + 32 * ks + 8 * fq + j];
                bf16x8 afr[2];
#pragma unroll
                for (int mt = 0; mt < 2; ++mt) { const int d = 32 * w + 16 * mt + fr; unsigned pk[4];
#pragma unroll
                    for (int j = 0; j < 4; ++j) { const float k0 = bf2f(*(const LAS bf16*)(L + KS_OFF + (32 * ks + 8 * fq + 2 * j) * KS_STRIDE + d * 2)) * wv8[2 * j];
                        const float k1 = bf2f(*(const LAS bf16*)(L + KS_OFF + (32 * ks + 8 * fq + 2 * j + 1) * KS_STRIDE + d * 2)) * wv8[2 * j + 1]; pk[j] = pk2(k0, k1); }
                    afr[mt] = __builtin_bit_cast(bf16x8, (u32x4){pk[0], pk[1], pk[2], pk[3]}); }
#pragma unroll
                for (int nt = 0; nt < 5; ++nt) { const bf16x8 bfr = *(const LAS bf16x8*)(L + VT_OFF + (16 * nt + fr) * VT_STRIDE + (32 * ks + 8 * fq) * 2);
#pragma unroll
                    for (int mt = 0; mt < 2; ++mt) Cst[mt][nt] = __builtin_amdgcn_mfma_f32_16x16x32_bf16(afr[mt], bfr, Cst[mt][nt], 0, 0, 0); }
                __builtin_amdgcn_sched_barrier(0);
            }
            __syncthreads();
            { IDS; LAS unsigned char* const L = vopq(F.lds);
#pragma unroll
            for (int mt = 0; mt < 2; ++mt)
#pragma unroll
                for (int nt = 0; nt < 5; ++nt) { const int e = 16 * nt + fr, d0 = 32 * w + 16 * mt + 4 * fq; u32x2 o; o.x = pk2(Cst[mt][nt][0], Cst[mt][nt][1]); o.y = pk2(Cst[mt][nt][2], Cst[mt][nt][3]);
                    *(LAS u32x2*)(L + R1_OFF + e * CT_STRIDE + d0 * 2) = o; } }
            m_prev = m_new;
        }
#undef CHUNK_BASE
#undef ROW_OF
#undef IDS
    }
}

constexpr int NPH = 2 + 9 * DEPTH;
__host__ __device__ inline bool phase_exists(int id) { if (id < 2) return true; const int L = (id - 2) / 9, s = (id - 2) % 9; return !((L & 1) == 0 && (s == 3 || s == 4)); }

__global__ void __launch_bounds__(NWAVES * 64, 2) fwd(Args args) {
    extern __shared__ __attribute__((aligned(16))) unsigned char lds_raw[];
    Frame F;
    F.lds = (LAS unsigned char*)lds_raw; F.tid = threadIdx.x; F.lane = F.tid & 63; F.wave = __builtin_amdgcn_readfirstlane(F.tid >> 6); F.G = gridDim.x; F.bid = blockIdx.x;
    F.ws = args.ws; F.out = args.out;
    if (F.tid < 26) { const unsigned long long pv = (unsigned long long)args.in[F.tid]; LAS unsigned* t = (LAS unsigned*)(F.lds + PTAB_OFF) + 2 * F.tid; t[0] = (unsigned)pv; t[1] = (unsigned)(pv >> 32); }
    volatile LAS unsigned* MISC = (volatile LAS unsigned*)(F.lds + MISC_OFF);
    if (F.tid < 64) MISC[F.tid] = 0u;
    __syncthreads();
    unsigned* ctl = (unsigned*)(F.ws + WS_CTL);
    XcdBarrier bar; bar.bar = ctl + CW_BAR; bar.x = 0; bar.st = nullptr;
    const int lo = args.ph_lo, hi = args.ph_hi;
    const bool multi = (hi - lo) > 1;
    if (multi) bar = xcd_barrier_post(ctl + CW_BAR, MISC + 8, F.tid == 0);
#define IN(k) (lo <= (k) && (k) < hi)
#define SEAM(k) do { if ((k) + 1 < hi) xcd_barrier(bar, F.wave == 0 && lane_id() == 0); } while (0)

    if (PHON(0) && IN(0)) { p0_prologue(F); SEAM(0); }
    if (PHON(1) && IN(1)) { p1_modulate0(F); SEAM(1); }
    for (int layer = 0; layer < DEPTH; ++layer) {
        const int pb = 2 + 9 * layer, idx = layer >> 1; const bool last = layer == DEPTH - 1;
        const int Mpost = last ? NLAT : NTOK;
        if ((layer & 1) == 0) {
            if (PHON(2) && IN(pb + 0)) {
                unsigned char* const ws = opq(F.ws);
                pg8::Gemm g{(const bf16*)(ws + WS_HT), (const bf16*)(ws + WS_WGIN) + (size_t)idx * 4096 * D, D, 0, nullptr};
                pg8::StaticOrder S; S.init(Mpost, 4096, F.G, sopqi(F.bid));
                EpiGA E{(bf16*)(ws + WS_A1), (bf16*)(ws + WS_A2), (float*)(ws + WS_VST)};
                pg8::gemm_phase<EpiGA, pg8::StaticOrder, 0>(F.lds, g, S, E, F.wave); SEAM(pb + 0); }
            if (PHON(3) && IN(pb + 1)) { gate_phase(F, idx); SEAM(pb + 1); }
            if (PHON(4) && IN(pb + 2)) {
                unsigned char* const ws = opq(F.ws);
                const float* g1base = (const float*)(ws + WS_MOD) + (size_t)layer * 5 * 12288 + 2 * D; const float* xlat = layer == 0 ? inp(F, I_X) : (const float*)(ws + WS_X); const float* xctx = layer == 0 ? inp(F, I_CTX) : (const float*)(ws + WS_X) + (size_t)NLAT * D;
                pg8::Gemm g{(const bf16*)(ws + WS_A3), (const bf16*)(ws + WS_WGOUT) + (size_t)idx * D * D, D, 0, nullptr};
                pg8::StaticOrder S; S.init(Mpost, D, F.G, sopqi(F.bid));
                EpiRes E{xlat, xctx, (float*)(ws + WS_X), g1base, 0};
                pg8::gemm_phase<EpiRes, pg8::StaticOrder, 0>(F.lds, g, S, E, F.wave); SEAM(pb + 2); }
        } else {
            const int perm = (idx & 1);
            if (PHON(5) && IN(pb + 0)) {
                unsigned char* const ws = opq(F.ws);
                pg8::Gemm g{(const bf16*)(ws + WS_HT), (const bf16*)(ws + WS_WMIN) + (size_t)idx * 6144 * D, D, 0, nullptr};
                pg8::StaticOrder S; S.init(NTOK, 6144, F.G, sopqi(F.bid));
                EpiLA E{ws, perm};
                pg8::gemm_phase<EpiLA, pg8::StaticOrder, 0>(F.lds, g, S, E, F.wave); SEAM(pb + 0); }
            if (PHON(6) && IN(pb + 1)) { conv_phase(F, idx); SEAM(pb + 1); }
            if (PHON(7) && IN(pb + 2)) { scan_phase(F, last ? 0 : 1); SEAM(pb + 2); }
            if (PHON(8) && IN(pb + 3)) { comb_phase(F, idx, Mpost); SEAM(pb + 3); }
            if (PHON(9) && IN(pb + 4)) {
                unsigned char* const ws = opq(F.ws);
                const float* g1base = (const float*)(ws + WS_MOD) + (size_t)layer * 5 * 12288 + 2 * D; const float* xlat = layer == 0 ? inp(F, I_X) : (const float*)(ws + WS_X); const float* xctx = layer == 0 ? inp(F, I_CTX) : (const float*)(ws + WS_X) + (size_t)NLAT * D;
                pg8::Gemm g{(const bf16*)(ws + WS_ZL), (const bf16*)(ws + WS_WMOUT) + (size_t)idx * D * D, D, 0, nullptr};
                pg8::StaticOrder S; S.init(Mpost, D, F.G, sopqi(F.bid));
                EpiRes E{xlat, xctx, (float*)(ws + WS_X), g1base, perm};
                pg8::gemm_phase<EpiRes, pg8::StaticOrder, 0>(F.lds, g, S, E, F.wave); SEAM(pb + 4); }
        }
        if (PHON(10) && IN(pb + 5)) { ln1_phase(F, layer, Mpost); SEAM(pb + 5); }
        if (PHON(11) && IN(pb + 6)) {
            unsigned char* const ws = opq(F.ws);
            pg8::Gemm g{(const bf16*)(ws + WS_HT), (const bf16*)(ws + WS_WEGU) + (size_t)layer * 16 * 1024 * D, D, (size_t)1024 * D * 2, (const int*)(ws + WS_TOKL)};
            pg8::MoeOrder S{(unsigned*)(ws + WS_CTL) + CW_CNT + layer * 64, 4, F.G, sopqi(F.bid)};
            EpiMoE1 E{(bf16*)(ws + WS_HM), (const float*)(ws + WS_WL)};
            pg8::gemm_phase<EpiMoE1, pg8::MoeOrder, 1>(F.lds, g, S, E, F.wave); SEAM(pb + 6); }
        if (PHON(12) && IN(pb + 7)) {
            unsigned char* const ws = opq(F.ws);
            pg8::Gemm g{(const bf16*)(ws + WS_HM), (const bf16*)(ws + WS_WED) + (size_t)layer * 16 * D * 512, 512, (size_t)D * 512 * 2, nullptr};
            pg8::MoeOrder S{(unsigned*)(ws + WS_CTL) + CW_CNT + layer * 64, 8, F.G, sopqi(F.bid)};
            EpiMoE2 E{(bf16*)(ws + WS_YM), (const int*)(ws + WS_TOKL)};
            pg8::gemm_phase<EpiMoE2, pg8::MoeOrder, 0>(F.lds, g, S, E, F.wave); SEAM(pb + 7); }
        if (PHON(13) && IN(pb + 8)) { ln2_phase(F, layer, Mpost); SEAM(pb + 8); }
    }
#undef IN
#undef SEAM
}

extern "C" void kernel_launch(void* const* d_in, const int* in_sizes, int n_in, void* d_out, int out_size, void* d_ws, size_t ws_size, hipStream_t stream) {
    static int grid = 0;
    if (grid == 0) {
        if (n_in != 26 || out_size != NLAT * D || ws_size < WS_END) { fprintf(stderr, "kernel_launch: unexpected problem: n_in %d out %d ws %zu (need %zu)\n", n_in, out_size, ws_size, (size_t)WS_END); grid = -1; return; }
        int dev = 0, cus = 0, per_cu = 0;
        if (hipGetDevice(&dev) != hipSuccess || hipDeviceGetAttribute(&cus, hipDeviceAttributeMultiprocessorCount, dev) != hipSuccess) { grid = -1; return; }
        if (hipFuncSetAttribute((const void*)fwd, hipFuncAttributeMaxDynamicSharedMemorySize, LDS_BYTES) != hipSuccess) { fprintf(stderr, "kernel_launch: hipFuncSetAttribute failed\n"); grid = -1; return; }
        if (hipOccupancyMaxActiveBlocksPerMultiprocessor(&per_cu, (const void*)fwd, NWAVES * 64, LDS_BYTES) != hipSuccess || per_cu < 1) fprintf(stderr, "kernel_launch: occupancy query says %d\n", per_cu);
        (void)hipGetLastError();
        grid = cus;
    }
    if (grid < 0) return;
    if (hipMemsetAsync((char*)d_ws + WS_CTL, 0, CTL_ZERO_BYTES, stream) != hipSuccess) return;
    Args a{};
    for (int i = 0; i < 26; ++i) a.in[i] = (const float*)d_in[i];
    a.out = (float*)d_out; a.ws = (unsigned char*)d_ws;
#if MK_ONE_LAUNCH
    a.ph_lo = 0; a.ph_hi = NPH;
    hipLaunchKernelGGL(fwd, dim3(grid), dim3(NWAVES * 64), LDS_BYTES, stream, a);
#else
    for (int p = 0; p < NPH; ++p) { if (!phase_exists(p)) continue; a.ph_lo = p; a.ph_hi = p + 1; hipLaunchKernelGGL(fwd, dim3(grid), dim3(NWAVES * 64), LDS_BYTES, stream, a); }
#endif
}
```

```cpp
#include <hip/hip_runtime.h>
#include <cstdio>
#include <cstdint>

#ifndef ONLY
#define ONLY -1
#endif
#define PHON(x) (ONLY < 0 || ONLY == (x))
#ifndef PROBE_MASK
#define PROBE_MASK 0
#endif
#ifndef PROBE_SEAMSEL
#define PROBE_SEAMSEL 0xfff
#endif
#ifndef PROBE_BID
#define PROBE_BID 0
#endif
#ifndef PROBE_AMP
#define PROBE_AMP 4
#endif
#ifndef MK_ONE_LAUNCH
#define MK_ONE_LAUNCH 1
#endif

#define GAS __attribute__((address_space(1)))
#define LAS __attribute__((address_space(3)))
typedef unsigned short bf16;
typedef float f32x4 __attribute__((ext_vector_type(4)));
struct __attribute__((packed, aligned(4))) f32x3 { float x, y, z; };
typedef float f32x2 __attribute__((ext_vector_type(2)));
typedef short bf16x8 __attribute__((ext_vector_type(8)));
typedef unsigned u32x4 __attribute__((ext_vector_type(4)));
typedef unsigned u32x2 __attribute__((ext_vector_type(2)));
typedef short v4i16_t __attribute__((ext_vector_type(4)));

constexpr int D = 2048, NLAT = 8192, NCTX = 1024, NTOK = NLAT + NCTX, DEPTH = 4;
constexpr int LCAP = 9216;
constexpr float ALPHA = 1.681792830507429f;
constexpr float LN_EPS = 1e-5f, RMS_EPS = 1e-6f;
constexpr int MLIN = 6160;
constexpr int NWAVES = 8;

__device__ __forceinline__ unsigned f2bf(float f) { unsigned u = __builtin_bit_cast(unsigned, f); return (u + 0x7fffu + ((u >> 16) & 1u)) >> 16; }
typedef float f32x2_t __attribute__((ext_vector_type(2)));
typedef __bf16 bf16x2_t __attribute__((ext_vector_type(2)));
__device__ __forceinline__ unsigned pk2(float lo, float hi) { const f32x2_t v = {lo, hi}; const bf16x2_t b = __builtin_convertvector(v, bf16x2_t); return __builtin_bit_cast(unsigned, b); }
__device__ __forceinline__ float bf2f(unsigned short b) { return __builtin_bit_cast(float, ((unsigned)b) << 16); }
__device__ __forceinline__ float bflo(unsigned w) { return __builtin_bit_cast(float, w << 16); }
__device__ __forceinline__ float bfhi(unsigned w) { return __builtin_bit_cast(float, w & 0xffff0000u); }
__device__ __forceinline__ float sigm(float x) { return __builtin_amdgcn_rcpf(1.f + __expf(-x)); }
__device__ __forceinline__ float siluf(float x) { return x * sigm(x); }
__device__ __forceinline__ float gelu_tanh(float x) { return x * sigm(1.5957691216057308f * (x + 0.044715f * x * x * x)); }
template <int CTRL, int ROWMASK> __device__ __forceinline__ float dppz(float v, int zero) { return __builtin_bit_cast(float, __builtin_amdgcn_update_dpp(zero, __builtin_bit_cast(int, v), CTRL, ROWMASK, 0xf, false)); }
template <int CTRL, int ROWMASK> __device__ __forceinline__ float dpp0(float v) { return __builtin_bit_cast(float, __builtin_amdgcn_update_dpp(0, __builtin_bit_cast(int, v), CTRL, ROWMASK, 0xf, false)); }
__device__ __forceinline__ float wave_sum(float v) {
    v += dpp0<0x111, 0xf>(v); v += dpp0<0x112, 0xf>(v); v += dpp0<0x114, 0xf>(v); v += dpp0<0x118, 0xf>(v);
    v += dpp0<0x142, 0xa>(v); v += dpp0<0x143, 0xc>(v);
    return __builtin_bit_cast(float, __builtin_amdgcn_readlane(__builtin_bit_cast(int, v), 63));
}
__device__ __forceinline__ int permrow(int r) {
    if (r >= NLAT) return r; const int b = r & ~2047, s = r & 2047; return b + ((s & 63) << 5) + (s >> 6);
}
__device__ __forceinline__ int invpermrow(int r) {
    if (r >= NLAT) return r; const int b = r & ~2047, p = r & 2047; return b + ((p & 31) << 6) + (p >> 5);
}
__device__ __forceinline__ LAS unsigned char* vopq(LAS unsigned char* p) { asm volatile("" : "+v"(p)); return p; }
__device__ __forceinline__ int vopqi(int v) { asm volatile("" : "+v"(v)); return v; }
__device__ __forceinline__ int sopqi(int v) { asm volatile("" : "+s"(v)); return v; }
__device__ __forceinline__ int lane_id() { int l; asm volatile("v_mbcnt_lo_u32_b32 %0, -1, 0\n\tv_mbcnt_hi_u32_b32 %0, -1, %0" : "=v"(l)); return l; }
__device__ __forceinline__ float shfl_lane(float v, int src) { return __builtin_bit_cast(float, __builtin_amdgcn_ds_bpermute(src << 2, __builtin_bit_cast(int, v))); }
#define VM_WAIT() asm volatile("s_waitcnt vmcnt(0)" ::: "memory")
#define LDS_WAIT() asm volatile("s_waitcnt lgkmcnt(0)" ::: "memory")

namespace pg8 {
#define PG8_LAS __attribute__((address_space(3)))
constexpr int BM = 256, BK = 64, HALF = 128, HTB = HALF * BK * 2, STAGE_BYTES = 8 * HTB, NXCD = 8, WGM = 8;
__host__ __device__ __forceinline__ int lds_byte(int r, int c) { const int st = (r >> 4) * 2 + (c >> 5), rr = r & 15, cc = c & 31, ob = rr * 64 + cc * 2; return st * 1024 + (ob ^ (((ob >> 9) & 1) << 5)); }
__host__ __device__ __forceinline__ void stage_rc(int b, int& R, int& C) { const int st = b / 1024, sb = b % 1024, swz = sb ^ (((sb >> 9) & 1) << 5); R = (st >> 1) * 16 + swz / 64; C = (st & 1) * 32 + (swz % 64) / 2; }
__host__ __device__ __forceinline__ int perm32(int rho) { const int n = rho >> 4, i = rho & 15; return 8 * (i >> 2) + 4 * n + (i & 3); }

struct Unit { int pm, pn, e, rt, nv; };
struct Gemm { const bf16* A; const bf16* Bt; int K; size_t estride; const int* lst; };

struct StaticOrder {
    static constexpr bool SIGNAL = false;
    int nM, nN, nwg, G, c;
    __device__ void init(int M, int N, int G_, int c_) { nM = M / BM; nN = N / BM; nwg = nM * nN; G = G_; c = c_; }
    __device__ bool next(int i, Unit& u) const {
        const long L = (long)i * G + c; if (L >= nwg) return false;
        int wgid = (int)L; { const int q = nwg / NXCD, r = nwg % NXCD, xcd = wgid % NXCD, off = wgid / NXCD; wgid = (xcd < r ? xcd * (q + 1) : r * (q + 1) + (xcd - r) * q) + off; }
        const int nig = WGM * nN, gid = wgid / nig, fm = gid * WGM, gsz = (nM - fm) < WGM ? (nM - fm) : WGM;
        u.pm = __builtin_amdgcn_readfirstlane(fm + ((wgid % nig) % gsz)); u.pn = __builtin_amdgcn_readfirstlane((wgid % nig) / gsz); u.e = 0; u.rt = 0; u.nv = 256; return true;
    }
};
template <bool SIG> struct PlanOrderT {
    static constexpr bool SIGNAL = SIG;
    const PG8_LAS int* arr; int N, cs, W, sl, x, cpx; unsigned* done; PG8_LAS unsigned* wcnt;
    __device__ __forceinline__ bool next(int i, Unit& u) const {
        if (sl < 0) return false;
        const int li = sl + i * W; if (li >= cpx) return false;
        const int L = x * cpx + li; if (L >= N) return false;
        const int info = __builtin_amdgcn_readfirstlane(arr[L >> cs]);
        u.e = info & 15; u.rt = (info >> 4) & 127; u.nv = (info >> 11) & 511; u.pm = (info >> 20) & 127; u.pn = L & ((1 << cs) - 1); return true;
    }
    __device__ __forceinline__ int tile_at(int i) const {
        if (sl < 0) return -1;
        const int li = sl + i * W; if (li >= cpx) return -1;
        const int L = x * cpx + li; if (L >= N) return -1;
        return (arr[L >> cs] >> 20) & 127;
    }
    __device__ __forceinline__ void signal(const Unit& u, int ui, int lane) const {
        asm volatile("s_waitcnt vmcnt(0)" ::: "memory");
        if (lane == 0) {
            const unsigned old = __hip_atomic_fetch_add(wcnt, 1u, __ATOMIC_RELAXED, __HIP_MEMORY_SCOPE_WORKGROUP);
            if (old == 8u * (unsigned)ui + 7u) { __builtin_amdgcn_fence(__ATOMIC_RELEASE, "agent"); __hip_atomic_fetch_add(done + 16 * u.pm, 1u, __ATOMIC_RELAXED, __HIP_MEMORY_SCOPE_AGENT); }
        }
    }
};
using PlanOrder = PlanOrderT<false>; using PlanOrderSig = PlanOrderT<true>;
template <int AMODE> __device__ __forceinline__ void a_off(const Gemm& g, const Unit& u, int R0, int C0, int R1, int C1, unsigned (&h0)[2], unsigned (&h1)[2]) {
    const int K = g.K;
    if constexpr (AMODE == 0) {
        h0[0] = (unsigned)(R0 * K + C0) * 2u; h0[1] = (unsigned)(R1 * K + C1) * 2u;
        h1[0] = (unsigned)((R0 + HALF) * K + C0) * 2u; h1[1] = (unsigned)((R1 + HALF) * K + C1) * 2u;
    } else {
        const int* l = g.lst + u.e * LCAP + u.rt * 256;
        const int v00 = l[R0 < u.nv ? R0 : 0], v01 = l[R1 < u.nv ? R1 : 0], v10 = l[(R0 + HALF) < u.nv ? R0 + HALF : 0], v11 = l[(R1 + HALF) < u.nv ? R1 + HALF : 0];
        const int t00 = R0 < u.nv ? (v00 >> 1) : 0, t01 = R1 < u.nv ? (v01 >> 1) : 0;
        const int t10 = (R0 + HALF) < u.nv ? (v10 >> 1) : 0, t11 = (R1 + HALF) < u.nv ? (v11 >> 1) : 0;
        h0[0] = (unsigned)(t00 * K + C0) * 2u; h0[1] = (unsigned)(t01 * K + C1) * 2u;
        h1[0] = (unsigned)(t10 * K + C0) * 2u; h1[1] = (unsigned)(t11 * K + C1) * 2u;
    }
}

template <class Epi, class Sched, int AMODE>
__device__ __forceinline__ void gemm_phase(PG8_LAS unsigned char* lds, const Gemm g, const Sched& S, const Epi& E, int wave_id) {
    const int wid = sopqi(wave_id), lane = vopqi(lane_id()), tid = wid * 64 + lane, wr = wid >> 2, wc = wid & 3, fr = lane & 15, fq = lane >> 4;
    const int K = g.K, nt = K / BK;
    int R0, C0, R1, C1; stage_rc(tid * 16, R0, C0); stage_rc(tid * 16 + 8192, R1, C1);
    unsigned voffB[2];
    { const int Rb0 = Epi::PERM ? ((R0 & ~31) + perm32(R0 & 31)) : R0, Rb1 = Epi::PERM ? ((R1 & ~31) + perm32(R1 & 31)) : R1;
      voffB[0] = (unsigned)(Rb0 * K + C0) * 2u; voffB[1] = (unsigned)(Rb1 * K + C1) * 2u; }
    const size_t kstep = (size_t)(BK * 2);
    const size_t hstep = (size_t)HALF * K * 2;
    const size_t tstep = 2 * hstep;
    const unsigned ldsw = (unsigned)wid * 1024u;
    const int aoff = lds_byte(wr * 64 + fr, fq * 8), boff = lds_byte(wc * 32 + fr, fq * 8);
#define PG8_SA(b, h) (((b) * 2 + (h)) * HTB)
#define PG8_SB(b, h) ((4 + (b) * 2 + (h)) * HTB)
#define PG8_STAGE(bufoff, gbase, voff) do { _Pragma("unroll") for (int _i = 0; _i < 2; ++_i) \
        __builtin_amdgcn_global_load_lds((const unsigned*)((const char*)(gbase) + (voff)[_i]), (PG8_LAS unsigned*)(lds + (bufoff) + ldsw + _i * 8192), 16, 0, 0); } while (0)
#define PG8_LDA(dst, b, h) do { _Pragma("unroll") for (int m = 0; m < 4; ++m) _Pragma("unroll") for (int k = 0; k < 2; ++k) dst[m][k] = *(const PG8_LAS bf16x8*)(lds + PG8_SA(b, h) + aoff + m * 2048 + k * 1024); } while (0)
#define PG8_LDB(dst, b, h) do { _Pragma("unroll") for (int n = 0; n < 2; ++n) _Pragma("unroll") for (int k = 0; k < 2; ++k) dst[n][k] = *(const PG8_LAS bf16x8*)(lds + PG8_SB(b, h) + boff + n * 2048 + k * 1024); } while (0)
#define PG8_MMA(ai, bj, At, Bt) do { __builtin_amdgcn_s_setprio(1); _Pragma("unroll") for (int m = 0; m < 4; ++m) _Pragma("unroll") for (int n = 0; n < 2; ++n) _Pragma("unroll") for (int k = 0; k < 2; ++k) \
        acc[ai][bj][m][n] = __builtin_amdgcn_mfma_f32_16x16x32_bf16(Bt[n][k], At[m][k], acc[ai][bj][m][n], 0, 0, 0); __builtin_amdgcn_s_setprio(0); } while (0)
#define PG8_WAIT_V(n) asm volatile("s_waitcnt vmcnt(" #n ")" ::: "memory")
#define PG8_WAIT_L(n) asm volatile("s_waitcnt lgkmcnt(" #n ")" ::: "memory")
#define PG8_BAR __builtin_amdgcn_s_barrier()
#define PG8_SCHED __builtin_amdgcn_sched_barrier(0)
    Unit cur, nxt; int ui = 0;
    if (!S.next(0, cur)) return;
    f32x4 acc[2][2][4][2];
#pragma unroll
    for (int a = 0; a < 2; ++a)
#pragma unroll
        for (int b = 0; b < 2; ++b)
#pragma unroll
            for (int m = 0; m < 4; ++m)
#pragma unroll
                for (int n = 0; n < 2; ++n) acc[a][b][m][n] = (f32x4){0.f, 0.f, 0.f, 0.f};
    bf16x8 At[4][2], B0[2][2], B1[2][2];
    unsigned vh0[2], vh1[2];
    const char* cA = AMODE ? (const char*)g.A : (const char*)g.A + (size_t)cur.pm * tstep;
    const char* cB = (const char*)g.Bt + (size_t)cur.e * g.estride + (size_t)cur.pn * tstep;
    PG8_STAGE(PG8_SB(0, 0), cB, voffB); PG8_STAGE(PG8_SB(0, 1), cB + hstep, voffB);
    a_off<AMODE>(g, cur, R0, C0, R1, C1, vh0, vh1);
    PG8_STAGE(PG8_SA(0, 0), cA, vh0); PG8_STAGE(PG8_SA(0, 1), cA, vh1);
    if (wr == 1) PG8_BAR;
    PG8_WAIT_V(2); PG8_BAR;
    PG8_STAGE(PG8_SB(1, 0), cB + kstep, voffB); PG8_STAGE(PG8_SA(1, 0), cA + kstep, vh0); PG8_STAGE(PG8_SB(1, 1), cB + hstep + kstep, voffB);
    PG8_WAIT_V(6); PG8_BAR;
    for (;;) {
        const bool has_next = S.next(ui + 1, nxt);
        const char* nA = cA; const char* nB = cB;
        if (has_next) {
            nA = AMODE ? (const char*)g.A : (const char*)g.A + (size_t)nxt.pm * tstep;
            nB = (const char*)g.Bt + (size_t)nxt.e * g.estride + (size_t)nxt.pn * tstep;
            if constexpr (AMODE != 0) { if (tid < 256) { const int* l = g.lst + nxt.e * LCAP + nxt.rt * 256; const int tv = l[(unsigned)(tid < nxt.nv ? tid : 0)]; ((PG8_LAS unsigned*)(lds + STAGE_BYTES))[tid] = (unsigned)((tid < nxt.nv ? (tv >> 1) : 0) * K) * 2u; } }
        }
        for (int t = 0; t < nt; t += 2) {
            const bool last = (t == nt - 2);
            const char* a1 = cA + (size_t)(t + 1) * kstep;
            const char* a2 = last ? nA : cA + (size_t)(t + 2) * kstep; const char* b2 = last ? nB : cB + (size_t)(t + 2) * kstep;
            const char* a3 = a2 + kstep; const char* b3 = b2 + kstep;
            PG8_LDB(B0, 0, 0); PG8_LDB(B1, 0, 1); PG8_SCHED; PG8_LDA(At, 0, 0); PG8_STAGE(PG8_SA(1, 1), a1, vh1);
            if constexpr (AMODE != 0) { if (last && has_next) { const PG8_LAS unsigned* gt = (const PG8_LAS unsigned*)(lds + STAGE_BYTES);
                vh0[0] = gt[R0] + (unsigned)C0 * 2u; vh0[1] = gt[R1] + (unsigned)C1 * 2u; vh1[0] = gt[R0 + HALF] + (unsigned)C0 * 2u; vh1[1] = gt[R1 + HALF] + (unsigned)C1 * 2u; } }
            PG8_WAIT_V(8); PG8_WAIT_L(0); PG8_BAR; PG8_MMA(0, 0, At, B0); PG8_MMA(0, 1, At, B1); PG8_BAR; PG8_SCHED;
            PG8_LDA(At, 0, 1); PG8_STAGE(PG8_SB(0, 0), b2, voffB); PG8_STAGE(PG8_SB(0, 1), b2 + hstep, voffB); PG8_STAGE(PG8_SA(0, 0), a2, vh0);
            PG8_WAIT_V(8); PG8_WAIT_L(0); PG8_BAR; PG8_MMA(1, 0, At, B0); PG8_MMA(1, 1, At, B1); PG8_BAR; PG8_SCHED;
            PG8_LDB(B0, 1, 0); PG8_LDB(B1, 1, 1); PG8_SCHED; PG8_LDA(At, 1, 0); PG8_STAGE(PG8_SA(0, 1), a2, vh1);
            PG8_WAIT_V(8); PG8_WAIT_L(0); PG8_BAR; PG8_MMA(0, 0, At, B0); PG8_MMA(0, 1, At, B1); PG8_BAR; PG8_SCHED;
            PG8_LDA(At, 1, 1); PG8_STAGE(PG8_SB(1, 0), b3, voffB); PG8_STAGE(PG8_SB(1, 1), b3 + hstep, voffB); PG8_STAGE(PG8_SA(1, 0), a3, vh0);
            PG8_WAIT_V(8); PG8_WAIT_L(0); PG8_BAR; PG8_MMA(1, 0, At, B0); PG8_MMA(1, 1, At, B1); PG8_BAR; PG8_SCHED;
        }
        if (wr == 0) PG8_BAR;
        E(acc, cur, wr, wc, fr, fq);
        if constexpr (Sched::SIGNAL) S.signal(cur, ui, lane);
        if (!has_next) break;
#pragma unroll
        for (int a = 0; a < 2; ++a)
#pragma unroll
            for (int b = 0; b < 2; ++b)
#pragma unroll
                for (int m = 0; m < 4; ++m)
#pragma unroll
                    for (int n = 0; n < 2; ++n) acc[a][b][m][n] = (f32x4){0.f, 0.f, 0.f, 0.f};
        cur = nxt; cA = nA; cB = nB; ++ui;
        if (wr == 1) PG8_BAR;
    }
    PG8_WAIT_V(0);
    PG8_BAR;
#undef PG8_SA
#undef PG8_SB
#undef PG8_STAGE
#undef PG8_LDA
#undef PG8_LDB
#undef PG8_MMA
#undef PG8_WAIT_V
#undef PG8_WAIT_L
#undef PG8_BAR
#undef PG8_SCHED
}
}
using pg8::Unit;

constexpr size_t MiB = 1u << 20;
constexpr size_t WS_CTL = 0, CTL_ZERO_BYTES = 128 * 1024;
constexpr size_t WS_MOD = 1 * MiB;
constexpr size_t WS_VST = 2 * MiB;
constexpr size_t WS_G = 5 * MiB;
constexpr size_t WS_TOKL = 6 * MiB;
constexpr size_t WS_WL = 7 * MiB;
constexpr size_t WS_WSB = 8 * MiB;
constexpr size_t WS_GS = 9 * MiB;
constexpr size_t WS_WR = 10 * MiB;
constexpr size_t WS_RC = 13 * MiB;
constexpr size_t WS_RP = 552 * MiB;
constexpr size_t WS_WGIN = 16 * MiB;
constexpr size_t WS_WGOUT = 48 * MiB;
constexpr size_t WS_WMIN = 966 * MiB;
constexpr size_t WS_WMOUT = 112 * MiB;
constexpr size_t WS_WEGU = 128 * MiB;
constexpr size_t WS_WED = 384 * MiB;
constexpr size_t WS_X = 512 * MiB;
constexpr size_t WS_HT = 584 * MiB;
constexpr size_t WS_A1 = 620 * MiB;
constexpr size_t WS_A2 = 656 * MiB;
constexpr size_t WS_A3 = 692 * MiB;
constexpr size_t WS_A4 = 728 * MiB;
constexpr size_t WS_HSF = 764 * MiB;
constexpr size_t WS_HSB = 800 * MiB;
constexpr size_t WS_ZL = 836 * MiB;
constexpr size_t WS_HM = 872 * MiB;
constexpr size_t WS_YM = 894 * MiB;
constexpr size_t WS_END = 1018 * MiB;
constexpr int CW_BAR = 4096;
constexpr int CW_CNT = 16384;

struct EpiGA {
    static constexpr bool PERM = true;
    bf16* U; bf16* V; float* vst;
    __device__ __forceinline__ void operator()(const f32x4 (&acc)[2][2][4][2], const Unit& u, int wr, int wc, int fr, int fq) const {
        const bool isv = u.pn >= 8; bf16* base = isv ? V : U;
        const int col0 = (u.pn & 7) * 256 + wc * 32 + 8 * fq, row0 = u.pm * 256 + wr * 64 + fr;
#pragma unroll
        for (int ai = 0; ai < 2; ++ai)
#pragma unroll
            for (int m = 0; m < 4; ++m) {
                const int row = row0 + ai * 128 + m * 16; float s = 0.f, q = 0.f; bf16* rp = base + (size_t)row * D + col0;
#pragma unroll
                for (int bj = 0; bj < 2; ++bj) {
                    f32x4 a = acc[ai][bj][m][0], b = acc[ai][bj][m][1];
#pragma unroll
                    for (int j = 0; j < 4; ++j) { a[j] = gelu_tanh(a[j]); b[j] = gelu_tanh(b[j]); s += a[j] + b[j]; q += a[j] * a[j] + b[j] * b[j]; }
                    u32x4 w; w.x = pk2(a[0], a[1]); w.y = pk2(a[2], a[3]); w.z = pk2(b[0], b[1]); w.w = pk2(b[2], b[3]);
                    *(u32x4*)(rp + bj * 128) = w;
                }
                if (isv) { const int ln = 16 * fq + fr; s += shfl_lane(s, ln ^ 16); s += shfl_lane(s, ln ^ 32); q += shfl_lane(q, ln ^ 16); q += shfl_lane(q, ln ^ 32);
                    if (fq == 0) *(f32x2*)(vst + ((size_t)row * 32 + (u.pn - 8) * 4 + wc) * 2) = (f32x2){s, q}; }
            }
    }
};
struct EpiLA {
    static constexpr bool PERM = true;
    unsigned char* ws; const float* gate_b; int perm;
    __device__ __forceinline__ void operator()(const f32x4 (&acc)[2][2][4][2], const Unit& u, int wr, int wc, int fr, int fq) const {
        const int seg = u.pn >> 3, row0 = u.pm * 256 + wr * 64 + fr;
        if (seg == 3) {
            if (wc == 0 && fq < 2) { float* G = (float*)(ws + WS_G); const f32x4 b0 = *(const f32x4*)(gate_b + 8 * fq), b1 = *(const f32x4*)(gate_b + 8 * fq + 4);
#pragma unroll
                for (int ai = 0; ai < 2; ++ai)
#pragma unroll
                    for (int m = 0; m < 4; ++m) { const int row = row0 + ai * 128 + m * 16, drow = perm ? permrow(row) : row; float* gp = G + (size_t)drow * 16 + 8 * fq;
                        *(f32x4*)gp = acc[ai][0][m][0] + b0; *(f32x4*)(gp + 4) = acc[ai][0][m][1] + b1; } }
            return; }
        bf16* base = (bf16*)(ws + WS_A1 + (size_t)seg * (WS_A3 - WS_A1) - (seg == 2 ? (WS_A3 - WS_A1) - (WS_A4 - WS_A3) : 0));
        const int col0 = (u.pn & 7) * 256 + wc * 32 + 8 * fq;
#pragma unroll
        for (int ai = 0; ai < 2; ++ai)
#pragma unroll
            for (int m = 0; m < 4; ++m) {
                const int row = row0 + ai * 128 + m * 16, drow = perm ? permrow(row) : row; bf16* rp = base + (size_t)drow * D + col0;
#pragma unroll
                for (int bj = 0; bj < 2; ++bj) {
                    f32x4 a = acc[ai][bj][m][0], b = acc[ai][bj][m][1];
                    if (seg == 2) {
#pragma unroll
                        for (int j = 0; j < 4; ++j) { a[j] = sigm(a[j]); b[j] = sigm(b[j]); } }
                    u32x4 w; w.x = pk2(a[0], a[1]); w.y = pk2(a[2], a[3]); w.z = pk2(b[0], b[1]); w.w = pk2(b[2], b[3]);
                    *(u32x4*)(rp + bj * 128) = w;
                }
            }
    }
};
struct EpiRes {
    static constexpr bool PERM = true;
    bf16* X; const float* g1base; int unperm;
    const bf16* wr; float* rp;
    __device__ __forceinline__ void operator()(const f32x4 (&acc)[2][2][4][2], const Unit& u, int wr_, int wc, int fr, int fq) const {
        const int mi = u.pm < 32 ? (u.pm >> 3) : 4; const float* g1 = g1base + (size_t)mi * 12288;
        const int col0 = u.pn * 256 + wc * 32 + 8 * fq, row0 = u.pm * 256 + wr_ * 64 + fr;
        f32x4 gv[2][2]; bf16x8 bh[2], bl[2];
        const bf16* wb = wr + (size_t)(mi * 32 + fr) * D + col0;
#pragma unroll
        for (int bj = 0; bj < 2; ++bj) {
#pragma unroll
            for (int n = 0; n < 2; ++n) gv[bj][n] = *(const f32x4*)(g1 + col0 + bj * 128 + n * 4);
            bh[bj] = *(const bf16x8*)(wb + bj * 128); bl[bj] = *(const bf16x8*)(wb + 16 * D + bj * 128); }
        float* const pp = rp + (u.pn * 4 + wc) * 16 + fr;
        const bool pz = unperm && u.pm < 32;
        const int s1 = pz ? 1024 : 16, s2 = pz ? 1 : 32, s3 = pz ? 4 : 128;
        const int rbase = pz ? ((u.pm & ~7) * 256 + (fr << 6) + (u.pm & 7) * 8 + wr_ * 2) : row0;
        bf16* const xb = X + (unsigned)(rbase * D + col0);
        u32x4 xa[4][2], ob[4][2];
#define ER_LOAD(ai) _Pragma("unroll") for (int m = 0; m < 4; ++m) { const bf16* xp = xb + (unsigned)(((m & 1) * s1 + (m >> 1) * s2 + (ai) * s3) * D); \
            xa[m][0] = *(const u32x4*)xp; xa[m][1] = *(const u32x4*)(xp + 128); }
#define ER_COMP(ai) _Pragma("unroll") for (int m = 0; m < 4; ++m) _Pragma("unroll") for (int bj = 0; bj < 2; ++bj) { const u32x4 xin = xa[m][bj]; \
            const f32x4 a = (f32x4){bflo(xin.x), bfhi(xin.x), bflo(xin.y), bfhi(xin.y)} * ALPHA + gv[bj][0] * acc[ai][bj][m][0]; \
            const f32x4 b = (f32x4){bflo(xin.z), bfhi(xin.z), bflo(xin.w), bfhi(xin.w)} * ALPHA + gv[bj][1] * acc[ai][bj][m][1]; \
            u32x4 o; o.x = pk2(a[0], a[1]); o.y = pk2(a[2], a[3]); o.z = pk2(b[0], b[1]); o.w = pk2(b[2], b[3]); ob[m][bj] = o; }
#define ER_EMIT(ai) _Pragma("unroll") for (int m = 0; m < 4; ++m) { bf16* xp = xb + (unsigned)(((m & 1) * s1 + (m >> 1) * s2 + (ai) * s3) * D); \
            f32x4 pl = (f32x4){0.f, 0.f, 0.f, 0.f}; \
            _Pragma("unroll") for (int bj = 0; bj < 2; ++bj) { *(u32x4*)(xp + bj * 128) = ob[m][bj]; const bf16x8 af = __builtin_bit_cast(bf16x8, ob[m][bj]); \
                pl = __builtin_amdgcn_mfma_f32_16x16x32_bf16(af, bh[bj], pl, 0, 0, 0); pl = __builtin_amdgcn_mfma_f32_16x16x32_bf16(af, bl[bj], pl, 0, 0, 0); } \
            const int rb0 = u.pm * 256 + wr_ * 64 + (ai) * 128 + m * 16 + 4 * fq;       \
            _Pragma("unroll") for (int reg = 0; reg < 4; ++reg) pp[(unsigned)((rb0 + reg) * 512)] = pl[reg]; }
        ER_LOAD(0); ER_COMP(0); ER_LOAD(1); ER_EMIT(0); ER_COMP(1); ER_EMIT(1);
#undef ER_LOAD
#undef ER_COMP
#undef ER_EMIT
    }
};
struct EpiMoE1 {
    static constexpr bool PERM = true;
    bf16* Hm; const float* wl;
    __device__ __forceinline__ void operator()(const f32x4 (&acc)[2][2][4][2], const Unit& u, int wr, int wc, int fr, int fq) const {
        const int col0 = u.pn * 128 + wc * 32 + 8 * fq; const float* wp = wl + u.e * LCAP + u.rt * 256;
        float wv[2][4];
#pragma unroll
        for (int ai = 0; ai < 2; ++ai)
#pragma unroll
            for (int m = 0; m < 4; ++m) { const int rl = ai * 128 + wr * 64 + m * 16 + fr; wv[ai][m] = wp[rl < u.nv ? rl : 0]; }
#pragma unroll
        for (int ai = 0; ai < 2; ++ai)
#pragma unroll
            for (int m = 0; m < 4; ++m) {
                const int rl = ai * 128 + wr * 64 + m * 16 + fr;
                if (rl < u.nv) {
                    const float w = wv[ai][m]; f32x4 g0 = acc[ai][0][m][0], g1 = acc[ai][0][m][1]; const f32x4 u0 = acc[ai][1][m][0], u1 = acc[ai][1][m][1];
#pragma unroll
                    for (int j = 0; j < 4; ++j) { g0[j] = siluf(g0[j]) * u0[j] * w; g1[j] = siluf(g1[j]) * u1[j] * w; }
                    u32x4 o; o.x = pk2(g0[0], g0[1]); o.y = pk2(g0[2], g0[3]); o.z = pk2(g1[0], g1[1]); o.w = pk2(g1[2], g1[3]);
                    *(u32x4*)(Hm + (size_t)(u.pm * 256 + rl) * 512 + col0) = o;
                }
            }
    }
};
struct EpiMoE2 {
    static constexpr bool PERM = true;
    bf16* YM; const int* lst;
    __device__ __forceinline__ void operator()(const f32x4 (&acc)[2][2][4][2], const Unit& u, int wr, int wc, int fr, int fq) const {
        const int col0 = u.pn * 256 + wc * 32 + 8 * fq; const int* lp = lst + u.e * LCAP + u.rt * 256;
        int tkv[2][4];
#pragma unroll
        for (int ai = 0; ai < 2; ++ai)
#pragma unroll
            for (int m = 0; m < 4; ++m) { const int rl = ai * 128 + wr * 64 + m * 16 + fr; tkv[ai][m] = lp[rl < u.nv ? rl : 0]; }
#pragma unroll
        for (int ai = 0; ai < 2; ++ai)
#pragma unroll
            for (int m = 0; m < 4; ++m) {
                const int rl = ai * 128 + wr * 64 + m * 16 + fr;
                if (rl < u.nv) {
                    const int tk = tkv[ai][m]; bf16* rp = YM + (size_t)tk * D + col0;
#pragma unroll
                    for (int bj = 0; bj < 2; ++bj) { const f32x4 a = acc[ai][bj][m][0], b = acc[ai][bj][m][1];
                        u32x4 o; o.x = pk2(a[0], a[1]); o.y = pk2(a[2], a[3]); o.z = pk2(b[0], b[1]); o.w = pk2(b[2], b[3]);
                        *(u32x4*)(rp + bj * 128) = o; }
                }
            }
    }
};

constexpr int LDS_BYTES = 155648, MISC_OFF = LDS_BYTES - 512, PTAB_OFF = LDS_BYTES - 256;

#define XB_TMO      128
#define XB_XCNT(j)  (256  + 64 * (j))
#define XB_XSUB(j)  (1280 + 64 * (j))
#define XB_XGEN(j)  (2304 + 64 * (j))
#define XB_TOP      3328
#define XB_TOPGEN   3392
#define XCD_BAR_WORDS 3456
#define XB_SPIN_CAP (1u << 18)
__device__ __forceinline__ unsigned xb_ld(unsigned* p)              { return __hip_atomic_load(p, __ATOMIC_RELAXED, __HIP_MEMORY_SCOPE_AGENT); }
__device__ __forceinline__ unsigned xb_add(unsigned* p, unsigned v) { return __hip_atomic_fetch_add(p, v, __ATOMIC_RELAXED, __HIP_MEMORY_SCOPE_AGENT); }
__device__ __forceinline__ unsigned xb_xcc_id() { return (unsigned)__builtin_amdgcn_s_getreg((3 << 11) | 20) & 0xFu; }
#define XB_SPIN(cond, bar) do { unsigned _sp = 0; while (cond) { __builtin_amdgcn_s_sleep(1); \
    if ((++_sp & 255u) == 0u) { if (xb_ld(&(bar)[XB_TMO])) break; if (_sp > XB_SPIN_CAP) { atomicAdd(&(bar)[XB_TMO], 1u); break; } } } } while (0)
struct XcdBarrier { unsigned* bar; unsigned x; volatile LAS unsigned* st; };
__device__ __forceinline__ XcdBarrier xcd_barrier_post(unsigned* bar, volatile LAS unsigned* st, bool t0) {
    XcdBarrier b; b.bar = bar; b.x = xb_xcc_id(); b.st = st;
    if (t0) (void)xb_add(&bar[XB_XCNT(b.x)], 1u);
    return b;
}
__device__ __forceinline__ void xcd_barrier_complete(unsigned* bar, unsigned x, unsigned& nloc, unsigned& nx) {
    const unsigned G = gridDim.x * gridDim.y * gridDim.z;
    unsigned sum, cnt, mine, sp = 0u;
    for (;;) {
        sum = 0u; cnt = 0u; mine = 0u;
#pragma unroll
        for (unsigned j = 0; j < 16; ++j) { const unsigned c = xb_ld(&bar[XB_XCNT(j)]); sum += c; cnt += (c > 0u) ? 1u : 0u; mine = (j == x) ? c : mine; }
        if (sum == G) break;
        __builtin_amdgcn_s_sleep(1);
        if ((++sp & 255u) == 0u) { if (xb_ld(&bar[XB_TMO])) break; if (sp > XB_SPIN_CAP) { atomicAdd(&bar[XB_TMO], 1u); break; } }
    }
    nloc = mine > 0u ? mine : 1u; nx = cnt > 0u ? cnt : 1u;
}
__device__ __forceinline__ void xcd_barrier(const XcdBarrier& b, bool t0) {
    asm volatile("s_waitcnt vmcnt(0)" ::: "memory");
    __syncthreads();
    if (t0) {
        unsigned* bar = b.bar;
        __builtin_amdgcn_s_waitcnt(0);
        unsigned nloc = b.st[0], nx = b.st[1];
        if (nloc == 0u) { xcd_barrier_complete(bar, b.x, nloc, nx); b.st[0] = nloc; b.st[1] = nx; }
        const unsigned old = xb_add(&bar[XB_XSUB(b.x)], 1u);
        const unsigned gen = old / nloc;
        if (old + 1u == (gen + 1u) * nloc) {
            __builtin_amdgcn_fence(__ATOMIC_RELEASE, "agent");
            asm volatile("s_waitcnt vmcnt(0)" ::: "memory");
            asm volatile("buffer_inv sc1" ::: "memory");
            const unsigned og = xb_add(&bar[XB_TOP], 1u);
            const unsigned tg = og / nx;
            if (og + 1u == (tg + 1u) * nx) xb_add(&bar[XB_TOPGEN], 1u);
            else XB_SPIN(xb_ld(&bar[XB_TOPGEN]) == tg, bar);
            xb_add(&bar[XB_XGEN(b.x)], 1u);
            asm volatile("s_waitcnt vmcnt(0)" ::: "memory");
        } else {
            asm volatile("buffer_inv sc1" ::: "memory");
            XB_SPIN(xb_ld(&bar[XB_XGEN(b.x)]) == gen, bar);
            asm volatile("s_waitcnt vmcnt(0)" ::: "memory");
        }
    }
    __syncthreads();
}

struct Args { const float* in[26]; float* out; unsigned char* ws; int ph_lo, ph_hi; };
struct Frame {
    LAS unsigned char* lds; int tid, lane, wave, G, bid;
    unsigned char* ws; float* out;
};
__device__ __forceinline__ const float* inp(const Frame& F, int i) {
    const LAS unsigned* t = (const LAS unsigned*)(F.lds + PTAB_OFF) + 2 * i;
    const unsigned lo = (unsigned)__builtin_amdgcn_readfirstlane((int)t[0]), hi = (unsigned)__builtin_amdgcn_readfirstlane((int)t[1]);
    return (const float*)(const GAS float*)(((unsigned long long)hi << 32) | lo);
}
__device__ __forceinline__ unsigned char* opq(unsigned char* p) { GAS unsigned char* g = (GAS unsigned char*)p; asm volatile("" : "+s"(g)); return (unsigned char*)g; }

enum { I_X = 0, I_C, I_CTX, I_CCTX, I_ADAW, I_ADAB, I_GMWIN, I_GMLNG, I_GMLNB, I_GMWS, I_GMBS, I_GMWOUT, I_MLWIN, I_MLCONV, I_MLGB, I_MLNG, I_MLWOUT,
       I_LN1G, I_LN1B, I_LN2G, I_LN2B, I_RW, I_RB, I_EXG, I_EXU, I_EXD };

__device__ __forceinline__ void p0_transpose_item(const float* W, int ldw, int Kout, bf16* WT, int out_row0, LAS float* scr, int k0, int n0, int lane) {
#pragma unroll 8
    for (int i = 0; i < 32; ++i) { const int kk = 2 * i + (lane >> 5); scr[kk * 33 + (lane & 31)] = W[(size_t)(k0 + kk) * ldw + n0 + (lane & 31)]; }
    LDS_WAIT(); asm volatile("" ::: "memory");
    const int c = lane & 7;
#pragma unroll
    for (int j = 0; j < 4; ++j) { const int n = (lane >> 3) + 8 * j; const LAS float* s = scr + (8 * c) * 33 + n;
        u32x4 o; o.x = pk2(s[0 * 33], s[1 * 33]); o.y = pk2(s[2 * 33], s[3 * 33]); o.z = pk2(s[4 * 33], s[5 * 33]); o.w = pk2(s[6 * 33], s[7 * 33]);
        *(u32x4*)(WT + (size_t)(out_row0 + n) * Kout + k0 + 8 * c) = o; }
    LDS_WAIT(); asm volatile("" ::: "memory");
}
constexpr int CV_B0 = 0, CV_B1 = 30720, CV_B2 = 63488, CV_B3 = 94208, CV_END = 126976;
constexpr int CV_GA0 = 4096, CV_GC0 = 18096, CV_M0 = 35096, CV_LA1 = 43696, CV_LC1 = 52696, CV_M1 = 69696, CV_GA2 = 78296, CV_GC2 = 92296, CV_M2 = 109296, CV_LA3 = 117896, CV_P0B = 126976;
struct CvItem { const float* src; bf16* dst; int ldw, kout; };
__device__ __forceinline__ CvItem cv_decode(const Frame& F, unsigned char* ws, int seq) {
    const int blk = seq >= CV_B3 ? 3 : (seq >= CV_B2 ? 2 : (seq >= CV_B1 ? 1 : 0)), idx = blk >> 1;
    int r = seq - (blk == 3 ? CV_B3 : (blk == 2 ? CV_B2 : (blk == 1 ? CV_B1 : 0)));
    const int n_in = (blk & 1) ? 6144 : 4096;
    const float* W; bf16* WT; int ldw, kout, orow, k0, n0;
    if (r < n_in) {
        if (blk & 1) { W = inp(F, I_MLWIN) + (size_t)idx * D * MLIN; ldw = MLIN; kout = D; WT = (bf16*)(ws + WS_WMIN) + (size_t)idx * 6400 * D; n0 = (r % 192) * 32; k0 = (r / 192) * 64; orow = n0; }
        else { W = inp(F, I_GMWIN) + (size_t)idx * D * 4096; ldw = 4096; kout = D; WT = (bf16*)(ws + WS_WGIN) + (size_t)idx * 4096 * D; n0 = (r & 127) * 32; k0 = (r >> 7) * 64; orow = n0; }
    } else if (r < n_in + 2048) { r -= n_in; W = inp(F, (blk & 1) ? I_MLWOUT : I_GMWOUT) + (size_t)idx * D * D; ldw = D; kout = D; WT = (bf16*)(ws + ((blk & 1) ? WS_WMOUT : WS_WGOUT)) + (size_t)idx * D * D; n0 = (r & 63) * 32; k0 = (r >> 6) * 64; orow = n0;
    } else { r -= n_in + 2048; const int which = r >> 13, rr = r & 8191, le = blk * 16 + (rr >> 9), q = rr & 511;
        if (which < 2) { n0 = (q & 15) * 32; k0 = (q >> 4) * 64; W = inp(F, which ? I_EXU : I_EXG) + (size_t)le * D * 512; ldw = 512; kout = D; WT = (bf16*)(ws + WS_WEGU) + (size_t)le * 1024 * D; orow = (n0 >> 7) * 256 + (n0 & 127) + which * 128; }
        else { n0 = (q & 63) * 32; k0 = (q >> 6) * 64; W = inp(F, I_EXD) + (size_t)le * 512 * D; ldw = D; kout = 512; WT = (bf16*)(ws + WS_WED) + (size_t)le * D * 512; orow = n0; } }
    CvItem it; it.src = W + (size_t)k0 * ldw + n0; it.dst = WT + (size_t)orow * kout + k0; it.ldw = ldw; it.kout = kout; return it;
}
__device__ __forceinline__ void cv_load(const CvItem& it, int lane, float (&v)[32]) {
    const float* p = it.src + (unsigned)((lane >> 5) * it.ldw + (lane & 31));
#pragma unroll
    for (int i = 0; i < 32; ++i) v[i] = __builtin_nontemporal_load(p + (unsigned)(2 * i * it.ldw));
}
__device__ __forceinline__ void cv_store(const CvItem& it, int lane, LAS float* scr, const float (&v)[32]) {
#pragma unroll
    for (int i = 0; i < 32; ++i) scr[(2 * i + (lane >> 5)) * 33 + (lane & 31)] = v[i];
    LDS_WAIT(); asm volatile("" ::: "memory");
    const int c = lane & 7;
#pragma unroll
    for (int j = 0; j < 4; ++j) { const int n = (lane >> 3) + 8 * j; const LAS float* s = scr + (8 * c) * 33 + n;
        u32x4 o; o.x = pk2(s[0 * 33], s[1 * 33]); o.y = pk2(s[2 * 33], s[3 * 33]); o.z = pk2(s[4 * 33], s[5 * 33]); o.w = pk2(s[6 * 33], s[7 * 33]);
        __builtin_nontemporal_store(o, (u32x4*)(it.dst + (unsigned)(n * it.kout + 8 * c))); }
    LDS_WAIT(); asm volatile("" ::: "memory");
}
template <class SeqFn> __device__ __forceinline__ void convert_items(const Frame& F0, int n, int rank, int nranks, SeqFn seqf) {
    Frame F = F0; F.wave = sopqi(F0.wave); F.lane = vopqi(lane_id());
    unsigned char* const ws = opq(F.ws);
    LAS float* scr = (LAS float*)(F.lds + F.wave * 8448);
    int i = rank * NWAVES + F.wave; const int step = nranks * NWAVES;
    if (i >= n) return;
    float cur[32], nxt[32]; CvItem ic = cv_decode(F, ws, seqf(i)), in_ = ic; cv_load(ic, F.lane, cur);
#pragma unroll 1
    for (; i < n; i += step) {
        const bool more = i + step < n;
        if (more) { in_ = cv_decode(F, ws, seqf(i + step)); cv_load(in_, F.lane, nxt); }
        cv_store(ic, F.lane, scr, cur);
        if (more) { ic = in_;
#pragma unroll
            for (int k = 0; k < 32; ++k) cur[k] = nxt[k]; }
    }
}
struct SeqRange { int lo; __device__ int operator()(int i) const { return lo + i; } };
struct SeqP0 { __device__ int operator()(int i) const { return i < CV_GA0 ? i : CV_P0B + (i - CV_GA0); } };
__device__ __forceinline__ void convert_range(const Frame& F, int lo, int hi, int rank, int nranks) { convert_items(F, hi - lo, rank, nranks, SeqRange{lo}); }
__device__ __forceinline__ void tail_convert(const Frame& F, int nunits, int lo, int hi) {
    const int rem = nunits % F.G;
    if (rem == 0) convert_range(F, lo, hi, F.bid, F.G);
    else if (F.bid >= rem) convert_range(F, lo, hi, F.bid - rem, F.G - rem);
}
__device__ __forceinline__ void p0_prologue(const Frame& F0) {
    Frame F = F0; F.wave = sopqi(F0.wave); F.lane = vopqi(lane_id()); F.tid = F.wave * 64 + F.lane; F.bid = sopqi(F0.bid);
    unsigned char* const ws = opq(F.ws);
    LAS float* cs = (LAS float*)F.lds;
    LAS float* red = (LAS float*)(F.lds + 65536);
    { const float* pc = inp(F, I_C); const float* pcc = inp(F, I_CCTX);
    for (int i = F.tid; i < 2048 * 8; i += 512) { const int k = i >> 3, j = i & 7; float v = 0.f;
        if (j < 4) v = siluf(pc[j * D + k]); else if (j == 4) v = siluf(pcc[k]); cs[i] = v; } }
    const float* adaw = inp(F, I_ADAW); const float* adab = inp(F, I_ADAB);
    __syncthreads();
    for (int u = F.bid; u < 256; u += F.G) {
        const int l = u >> 6, n0 = (u & 63) * 192;
        const float* W = adaw + (size_t)l * D * 12288 + n0 + 3 * F.lane;
        float acc[5][3];
#pragma unroll
        for (int j = 0; j < 5; ++j) { acc[j][0] = 0.f; acc[j][1] = 0.f; acc[j][2] = 0.f; }
        const int kb = F.wave * 256;
        for (int k0 = 0; k0 < 256; k0 += 8) {
            f32x3 w[8];
#pragma unroll
            for (int i = 0; i < 8; ++i) { const float* wp_ = W + (size_t)(kb + k0 + i) * 12288; w[i].x = __builtin_nontemporal_load(wp_); w[i].y = __builtin_nontemporal_load(wp_ + 1); w[i].z = __builtin_nontemporal_load(wp_ + 2); }
#pragma unroll
            for (int i = 0; i < 8; ++i) { const f32x4 c0 = *(const LAS f32x4*)(cs + (kb + k0 + i) * 8); const float c4 = cs[(kb + k0 + i) * 8 + 4];
                acc[0][0] += c0.x * w[i].x; acc[0][1] += c0.x * w[i].y; acc[0][2] += c0.x * w[i].z;
                acc[1][0] += c0.y * w[i].x; acc[1][1] += c0.y * w[i].y; acc[1][2] += c0.y * w[i].z;
                acc[2][0] += c0.z * w[i].x; acc[2][1] += c0.z * w[i].y; acc[2][2] += c0.z * w[i].z;
                acc[3][0] += c0.w * w[i].x; acc[3][1] += c0.w * w[i].y; acc[3][2] += c0.w * w[i].z;
                acc[4][0] += c4 * w[i].x;   acc[4][1] += c4 * w[i].y;   acc[4][2] += c4 * w[i].z; }
        }
#pragma unroll
        for (int j = 0; j < 5; ++j)
#pragma unroll
            for (int c = 0; c < 3; ++c) red[(F.wave * 64 + F.lane) * 15 + j * 3 + c] = acc[j][c];
        __syncthreads();
        for (int idx = F.tid; idx < 960; idx += 512) { const int ln = idx / 15, q = idx % 15, j = q / 3, cc = q % 3; float s = 0.f;
#pragma unroll
            for (int w = 0; w < 8; ++w) s += red[(w * 64 + ln) * 15 + q];
            const int n = n0 + 3 * ln + cc; ((float*)(ws + WS_MOD))[(size_t)(l * 5 + j) * 12288 + n] = s + adab[l * 12288 + n]; }
        __syncthreads();
    }
    __syncthreads();
    convert_items(F, CV_GA0 + (CV_END - CV_P0B), F.bid, F.G, SeqP0{});
    const float* p_mlwin = inp(F, I_MLWIN);
    for (int i = F.bid * 512 + F.tid; i < 2 * 256 * 2048; i += F.G * 512) { const int l = i >> 19, rr = (i >> 11) & 255, k = i & 2047;
        ((bf16*)(ws + WS_WMIN))[(size_t)(l * 6400 + 6144 + rr) * D + k] = (bf16)(rr < 16 ? f2bf(p_mlwin[(size_t)l * D * MLIN + (size_t)k * MLIN + 6144 + rr]) : 0u); }
    { const float* src = inp(F, I_GMWS); bf16* dst = (bf16*)(ws + WS_WSB);
      for (int i = F.bid * 512 + F.tid; i < 2 * 8 * 128 * 128 / 2; i += F.G * 512) ((unsigned*)dst)[i] = pk2(src[2 * i], src[2 * i + 1]); }
}

__device__ __forceinline__ const float* modp(unsigned char* ws, int l, int mi, int chunk) { return (const float*)(ws + WS_MOD) + ((size_t)(l * 5 + mi) * 6 + chunk) * D; }
__device__ __forceinline__ void load_row(const float* p, int lane, f32x4 (&v)[8]) {
    const f32x4* q = (const f32x4*)p + lane;
#pragma unroll
    for (int j = 0; j < 8; ++j) v[j] = q[64 * j];
}
__device__ __forceinline__ void load_row_bf16(const bf16* p, int lane, f32x4 (&v)[8]) {
    const u32x2* q = (const u32x2*)p + lane;
#pragma unroll
    for (int j = 0; j < 8; ++j) { const u32x2 w = q[64 * j]; v[j] = (f32x4){bflo(w.x), bfhi(w.x), bflo(w.y), bfhi(w.y)}; }
}
__device__ __forceinline__ void load_row_raw(const bf16* p, int lane, u32x2 (&r)[8]) {
    const u32x2* q = (const u32x2*)p + lane;
#pragma unroll
    for (int j = 0; j < 8; ++j) r[j] = q[64 * j];
}
__device__ __forceinline__ void cvt_row(const u32x2 (&r)[8], f32x4 (&v)[8]) {
#pragma unroll
    for (int j = 0; j < 8; ++j) v[j] = (f32x4){bflo(r[j].x), bfhi(r[j].x), bflo(r[j].y), bfhi(r[j].y)};
}
__device__ __forceinline__ void store_row(float* p, int lane, const f32x4 (&v)[8]) {
    f32x4* q = (f32x4*)p + lane;
#pragma unroll
    for (int j = 0; j < 8; ++j) q[64 * j] = v[j];
}
__device__ __forceinline__ void store_row_bf16(bf16* p, int lane, const f32x4 (&v)[8]) {
    u32x2* q = (u32x2*)p + lane;
#pragma unroll
    for (int j = 0; j < 8; ++j) { u32x2 o; o.x = pk2(v[j].x, v[j].y); o.y = pk2(v[j].z, v[j].w); q[64 * j] = o; }
}
__device__ __forceinline__ void layer_norm_row(f32x4 (&v)[8], const float* g, const float* b, int lane) {
    float s = 0.f;
#pragma unroll
    for (int j = 0; j < 8; ++j) s += (v[j].x + v[j].y) + (v[j].z + v[j].w);
    const float mean = wave_sum(s) * (1.f / D); float q = 0.f;
#pragma unroll
    for (int j = 0; j < 8; ++j) { v[j] = v[j] - mean; q += (v[j].x * v[j].x + v[j].y * v[j].y) + (v[j].z * v[j].z + v[j].w * v[j].w); }
    const float rstd = 1.f / sqrtf(wave_sum(q) * (1.f / D) + LN_EPS);
    const f32x4* gp = (const f32x4*)g + lane; const f32x4* bp = (const f32x4*)b + lane;
#pragma unroll
    for (int j = 0; j < 8; ++j) v[j] = v[j] * rstd * gp[64 * j] + bp[64 * j];
}
__device__ __forceinline__ void modulate_row(f32x4 (&v)[8], const float* sc, const float* sh, int lane) {
    const f32x4* cp = (const f32x4*)sc + lane; const f32x4* hp = (const f32x4*)sh + lane;
#pragma unroll
    for (int j = 0; j < 8; ++j) v[j] = v[j] * (cp[64 * j] + 1.0f) + hp[64 * j];
}
__device__ __forceinline__ int mod_index(int r) { return r < NLAT ? (r >> 11) : 4; }

__device__ __forceinline__ void p1_modulate0(const Frame& F0) {
    Frame F = F0; F.wave = sopqi(F0.wave); F.lane = vopqi(lane_id()); F.tid = F.wave * 64 + F.lane; F.bid = sopqi(F0.bid);
    unsigned char* const ws = opq(F.ws);
    const int gw = F.bid * NWAVES + F.wave, NGW = F.G * NWAVES;
    const float* xl = inp(F, I_X); const float* xc = inp(F, I_CTX);
#pragma unroll 1
    for (int sg = gw; sg < 2048 + 1024; sg += NGW) {
        const int row0 = sg < 2048 ? 4 * sg : NLAT + (sg - 2048), nrows = sg < 2048 ? 4 : 1;
        const int mi = mod_index(row0);
        f32x4 sc[8], sh[8], nx[8];
        { const f32x4* cp = (const f32x4*)modp(ws, 0, mi, 1) + F.lane; const f32x4* hp = (const f32x4*)modp(ws, 0, mi, 0) + F.lane;
#pragma unroll
          for (int j = 0; j < 8; ++j) { sc[j] = cp[64 * j] + 1.0f; sh[j] = hp[64 * j]; } }
        load_row(row0 < NLAT ? xl + (size_t)row0 * D : xc + (size_t)(row0 - NLAT) * D, F.lane, nx);
#pragma unroll 1
        for (int rr = 0; rr < nrows; ++rr) {
            const int r = row0 + rr;
            f32x4 v[8];
#pragma unroll
            for (int j = 0; j < 8; ++j) v[j] = nx[j];
            if (rr + 1 < nrows) load_row(xl + (size_t)(r + 1) * D, F.lane, nx);
            store_row_bf16((bf16*)(ws + WS_X) + (size_t)r * D, F.lane, v);
#pragma unroll
            for (int j = 0; j < 8; ++j) v[j] = v[j] * sc[j] + sh[j];
            store_row_bf16((bf16*)(ws + WS_HT) + (size_t)r * D, F.lane, v); }
    }
    { const float* rw = inp(F, I_RW); float* rc = (float*)(ws + WS_RC);
#pragma unroll 1
      for (int t = gw; t < DEPTH * 5 * 16 * 8; t += NGW) {
          const int j = t & 7, e = (t >> 3) & 15, lm = t >> 7, l = lm / 5;
          const int k = 256 * j + 4 * F.lane;
          const f32x4 gg = *(const f32x4*)(inp(F, I_LN1G) + l * D + k), bb = *(const f32x4*)(inp(F, I_LN1B) + l * D + k);
          const f32x4 s4 = *(const f32x4*)((const float*)(ws + WS_MOD) + ((size_t)lm * 6 + 4) * D + k) + 1.0f, h4 = *(const f32x4*)((const float*)(ws + WS_MOD) + ((size_t)lm * 6 + 3) * D + k);
          float r4[4];
#pragma unroll
          for (int i = 0; i < 4; ++i) r4[i] = rw[(k + i) * 16 + e];
          unsigned hi[4], lo[4]; float c1 = 0.f, c2 = 0.f;
#pragma unroll
          for (int i = 0; i < 4; ++i) { const float w = gg[i] * s4[i] * r4[i]; hi[i] = f2bf(w); lo[i] = f2bf(w - bf2f((unsigned short)hi[i]));
              c1 += bf2f((unsigned short)hi[i]) + bf2f((unsigned short)lo[i]); c2 += (bb[i] * s4[i] + h4[i]) * r4[i]; }
          bf16* whi = (bf16*)(ws + WS_WR) + (size_t)(lm * 32 + e) * D + k;
          *(u32x2*)whi = (u32x2){hi[0] | (hi[1] << 16), hi[2] | (hi[3] << 16)}; *(u32x2*)(whi + 16 * D) = (u32x2){lo[0] | (lo[1] << 16), lo[2] | (lo[3] << 16)};
          c1 = wave_sum(c1); c2 = wave_sum(c2);
          if (F.lane == 0) { rc[((lm * 2 + 0) * 8 + j) * 16 + e] = c1; rc[((lm * 2 + 1) * 8 + j) * 16 + e] = c2; } } }
}
__device__ __forceinline__ void ln1_phase(const Frame& F0, int layer, int Mrows) {
    Frame F = F0; F.wave = sopqi(F0.wave); F.lane = vopqi(lane_id()); F.tid = F.wave * 64 + F.lane; F.bid = sopqi(F0.bid);
    unsigned char* const ws = opq(F.ws);
    LAS float* lgl = (LAS float*)(F.lds + 131072); LAS float* lbl = (LAS float*)(F.lds + 139264);
    LAS unsigned* cntl = (LAS unsigned*)(F.lds + 147456 + 64); LAS unsigned* basel = cntl + 16;
    LAS int* rinfo = (LAS int*)(F.lds + 147456 + 256) + F.wave * 64;
    { const f32x4 a = ((const f32x4*)(inp(F, I_LN1G) + layer * D))[F.tid], b = ((const f32x4*)(inp(F, I_LN1B) + layer * D))[F.tid]; ((LAS f32x4*)lgl)[F.tid] = a; ((LAS f32x4*)lbl)[F.tid] = b; }
    if (F.tid < 16) cntl[F.tid] = 0u;
    LAS float* rcl = (LAS float*)(F.lds + 150016);
    if (F.tid < 160) { const int mi = F.tid >> 5, which = (F.tid >> 4) & 1, e = F.tid & 15; const float* p = (const float*)(ws + WS_RC) + ((layer * 5 + mi) * 2 + which) * 128 + e;
        float a = which ? inp(F, I_RB)[e] : 0.f; float pv[8];
#pragma unroll
        for (int j = 0; j < 8; ++j) pv[j] = p[j * 16];
        asm volatile("" : "+v"(pv[0]), "+v"(pv[1]), "+v"(pv[2]), "+v"(pv[3]), "+v"(pv[4]), "+v"(pv[5]), "+v"(pv[6]), "+v"(pv[7]));
#pragma unroll
        for (int j = 0; j < 8; ++j) a += pv[j];
        rcl[F.tid] = a; }
    __syncthreads();
    const int gw = F.bid * NWAVES + F.wave, NGW = F.G * NWAVES;
    bf16* X = (bf16*)(ws + WS_X); bf16* T = (bf16*)(ws + WS_HT);
    const float* RP = (const float*)(ws + WS_RP) + (F.lane & 31) * 16 + (F.lane >> 5) * 8;
    int nr = 0; const int perm = (layer & 1) ? ((layer >> 1) & 1) : 0;
#pragma unroll 1
    for (int sg = gw; sg < 2048 + 1024; sg += NGW) {
        const int row0 = sg < 2048 ? 4 * sg : NLAT + (sg - 2048), nrows = sg < 2048 ? 4 : 1;
        if (row0 >= Mrows) break;
        const int mi = mod_index(row0);
        f32x4 sc[8], sh[8];
        { const f32x4* cp = (const f32x4*)modp(ws, layer, mi, 4) + F.lane; const f32x4* hp = (const f32x4*)modp(ws, layer, mi, 3) + F.lane;
#pragma unroll
          for (int j = 0; j < 8; ++j) { sc[j] = cp[64 * j] + 1.0f; sh[j] = hp[64 * j]; } }
        const LAS float* rcp = rcl + mi * 32;
        u32x2 nx[8]; load_row_raw(X + (size_t)row0 * D, F.lane, nx);
        f32x4 pa = *(const f32x4*)(RP + (size_t)(perm ? permrow(row0) : row0) * 512), pb = *(const f32x4*)(RP + (size_t)(perm ? permrow(row0) : row0) * 512 + 4);
#pragma unroll 1
        for (int rr = 0; rr < nrows; ++rr) {
            const int r = row0 + rr;
            f32x4 v[8]; cvt_row(nx, v);
            float sp[8] = {pa.x, pa.y, pa.z, pa.w, pb.x, pb.y, pb.z, pb.w};
            if (rr + 1 < nrows) { load_row_raw(X + (size_t)(r + 1) * D, F.lane, nx); const int pr = perm ? permrow(r + 1) : r + 1; pa = *(const f32x4*)(RP + (size_t)pr * 512); pb = *(const f32x4*)(RP + (size_t)pr * 512 + 4); }
            float s = 0.f;
#pragma unroll
            for (int j = 0; j < 8; ++j) s += (v[j].x + v[j].y) + (v[j].z + v[j].w);
            const float mean = wave_sum(s) * (1.f / D); float q = 0.f;
#pragma unroll
            for (int j = 0; j < 8; ++j) { v[j] = v[j] - mean; q += (v[j].x * v[j].x + v[j].y * v[j].y) + (v[j].z * v[j].z + v[j].w * v[j].w); }
            const float rstd = 1.f / sqrtf(wave_sum(q) * (1.f / D) + LN_EPS);
            u32x2* xo = (u32x2*)(X + (size_t)r * D) + F.lane; u32x2* to = (u32x2*)(T + (size_t)r * D) + F.lane;
#pragma unroll
            for (int j = 0; j < 8; ++j) { const f32x4 g = *(const LAS f32x4*)(lgl + 256 * j + 4 * F.lane), b = *(const LAS f32x4*)(lbl + 256 * j + 4 * F.lane);
                const f32x4 xn = v[j] * rstd * g + b; { u32x2 ox; ox.x = pk2(xn.x, xn.y); ox.y = pk2(xn.z, xn.w); xo[64 * j] = ox; } v[j] = xn * sc[j] + sh[j];
                u32x2 o; o.x = pk2(v[j].x, v[j].y); o.y = pk2(v[j].z, v[j].w); to[64 * j] = o; }
            { const int zr = vopqi(0);
#pragma unroll
              for (int e = 0; e < 8; ++e) sp[e] += dppz<0x111, 0xf>(sp[e], zr);
#pragma unroll
              for (int e = 0; e < 8; ++e) sp[e] += dppz<0x112, 0xf>(sp[e], zr);
#pragma unroll
              for (int e = 0; e < 8; ++e) sp[e] += dppz<0x114, 0xf>(sp[e], zr);
#pragma unroll
              for (int e = 0; e < 8; ++e) sp[e] += dppz<0x118, 0xf>(sp[e], zr);
#pragma unroll
              for (int e = 0; e < 8; ++e) sp[e] += dppz<0x142, 0xa>(sp[e], zr); }
            float lg[16];
#pragma unroll
            for (int e = 0; e < 8; ++e) { lg[e] = __builtin_bit_cast(float, __builtin_amdgcn_readlane(__builtin_bit_cast(int, sp[e]), 31)); lg[e + 8] = __builtin_bit_cast(float, __builtin_amdgcn_readlane(__builtin_bit_cast(int, sp[e]), 63)); }
            float mx = -3.0e38f;
#pragma unroll
            for (int e = 0; e < 16; ++e) { lg[e] = rstd * (lg[e] - mean * rcp[e]) + rcp[16 + e]; mx = fmaxf(mx, lg[e]); }
#pragma unroll
            for (int e = 0; e < 16; ++e) lg[e] = __expf(lg[e] - mx);
            float best = -1.f; int gs = 0;
#pragma unroll
            for (int g = 0; g < 4; ++g) { const float a = lg[4 * g], b = lg[4 * g + 1], c = lg[4 * g + 2], d = lg[4 * g + 3];
                const float h1 = fmaxf(a, b), l1 = fminf(a, b), h2 = fmaxf(c, d), l2 = fminf(c, d);
                const float scr = fmaxf(h1, h2) + fmaxf(fminf(h1, h2), fmaxf(l1, l2)); if (scr > best) { best = scr; gs = g; } }
            float q0 = 0.f, q1 = 0.f, q2 = 0.f, q3 = 0.f;
#pragma unroll
            for (int g = 0; g < 4; ++g) if (g == gs) { q0 = lg[4 * g]; q1 = lg[4 * g + 1]; q2 = lg[4 * g + 2]; q3 = lg[4 * g + 3]; }
            int i1 = 0; float p1 = q0; if (q1 > p1) { p1 = q1; i1 = 1; } if (q2 > p1) { p1 = q2; i1 = 2; } if (q3 > p1) { p1 = q3; i1 = 3; }
            int i2 = 0; float p2 = -1.f;
            if (i1 != 0 && q0 > p2) { p2 = q0; i2 = 0; } if (i1 != 1 && q1 > p2) { p2 = q1; i2 = 1; } if (i1 != 2 && q2 > p2) { p2 = q2; i2 = 2; } if (i1 != 3 && q3 > p2) { p2 = q3; i2 = 3; }
            const float inv = 1.f / (p1 + p2);
            if (F.lane == 0 && nr < 10) { const int e0 = 4 * gs + i1, e1 = 4 * gs + i2;
                rinfo[nr * 6 + 0] = e0; rinfo[nr * 6 + 1] = e1;
                rinfo[nr * 6 + 2] = (int)atomicAdd((unsigned*)&cntl[e0], 1u); rinfo[nr * 6 + 3] = (int)atomicAdd((unsigned*)&cntl[e1], 1u);
                rinfo[nr * 6 + 4] = __builtin_bit_cast(int, p1 * inv); rinfo[nr * 6 + 5] = __builtin_bit_cast(int, p2 * inv); }
            ++nr;
        }
    }
    __syncthreads();
    unsigned* gcnt = (unsigned*)(ws + WS_CTL) + CW_CNT + layer * 1024;
    if (F.tid < 16) { const unsigned c = cntl[F.tid]; basel[F.tid] = c ? __hip_atomic_fetch_add(gcnt + 64 * F.tid, c, __ATOMIC_RELAXED, __HIP_MEMORY_SCOPE_AGENT) : 0u; }
    __syncthreads();
    int* tokl = (int*)(ws + WS_TOKL); float* wl = (float*)(ws + WS_WL);
    if (F.lane == 0) {
        int k = 0;
        for (int sg = gw; sg < 2048 + 1024; sg += NGW) {
            const int row0 = sg < 2048 ? 4 * sg : NLAT + (sg - 2048), nrows = sg < 2048 ? 4 : 1;
            if (row0 >= Mrows) break;
            for (int rr = 0; rr < nrows; ++rr, ++k) { if (k >= 10) break;
                const int r = row0 + rr, e0 = rinfo[k * 6 + 0], e1 = rinfo[k * 6 + 1];
                const int p0 = (int)basel[e0] + rinfo[k * 6 + 2], p1 = (int)basel[e1] + rinfo[k * 6 + 3];
                tokl[e0 * LCAP + p0] = r * 2; wl[e0 * LCAP + p0] = __builtin_bit_cast(float, rinfo[k * 6 + 4]);
                tokl[e1 * LCAP + p1] = r * 2 + 1; wl[e1 * LCAP + p1] = __builtin_bit_cast(float, rinfo[k * 6 + 5]); }
        }
    }
}
__device__ __forceinline__ void ln2_phase(const Frame& F0, int layer, int Mrows) {
    Frame F = F0; F.wave = sopqi(F0.wave); F.lane = vopqi(lane_id()); F.tid = F.wave * 64 + F.lane; F.bid = sopqi(F0.bid);
    unsigned char* const ws = opq(F.ws);
    const bool last = layer == DEPTH - 1; const int nl = last ? layer : layer + 1;
    LAS float* lgl = (LAS float*)F.lds; LAS float* lbl = lgl + 2048; LAS float* vec = lgl + 4096;
    bf16* X = (bf16*)(ws + WS_X); const bf16* YM = (const bf16*)(ws + WS_YM); bf16* H = (bf16*)(ws + WS_HT); float* const outp = F.out;
    const float* lng = inp(F, I_LN2G) + layer * D; const float* lnb = inp(F, I_LN2B) + layer * D;
#pragma unroll 1
    for (int vb = F.bid; vb < 256; vb += F.G) {
        __syncthreads();
        { const int mil = vb >> 6;
          f32x4 tv[8]; tv[0] = ((const f32x4*)lng)[F.tid]; tv[1] = ((const f32x4*)lnb)[F.tid];
#pragma unroll
          for (int kind = 0; kind < 2; ++kind) { const int mi = kind ? 4 : mil;
              tv[2 + 3 * kind] = ((const f32x4*)modp(ws, layer, mi, 5))[F.tid]; tv[3 + 3 * kind] = ((const f32x4*)modp(ws, nl, mi, 1))[F.tid]; tv[4 + 3 * kind] = ((const f32x4*)modp(ws, nl, mi, 0))[F.tid]; }
          asm volatile("" : "+v"(tv[0]), "+v"(tv[1]), "+v"(tv[2]), "+v"(tv[3]), "+v"(tv[4]), "+v"(tv[5]), "+v"(tv[6]), "+v"(tv[7]));
          ((LAS f32x4*)lgl)[F.tid] = tv[0]; ((LAS f32x4*)lbl)[F.tid] = tv[1];
#pragma unroll
          for (int kind = 0; kind < 2; ++kind) { LAS f32x4* d = (LAS f32x4*)(vec + kind * 6144);
              d[F.tid] = tv[2 + 3 * kind]; d[512 + F.tid] = tv[3 + 3 * kind] + 1.0f; d[1024 + F.tid] = tv[4 + 3 * kind]; } }
        __syncthreads();
        const int gwv = vb * NWAVES + F.wave;
#pragma unroll 1
        for (int kind = 0; kind < 2; ++kind) {
            const int row0 = kind ? NLAT + gwv : 4 * gwv, nrows = kind ? 1 : 4;
            if (kind && (gwv >= 1024 || row0 >= Mrows)) break;
            const LAS float* vg = vec + kind * 6144;
            u32x2 nx[8], na[8], nb[8];
            { load_row_raw(X + (size_t)row0 * D, F.lane, nx);
              const u32x2* y0 = (const u32x2*)(YM + (size_t)(2 * row0) * D) + F.lane; const u32x2* y1 = (const u32x2*)(YM + (size_t)(2 * row0 + 1) * D) + F.lane;
#pragma unroll
              for (int j = 0; j < 8; ++j) { na[j] = y0[64 * j]; nb[j] = y1[64 * j]; } }
#pragma unroll 1
            for (int rr = 0; rr < nrows; ++rr) {
                const int r = row0 + rr;
                f32x4 v[8];
#pragma unroll
                for (int j = 0; j < 8; ++j) { const u32x2 a = na[j], b = nb[j]; const f32x4 g2 = *(const LAS f32x4*)(vg + 256 * j + 4 * F.lane);
                    const f32x4 y = (f32x4){bflo(a.x) + bflo(b.x), bfhi(a.x) + bfhi(b.x), bflo(a.y) + bflo(b.y), bfhi(a.y) + bfhi(b.y)};
                    v[j] = (f32x4){bflo(nx[j].x), bfhi(nx[j].x), bflo(nx[j].y), bfhi(nx[j].y)} * ALPHA + g2 * y; }
                if (rr + 1 < nrows) { const int rn = r + 1; load_row_raw(X + (size_t)rn * D, F.lane, nx);
                    const u32x2* y0 = (const u32x2*)(YM + (size_t)(2 * rn) * D) + F.lane; const u32x2* y1 = (const u32x2*)(YM + (size_t)(2 * rn + 1) * D) + F.lane;
#pragma unroll
                    for (int j = 0; j < 8; ++j) { na[j] = y0[64 * j]; nb[j] = y1[64 * j]; } }
                float s = 0.f;
#pragma unroll
                for (int j = 0; j < 8; ++j) s += (v[j].x + v[j].y) + (v[j].z + v[j].w);
                const float mean = wave_sum(s) * (1.f / D); float q = 0.f;
#pragma unroll
                for (int j = 0; j < 8; ++j) { v[j] = v[j] - mean; q += (v[j].x * v[j].x + v[j].y * v[j].y) + (v[j].z * v[j].z + v[j].w * v[j].w); }
                const float rstd = 1.f / sqrtf(wave_sum(q) * (1.f / D) + LN_EPS);
                if (last) { f32x4* oo = (f32x4*)(outp + (size_t)r * D) + F.lane;
#pragma unroll
                    for (int j = 0; j < 8; ++j) { const f32x4 g = *(const LAS f32x4*)(lgl + 256 * j + 4 * F.lane), b = *(const LAS f32x4*)(lbl + 256 * j + 4 * F.lane); oo[64 * j] = v[j] * rstd * g + b; }
                } else { u32x2* xo = (u32x2*)(X + (size_t)r * D) + F.lane; u32x2* ho = (u32x2*)(H + (size_t)r * D) + F.lane;
#pragma unroll
                    for (int j = 0; j < 8; ++j) { const f32x4 g = *(const LAS f32x4*)(lgl + 256 * j + 4 * F.lane), b = *(const LAS f32x4*)(lbl + 256 * j + 4 * F.lane);
                        const f32x4 xn = v[j] * rstd * g + b; { u32x2 ox; ox.x = pk2(xn.x, xn.y); ox.y = pk2(xn.z, xn.w); xo[64 * j] = ox; }
                        const f32x4 hh = xn * *(const LAS f32x4*)(vg + 2048 + 256 * j + 4 * F.lane) + *(const LAS f32x4*)(vg + 4096 + 256 * j + 4 * F.lane);
                        u32x2 o; o.x = pk2(hh.x, hh.y); o.y = pk2(hh.z, hh.w); ho[64 * j] = o; } }
            }
        }
    }
}
__device__ __forceinline__ float wave_incl_sum(float v, int lane) {
#pragma unroll
    for (int o = 1; o < 64; o <<= 1) { const float t = shfl_lane(v, lane >= o ? lane - o : lane); if (lane >= o) v += t; }
    return v;
}
__device__ __forceinline__ float wave_incl_max(float v, int lane) {
#pragma unroll
    for (int o = 1; o < 64; o <<= 1) { const float t = shfl_lane(v, lane >= o ? lane - o : lane); if (lane >= o) v = fmaxf(v, t); }
    return v;
}
__device__ __forceinline__ float log_sigmoid(float x) { return fminf(x, 0.f) - log1pf(__expf(-fabsf(x))); }
__device__ __forceinline__ void conv_phase(const Frame& F0, int idx) {
    Frame F = F0; F.wave = sopqi(F0.wave); F.lane = vopqi(lane_id()); F.tid = F.wave * 64 + F.lane; F.bid = sopqi(F0.bid);
    unsigned char* const ws = opq(F.ws);
    const bf16* P = (const bf16*)(ws + WS_A1); bf16* Q = (bf16*)(ws + WS_A2); const float* cw = inp(F, I_MLCONV) + (size_t)idx * 3 * D;
    for (int it = F.bid * 512 + F.tid; it < (NTOK / 8) * 256; it += F.G * 512) {
        const int cg = it & 255, r0 = (it >> 8) * 8, c0 = cg * 8;
        const int seqlen = r0 < NLAT ? 2048 : 256, p0 = r0 < NLAT ? (r0 & 2047) : ((r0 - NLAT) & 255);
        float w0[8], w1[8], w2[8];
        { const f32x4 a0 = *(const f32x4*)(cw + c0), a1 = *(const f32x4*)(cw + c0 + 4), b0 = *(const f32x4*)(cw + D + c0), b1 = *(const f32x4*)(cw + D + c0 + 4), d0 = *(const f32x4*)(cw + 2 * D + c0), d1 = *(const f32x4*)(cw + 2 * D + c0 + 4);
#pragma unroll
          for (int j = 0; j < 4; ++j) { w0[j] = a0[j]; w0[4 + j] = a1[j]; w1[j] = b0[j]; w1[4 + j] = b1[j]; w2[j] = d0[j]; w2[4 + j] = d1[j]; } }
        const float ksc = c0 >= 1024 ? 0.0625f : 1.0f;
        u32x4 rows[10];
        rows[0] = (u32x4){0u, 0u, 0u, 0u}; rows[9] = (u32x4){0u, 0u, 0u, 0u};
        if (p0 > 0) rows[0] = *(const u32x4*)(P + (size_t)(r0 - 1) * D + c0);
#pragma unroll
        for (int i = 0; i < 8; ++i) rows[i + 1] = *(const u32x4*)(P + (size_t)(r0 + i) * D + c0);
        if (p0 + 8 < seqlen) rows[9] = *(const u32x4*)(P + (size_t)(r0 + 8) * D + c0);
#pragma unroll
        for (int i = 0; i < 8; ++i) {
            const u32x4 prev = rows[i], curv = rows[i + 1], nxtv = rows[i + 2];
            float o[8];
#pragma unroll
            for (int j = 0; j < 4; ++j) {
                const float a0 = bflo(prev[j]), a1 = bfhi(prev[j]), b0 = bflo(curv[j]), b1 = bfhi(curv[j]), d0 = bflo(nxtv[j]), d1 = bfhi(nxtv[j]);
                o[2 * j] = siluf(w0[2 * j] * a0 + w1[2 * j] * b0 + w2[2 * j] * d0) * ksc;
                o[2 * j + 1] = siluf(w0[2 * j + 1] * a1 + w1[2 * j + 1] * b1 + w2[2 * j + 1] * d1) * ksc; }
            u32x4 ov; ov.x = pk2(o[0], o[1]); ov.y = pk2(o[2], o[3]); ov.z = pk2(o[4], o[5]); ov.w = pk2(o[6], o[7]);
            *(u32x4*)(Q + (size_t)(r0 + i) * D + c0) = ov;
        }
    }
    { const float* G = (const float*)(ws + WS_G); float* GS = (float*)(ws + WS_GS);
      for (int task = F.bid * NWAVES + F.wave; task < 72 * 8; task += F.G * NWAVES) {
        const int dir = task & 1, h = (task >> 1) & 3, base = (task >> 3) * 128, j0 = 2 * F.lane;
        const int ra = base + (dir ? 127 - j0 : j0), rb = base + (dir ? 126 - j0 : j0 + 1);
        const float i0 = G[ra * 16 + dir * 8 + h], f0 = log_sigmoid(G[ra * 16 + dir * 8 + 4 + h]), i1 = G[rb * 16 + dir * 8 + h], f1 = log_sigmoid(G[rb * 16 + dir * 8 + 4 + h]);
        const float incl = wave_incl_sum(f0 + f1, F.lane), b1 = incl, b0 = incl - f1;
        const float u0 = i0 - b0, u1 = i1 - b1;
        const float pin = wave_incl_max(fmaxf(u0, u1), F.lane); float pex = shfl_lane(pin, F.lane > 0 ? F.lane - 1 : 0); if (F.lane == 0) pex = -3.0e38f;
        float* o = GS + (size_t)task * 384 + j0;
        *(f32x2*)o = (f32x2){u0, u1}; *(f32x2*)(o + 128) = (f32x2){fmaxf(pex, u0), pin}; *(f32x2*)(o + 256) = (f32x2){b0, b1};
      } }
}
__device__ __forceinline__ void comb_phase(const Frame& F0, int idx, int Mrows) {
    Frame F = F0; F.wave = sopqi(F0.wave); F.lane = vopqi(lane_id()); F.tid = F.wave * 64 + F.lane; F.bid = sopqi(F0.bid);
    unsigned char* const ws = opq(F.ws);
    const bf16* HF = (const bf16*)(ws + WS_HSF); const bf16* HB = (const bf16*)(ws + WS_HSB); const bf16* PO = (const bf16*)(ws + WS_A4); bf16* ZL = (bf16*)(ws + WS_ZL);
    f32x4 ngv[8];
    { const f32x4* ng = (const f32x4*)(inp(F, I_MLNG) + (size_t)idx * D) + F.lane;
#pragma unroll
      for (int j = 0; j < 8; ++j) ngv[j] = ng[64 * j]; }
    const int gw = F.bid * NWAVES + F.wave, NGW = F.G * NWAVES;
    u32x2 pa[8], pb[8], pc[8];
    if (gw < Mrows) { const u32x2* hf = (const u32x2*)(HF + (size_t)gw * D) + F.lane; const u32x2* hb = (const u32x2*)(HB + (size_t)gw * D) + F.lane; const u32x2* po = (const u32x2*)(PO + (size_t)gw * D) + F.lane;
#pragma unroll
        for (int j = 0; j < 8; ++j) { pa[j] = hf[64 * j]; pb[j] = hb[64 * j]; pc[j] = po[64 * j]; } }
#pragma unroll 1
    for (int r = gw; r < Mrows; r += NGW) {
        f32x4 v[8]; u32x2 po[8];
#pragma unroll
        for (int j = 0; j < 8; ++j) { const u32x2 a = pa[j], b = pb[j]; po[j] = pc[j]; v[j] = (f32x4){bflo(a.x) + bflo(b.x), bfhi(a.x) + bfhi(b.x), bflo(a.y) + bflo(b.y), bfhi(a.y) + bfhi(b.y)}; }
        const int rn = r + NGW;
        if (rn < Mrows) { const u32x2* hf = (const u32x2*)(HF + (size_t)rn * D) + F.lane; const u32x2* hb = (const u32x2*)(HB + (size_t)rn * D) + F.lane; const u32x2* pq = (const u32x2*)(PO + (size_t)rn * D) + F.lane;
#pragma unroll
            for (int j = 0; j < 8; ++j) { pa[j] = hf[64 * j]; pb[j] = hb[64 * j]; pc[j] = pq[64 * j]; } }
#pragma unroll
        for (int h = 0; h < 4; ++h) { float q = 0.f;
#pragma unroll
            for (int jj = 0; jj < 2; ++jj) { const f32x4 x = v[2 * h + jj]; q += (x.x * x.x + x.y * x.y) + (x.z * x.z + x.w * x.w); }
            const float rs = 1.f / sqrtf(wave_sum(q) * (1.f / 512.f) + RMS_EPS);
#pragma unroll
            for (int jj = 0; jj < 2; ++jj) { const int j = 2 * h + jj; const u32x2 o = po[j]; const f32x4 sg = (f32x4){bflo(o.x), bfhi(o.x), bflo(o.y), bfhi(o.y)}; v[j] = v[j] * rs * ngv[j] * sg; } }
        store_row_bf16(ZL + (size_t)r * D, F.lane, v);
    }
}
__device__ __forceinline__ void gate_phase(const Frame& F0, int idx) {
    Frame F = F0; F.wave = sopqi(F0.wave); F.lane = vopqi(lane_id()); F.tid = F.wave * 64 + F.lane; F.bid = sopqi(F0.bid);
    unsigned char* const ws = opq(F.ws);
    constexpr int VT_STRIDE = 272, SS_STRIDE = 132, VT_OFF = 0, SS_OFF = 34816;
    const bf16* U = (const bf16*)(ws + WS_A1); const bf16* V = (const bf16*)(ws + WS_A2); bf16* Z = (bf16*)(ws + WS_A3);
    const float* vst = (const float*)(ws + WS_VST); const bf16* Wsb = (const bf16*)(ws + WS_WSB) + (size_t)idx * 8 * 128 * 128;
    const float* lg = inp(F, I_GMLNG) + (size_t)idx * D; const float* lb = inp(F, I_GMLNB) + (size_t)idx * D; const float* bs = inp(F, I_GMBS) + (size_t)idx * 8 * 128;
    const int fr = F.lane & 15, fq = F.lane >> 4, w = F.wave;
    LAS float* lgl = (LAS float*)(F.lds + 106496); LAS float* lbl = lgl + 2048;
    { const f32x4 ga_ = ((const f32x4*)lg)[F.tid], gb_ = ((const f32x4*)lb)[F.tid]; ((LAS f32x4*)lgl)[F.tid] = ga_; ((LAS f32x4*)lbl)[F.tid] = gb_; }
    u32x4 xvn[4], uvn[4]; f32x4 stn[4];
#define GB_PREFETCH(unx) do { const int n_ = (unx) >> 4, jb_ = (unx) & 15, R0_ = n_ * 128, C0_ = jb_ * 128, q_ = F.tid >> 2, seg_ = F.tid & 3; \
        const float* sp_ = vst + (unsigned)((R0_ + q_) * 64 + seg_ * 16); const bf16* vp_ = V + (unsigned)((R0_ + q_) * D + C0_ + seg_ * 32); \
        const bf16* up_ = U + (unsigned)((R0_ + 16 * w + (F.lane >> 2)) * D + C0_ + (F.lane & 3) * 32); \
        _Pragma("unroll") for (int i = 0; i < 4; ++i) { stn[i] = *(const f32x4*)(sp_ + 4 * i); xvn[i] = *(const u32x4*)(vp_ + 8 * i); uvn[i] = *(const u32x4*)(up_ + 8 * i); } } while (0)
    if (F.bid < 72 * 16) GB_PREFETCH(F.bid);
    bf16x8 af[4] = {}; float bsv[4] = {0.f, 0.f, 0.f, 0.f}; int gcur = -1;
    for (int un = F.bid; un < 72 * 16; un += F.G) {
        const int n = un >> 4, jb = un & 15, g = jb >> 1, R0 = n * 128, C0 = jb * 128;
        __syncthreads();
        u32x4 uv[4];
        {
            const int q = F.tid >> 2, seg = F.tid & 3;
            float s = 0.f, ss = 0.f;
#pragma unroll
            for (int i = 0; i < 4; ++i) { s += stn[i].x + stn[i].z; ss += stn[i].y + stn[i].w; uv[i] = uvn[i]; }
            s += dpp0<0xB1, 0xf>(s); ss += dpp0<0xB1, 0xf>(ss); s += dpp0<0x4E, 0xf>(s); ss += dpp0<0x4E, 0xf>(ss);
            const float mean = s * (1.f / D), rstd = 1.f / sqrtf(ss * (1.f / D) - mean * mean + LN_EPS);
#pragma unroll
            for (int i = 0; i < 4; ++i) { const u32x4 x = xvn[i]; const int c = seg * 32 + 8 * i;
                const f32x4 ga = *(const LAS f32x4*)(lgl + C0 + c), gb = *(const LAS f32x4*)(lgl + C0 + c + 4), ba = *(const LAS f32x4*)(lbl + C0 + c), bb_ = *(const LAS f32x4*)(lbl + C0 + c + 4);
#pragma unroll
                for (int j = 0; j < 4; ++j) { const f32x4 gg = (j >> 1) ? gb : ga, bb = (j >> 1) ? bb_ : ba;
                    const float a = (bflo(x[j]) - mean) * rstd * gg[2 * (j & 1)] + bb[2 * (j & 1)], b = (bfhi(x[j]) - mean) * rstd * gg[2 * (j & 1) + 1] + bb[2 * (j & 1) + 1];
                    *(LAS bf16*)(F.lds + VT_OFF + (c + 2 * j) * VT_STRIDE + q * 2) = (bf16)f2bf(a); *(LAS bf16*)(F.lds + VT_OFF + (c + 2 * j + 1) * VT_STRIDE + q * 2) = (bf16)f2bf(b); } }
        }
        if (un + F.G < 72 * 16) GB_PREFETCH(un + F.G);
        if (g != gcur) { gcur = g;
#pragma unroll
            for (int ks = 0; ks < 4; ++ks) af[ks] = *(const bf16x8*)(Wsb + ((size_t)g * 128 + 16 * w + fr) * 128 + 32 * ks + 8 * fq);
#pragma unroll
            for (int reg = 0; reg < 4; ++reg) bsv[reg] = bs[g * 128 + 16 * w + 4 * fq + reg]; }
        __syncthreads();
        f32x4 acc[8];
#pragma unroll
        for (int nt = 0; nt < 8; ++nt) { acc[nt] = (f32x4){0.f, 0.f, 0.f, 0.f};
#pragma unroll
            for (int ks = 0; ks < 4; ++ks) { const bf16x8 bfr = *(const LAS bf16x8*)(F.lds + VT_OFF + (16 * nt + fr) * VT_STRIDE + (32 * ks + 8 * fq) * 2);
                acc[nt] = __builtin_amdgcn_mfma_f32_16x16x32_bf16(af[ks], bfr, acc[nt], 0, 0, 0); } }
        LAS float* SS = (LAS float*)(F.lds + SS_OFF);
#pragma unroll
        for (int reg = 0; reg < 4; ++reg) { const int p = 16 * w + 4 * fq + reg; const float b = bsv[reg];
#pragma unroll
            for (int nt = 0; nt < 8; ++nt) SS[p * SS_STRIDE + 16 * nt + fr] = acc[nt][reg] + b; }
        LDS_WAIT(); asm volatile("" ::: "memory");
        {
            const int p = 16 * w + (F.lane >> 2), seg = F.lane & 3; bf16* zp = Z + (size_t)(R0 + p) * D + C0 + seg * 32;
#pragma unroll
            for (int i = 0; i < 4; ++i) { const u32x4 x = uv[i]; const LAS float* sp = SS + p * SS_STRIDE + seg * 32 + 8 * i;
                const f32x4 s0 = *(const LAS f32x4*)sp, s1 = *(const LAS f32x4*)(sp + 4);
                u32x4 o; o.x = pk2(bflo(x.x) * s0.x, bfhi(x.x) * s0.y); o.y = pk2(bflo(x.y) * s0.z, bfhi(x.y) * s0.w); o.z = pk2(bflo(x.z) * s1.x, bfhi(x.z) * s1.y); o.w = pk2(bflo(x.w) * s1.z, bfhi(x.w) * s1.w);
                *(u32x4*)(zp + 8 * i) = o; }
        }
    }
}
__device__ __forceinline__ void scan_phase(const Frame& F0, int write_ctx, unsigned long long& pacc) {
    unsigned long long spt = 0ull; (void)spt;
#define SPB() do { if (PROBE_MASK >> 16) spt = __builtin_amdgcn_s_memrealtime(); } while (0)
#define SPE(k) do { if ((PROBE_MASK >> (16 + (k))) & 1) pacc += __builtin_amdgcn_s_memrealtime() - spt; } while (0)
    Frame F = F0; F.wave = sopqi(F0.wave); F.lane = vopqi(lane_id()); F.tid = F.wave * 64 + F.lane; F.bid = sopqi(F0.bid);
    unsigned char* const ws = opq(F.ws);
    constexpr int KS_OFF = 0, KS_STRIDE = 528, VT_OFF = 67584, VT_STRIDE = 272, R1_OFF = 89344, CT_STRIDE = 528, SP_STRIDE = 272, GU_OFF = 131584, HST_OFF = 135680;
    static_assert(HST_OFF + 8 * 16 * 144 <= MISC_OFF, "scan LDS map");
    const bf16* QK = (const bf16*)(ws + WS_A2); const bf16* PV = (const bf16*)(ws + WS_A3); const float* GS = (const float*)(ws + WS_GS);
    const int w = F.wave, tid0 = F.tid;
#define IDS const int tid = vopqi(tid0), lane = tid & 63, fr = lane & 15, fq = lane >> 4; (void)tid; (void)lane; (void)fr; (void)fq
    const int tau = w < 4 ? w : 11 - w;
    for (int uid = F.bid; uid < 256; uid += F.G) {
        const int sl = uid & 7, dir = (uid >> 3) & 1, h = (uid >> 4) & 3, b = uid >> 6;
        bf16* HS = (bf16*)(ws + (dir ? WS_HSB : WS_HSF));
        __syncthreads();
        { IDS;
        for (int i = tid; i < 16 * 128; i += 512) { const int e = 64 + (i >> 7), s = i & 127; *(LAS bf16*)(F.lds + VT_OFF + e * VT_STRIDE + s * 2) = (bf16)(e == 64 ? 0x3f80u : 0u); }
        for (int i = tid; i < 80 * 128; i += 512) { const int e = i >> 7, d4 = i & 127; *(LAS unsigned*)(F.lds + R1_OFF + e * CT_STRIDE + d4 * 4) = 0u; } }
        f32x4 Cst[2][5];
#pragma unroll
        for (int mt = 0; mt < 2; ++mt)
#pragma unroll
            for (int nt = 0; nt < 5; ++nt) Cst[mt][nt] = (f32x4){0.f, 0.f, 0.f, 0.f};
        float m_prev = 0.f;
#define CHUNK_BASE(ci) ((ci) < 2 ? (NLAT + b * 256 + (dir ? 1 - (ci) : (ci)) * 128) : (b * 2048 + (dir ? 17 - (ci) : (ci) - 2) * 128))
#define ROW_OF(base, j) ((base) + (dir ? 127 - (j) : (j)))
        u32x4 kpre[8], vpre[2]; float gi = 0.f, gf = 0.f, gb_ = 0.f; bf16x8 Qf[8];
        {   IDS; const int base = CHUNK_BASE(0);
#pragma unroll
            for (int i = 0; i < 8; ++i) { const int p = tid + 512 * i, j = p >> 5, c16 = p & 31; kpre[i] = *(const u32x4*)(QK + (unsigned)(ROW_OF(base, j) * D + 1024 + h * 256 + c16 * 8)); }
#pragma unroll
            for (int i = 0; i < 2; ++i) { const int p = tid + 512 * i, j = p >> 3, e8 = p & 7; vpre[i] = *(const u32x4*)(PV + (unsigned)(ROW_OF(base, j) * D + h * 512 + sl * 64 + e8 * 8)); }
            if (tid < 128) { const float* gp = GS + (unsigned)((((base >> 7) * 4 + h) * 2 + dir) * 384 + tid); gi = gp[0]; gf = gp[128]; gb_ = gp[256]; }
#pragma unroll
            for (int ks = 0; ks < 8; ++ks) Qf[ks] = *(const bf16x8*)(QK + (unsigned)(ROW_OF(base, 16 * tau + fr) * D + h * 256 + 32 * ks + 8 * fq));
        }
        for (int ci = 0; ci < 18; ++ci) {
            const int base = CHUNK_BASE(ci);
            SPB();
            { IDS; LAS unsigned char* const L = vopq(F.lds);
#pragma unroll
            for (int i = 0; i < 8; ++i) { const int p = tid + 512 * i, j = p >> 5, c16 = p & 31; *(LAS u32x4*)(L + KS_OFF + j * KS_STRIDE + c16 * 16) = kpre[i]; }
#pragma unroll
            for (int i = 0; i < 2; ++i) { const int p = tid + 512 * i, j = p >> 3, e8 = p & 7;
#pragma unroll
                for (int q = 0; q < 4; ++q) { *(LAS bf16*)(L + VT_OFF + (e8 * 8 + 2 * q) * VT_STRIDE + j * 2) = (bf16)(vpre[i][q] & 0xffffu); *(LAS bf16*)(L + VT_OFF + (e8 * 8 + 2 * q + 1) * VT_STRIDE + j * 2) = (bf16)(vpre[i][q] >> 16); } }
            if (tid < 128) { LAS float* tt = (LAS float*)(L + GU_OFF); tt[tid] = gi; tt[512 + tid] = gf; tt[640 + tid] = gb_; } }
            __syncthreads();
            SPE(0); SPB();
            if (ci + 1 < 18) {
                IDS; const int nb = CHUNK_BASE(ci + 1);
#pragma unroll
                for (int i = 0; i < 8; ++i) { const int p = tid + 512 * i, j = p >> 5, c16 = p & 31; kpre[i] = *(const u32x4*)(QK + (unsigned)(ROW_OF(nb, j) * D + 1024 + h * 256 + c16 * 8)); }
#pragma unroll
                for (int i = 0; i < 2; ++i) { const int p = tid + 512 * i, j = p >> 3, e8 = p & 7; vpre[i] = *(const u32x4*)(PV + (unsigned)(ROW_OF(nb, j) * D + h * 512 + sl * 64 + e8 * 8)); }
                if (tid < 128) { const float* gp = GS + (unsigned)((((nb >> 7) * 4 + h) * 2 + dir) * 384 + tid); gi = gp[0]; gf = gp[128]; gb_ = gp[256]; }
            }
            if (tid0 < 128) { IDS; LAS float* const gu = (LAS float*)(vopq(F.lds) + GU_OFF);
                const float pm127 = gu[512 + 127], bL = gu[640 + 127], M127 = fmaxf(m_prev, pm127), u = gu[tid], pm = gu[512 + tid], bb = gu[640 + tid];
                gu[128 + tid] = fmaxf(m_prev, pm); gu[256 + tid] = bb; gu[384 + tid] = __expf(u - M127);
                if (tid == 0) { gu[768] = bL + M127; gu[769] = __expf(m_prev - M127); } }
            f32x4 acc3[5];
#pragma unroll
            for (int nt = 0; nt < 5; ++nt) acc3[nt] = (f32x4){0.f, 0.f, 0.f, 0.f};
            { IDS; LAS unsigned char* L = vopq(F.lds) + R1_OFF + fr * CT_STRIDE + fq * 16;
#pragma unroll
            for (int ks = 0; ks < 8; ++ks)
            {
#pragma unroll
                for (int nt = 0; nt < 5; ++nt) { const bf16x8 bfr = *(const LAS bf16x8*)(L + 16 * nt * CT_STRIDE + 64 * ks);
                    acc3[nt] = __builtin_amdgcn_mfma_f32_16x16x32_bf16(Qf[ks], bfr, acc3[nt], 0, 0, 0);
                    if (nt == 0) asm volatile("" : "+v"(L) : "v"(acc3[0])); }
            } }
            __syncthreads();
            SPE(1); SPB();
            float m_new, a_dec, Mt[4], bt[4];
            { IDS; LAS float* const gu = (LAS float*)(vopq(F.lds) + GU_OFF); m_new = gu[768]; a_dec = gu[769];
#pragma unroll
            for (int reg = 0; reg < 4; ++reg) { Mt[reg] = gu[128 + 16 * tau + 4 * fq + reg]; bt[reg] = gu[256 + 16 * tau + 4 * fq + reg]; } }
#pragma unroll 1
            for (int nt = 0; nt < 8; ++nt) {
                IDS; const int s = 16 * nt + fr; LAS unsigned char* const L = vopq(F.lds);
                if (nt <= tau) {
                    f32x4 a = (f32x4){0.f, 0.f, 0.f, 0.f};
#pragma unroll
                    for (int ks = 0; ks < 8; ++ks) { const bf16x8 kf = *(const LAS bf16x8*)(L + KS_OFF + s * KS_STRIDE + (32 * ks + 8 * fq) * 2);
                        a = __builtin_amdgcn_mfma_f32_16x16x32_bf16(Qf[ks], kf, a, 0, 0, 0); }
                    const float us = ((const LAS float*)(L + GU_OFF))[s];
#pragma unroll
                    for (int reg = 0; reg < 4; ++reg) { const int t = 16 * tau + 4 * fq + reg; const float val = (s <= t) ? a[reg] * __expf(us - Mt[reg]) : 0.f;
                        *(LAS bf16*)(L + R1_OFF + t * SP_STRIDE + s * 2) = (bf16)f2bf(val); }
                } else {
#pragma unroll
                    for (int reg = 0; reg < 4; ++reg) { const int t = 16 * tau + 4 * fq + reg; *(LAS bf16*)(L + R1_OFF + t * SP_STRIDE + s * 2) = (bf16)0u; }
                }
            }
            if (ci + 1 < 18) { IDS; const int nb = CHUNK_BASE(ci + 1);
#pragma unroll
                for (int ks = 0; ks < 8; ++ks) Qf[ks] = *(const bf16x8*)(QK + (unsigned)(ROW_OF(nb, 16 * tau + fr) * D + h * 256 + 32 * ks + 8 * fq)); }
            LDS_WAIT(); asm volatile("" ::: "memory");
            __syncthreads();
            SPE(2); SPB();
            f32x4 acc2[5];
#pragma unroll
            for (int nt = 0; nt < 5; ++nt) acc2[nt] = (f32x4){0.f, 0.f, 0.f, 0.f};
#pragma unroll 1
            for (int ks = 0; ks < 4; ++ks) if (2 * ks <= tau) {
                IDS; LAS unsigned char* const L = vopq(F.lds);
                const bf16x8 af = *(const LAS bf16x8*)(L + R1_OFF + (16 * tau + fr) * SP_STRIDE + (32 * ks + 8 * fq) * 2);
#pragma unroll
                for (int nt = 0; nt < 5; ++nt) { const bf16x8 bfr = *(const LAS bf16x8*)(L + VT_OFF + (16 * nt + fr) * VT_STRIDE + (32 * ks + 8 * fq) * 2);
                    acc2[nt] = __builtin_amdgcn_mfma_f32_16x16x32_bf16(af, bfr, acc2[nt], 0, 0, 0); } }
            __syncthreads();
            SPE(3); SPB();
            {
                IDS; const bool wr_out = (ci >= 2) || write_ctx;
                LAS unsigned char* const hst = vopq(F.lds) + HST_OFF + w * (16 * 144);
#pragma unroll
                for (int reg = 0; reg < 4; ++reg) {
                    const float dec = __expf(m_prev - Mt[reg]);
                    float den = dec * acc3[4][reg] + acc2[4][reg]; den = __shfl(den, lane & 48);
                    const float dn = fmaxf(fabsf(den), __expf(-(bt[reg] + Mt[reg]))), inv = 1.f / dn;
#pragma unroll
                    for (int nt = 0; nt < 4; ++nt) *(LAS bf16*)(hst + (4 * fq + reg) * 144 + (16 * nt + fr) * 2) = (bf16)f2bf((dec * acc3[nt][reg] + acc2[nt][reg]) * inv);
                }
                LDS_WAIT(); asm volatile("" ::: "memory");
                if (wr_out) { const int tl = lane >> 2, c = lane & 3, t = 16 * tau + tl;
                    const u32x4 v0 = *(const LAS u32x4*)(hst + tl * 144 + c * 32), v1 = *(const LAS u32x4*)(hst + tl * 144 + c * 32 + 16);
                    bf16* hp = HS + (unsigned)(ROW_OF(base, t) * D + h * 512 + sl * 64 + c * 16);
                    *(u32x4*)hp = v0; *(u32x4*)(hp + 8) = v1; }
            }
            SPE(4); SPB();
#pragma unroll
            for (int mt = 0; mt < 2; ++mt)
#pragma unroll
                for (int nt = 0; nt < 5; ++nt) Cst[mt][nt] = Cst[mt][nt] * a_dec;
#pragma unroll 1
            for (int ks = 0; ks < 4; ++ks) {
                IDS; LAS unsigned char* const L = vopq(F.lds);
                float wv8[8];
#pragma unroll
                for (int j = 0; j < 8; ++j) wv8[j] = ((const LAS float*)(L + GU_OFF))[384 + 32 * ks + 8 * fq + j];
                bf16x8 afr[2];
#pragma unroll
                for (int mt = 0; mt < 2; ++mt) { const int d = 32 * w + 16 * mt + fr; unsigned pk[4];
#pragma unroll
                    for (int j = 0; j < 4; ++j) { const float k0 = bf2f(*(const LAS bf16*)(L + KS_OFF + (32 * ks + 8 * fq + 2 * j) * KS_STRIDE + d * 2)) * wv8[2 * j];
                        const float k1 = bf2f(*(const LAS bf16*)(L + KS_OFF + (32 * ks + 8 * fq + 2 * j + 1) * KS_STRIDE + d * 2)) * wv8[2 * j + 1]; pk[j] = pk2(k0, k1); }
                    afr[mt] = __builtin_bit_cast(bf16x8, (u32x4){pk[0], pk[1], pk[2], pk[3]}); }
#pragma unroll
                for (int nt = 0; nt < 5; ++nt) { const bf16x8 bfr = *(const LAS bf16x8*)(L + VT_OFF + (16 * nt + fr) * VT_STRIDE + (32 * ks + 8 * fq) * 2);
#pragma unroll
                    for (int mt = 0; mt < 2; ++mt) Cst[mt][nt] = __builtin_amdgcn_mfma_f32_16x16x32_bf16(afr[mt], bfr, Cst[mt][nt], 0, 0, 0); }
                __builtin_amdgcn_sched_barrier(0);
            }
            __syncthreads();
            SPE(5); SPB();
            { IDS; LAS unsigned char* const L = vopq(F.lds);
#pragma unroll
            for (int mt = 0; mt < 2; ++mt)
#pragma unroll
                for (int nt = 0; nt < 5; ++nt) { const int e = 16 * nt + fr, d0 = 32 * w + 16 * mt + 4 * fq; u32x2 o; o.x = pk2(Cst[mt][nt][0], Cst[mt][nt][1]); o.y = pk2(Cst[mt][nt][2], Cst[mt][nt][3]);
                    *(LAS u32x2*)(L + R1_OFF + e * CT_STRIDE + d0 * 2) = o; } }
            m_prev = m_new;
            SPE(6);
        }
#undef CHUNK_BASE
#undef ROW_OF
#undef IDS
#undef SPB
#undef SPE
    }
}

constexpr int NSLOT = 10, NPH = 2 + NSLOT * DEPTH;
constexpr int PL_TILE = 0, PL_READY = 128, PL_LATE = 256, PL_T = 384, PL_NREADY = 385, PL_NLATE = 386, PL_WCNT = 400;
constexpr int CW_DONE = 24576;
__device__ __forceinline__ void moe_plan(const LAS int* cl, LAS int* plan, int NX, int slots, int lane) {
    int n[16], t0[16], T = 0;
#pragma unroll
    for (int e = 0; e < 16; ++e) { n[e] = __builtin_amdgcn_readfirstlane(cl[e]); t0[e] = T; T += (n[e] + 255) >> 8; }
    int cpx1 = (4 * T + NX - 1) / NX; cpx1 = cpx1 < 1 ? 1 : cpx1;
    int nready = 0, nlate = 0;
#pragma unroll
    for (int pass = 0; pass < 2; ++pass) {
        const int tau = lane + 64 * pass; const bool valid = tau < T;
        int e = 0, base = 0, ne = n[0];
#pragma unroll
        for (int k = 1; k < 16; ++k) if (tau >= t0[k]) { e = k; base = t0[k]; ne = n[k]; }
        const int rt = tau - base; int nv = ne - 256 * rt; nv = nv > 256 ? 256 : (nv < 0 ? 0 : nv);
        const unsigned L0 = 4u * (unsigned)tau, q = L0 / (unsigned)cpx1; const int r = (int)(L0 - q * (unsigned)cpx1); bool late = false;
#pragma unroll
        for (int j = 0; j < 4; ++j) { int rj = r + j; if (rj >= cpx1) rj -= cpx1; late = late || (rj >= slots); }
        const int info = e | (rt << 4) | (nv << 11) | (tau << 20);
        if (valid) plan[PL_TILE + tau] = info;
        const unsigned long long mr = __ballot(valid && !late), ml = __ballot(valid && late), below = (1ull << lane) - 1ull;
        if (valid && !late) plan[PL_READY + nready + __popcll(mr & below)] = info;
        if (valid && late) plan[PL_LATE + nlate + __popcll(ml & below)] = info;
        nready += __popcll(mr); nlate += __popcll(ml);
    }
    if (lane == 0) { plan[PL_T] = T; plan[PL_NREADY] = nready; plan[PL_NLATE] = nlate; plan[PL_WCNT] = 0; }
}
__host__ __device__ inline bool phase_exists(int id) { if (id < 2) return true; const int L = (id - 2) / NSLOT, s = (id - 2) % NSLOT; return !(((L & 1) == 0 && (s == 3 || s == 4)) || s == 7 || s == 8); }

__global__ void __launch_bounds__(NWAVES * 64, 2) fwd(Args args) {
    extern __shared__ __attribute__((aligned(16))) unsigned char lds_raw[];
    Frame F;
    F.lds = (LAS unsigned char*)lds_raw; F.tid = threadIdx.x; F.lane = F.tid & 63; F.wave = __builtin_amdgcn_readfirstlane(F.tid >> 6); F.G = gridDim.x; F.bid = blockIdx.x;
    F.ws = args.ws; F.out = args.out;
    if (F.tid < 26) { const unsigned long long pv = (unsigned long long)args.in[F.tid]; LAS unsigned* t = (LAS unsigned*)(F.lds + PTAB_OFF) + 2 * F.tid; t[0] = (unsigned)pv; t[1] = (unsigned)(pv >> 32); }
    volatile LAS unsigned* MISC = (volatile LAS unsigned*)(F.lds + MISC_OFF);
    if (F.tid < 64) MISC[F.tid] = 0u;
    __syncthreads();
    unsigned* ctl = (unsigned*)(F.ws + WS_CTL);
    XcdBarrier bar; bar.bar = ctl + CW_BAR; bar.x = 0; bar.st = nullptr;
    const int lo = args.ph_lo, hi = args.ph_hi;
    const bool multi = (hi - lo) > 1;
    if (multi) bar = xcd_barrier_post(ctl + CW_BAR, MISC + 8, F.tid == 0);
#define IN(k) (lo <= (k) && (k) < hi)
#define RT() __builtin_amdgcn_s_memrealtime()
    unsigned long long pacc = 0ull, pt0 = 0ull; (void)pacc; (void)pt0;
#define PB() do { if (PROBE_MASK) pt0 = RT(); } while (0)
#define PE(ty) do { if ((PROBE_MASK >> (ty)) & 1) pacc += RT() - pt0; } while (0)
#define SEAM(k) do { if ((k) + 1 < hi) { if ((PROBE_MASK >> 14) & 3) pt0 = RT(); { XcdBarrier bq = bar; bq.bar = (unsigned*)opq((unsigned char*)bar.bar); xcd_barrier(bq, F.wave == 0 && lane_id() == 0); } if (((PROBE_MASK >> 14) & 1) && ((PROBE_SEAMSEL >> ((k) < 2 ? 10 + (k) : ((k) - 2) % NSLOT)) & 1)) pacc += RT() - pt0; \
    if ((PROBE_MASK >> 15) & 1) { if (F.wave == 0 && lane_id() == 0) atomicMax((unsigned*)(opq(F.ws) + WS_CTL) + 2048 + (k), (1u << 20) - (unsigned)(RT() - pt0)); } } } while (0)

    if (PHON(0) && IN(0)) { PB(); p0_prologue(F); PE(0); SEAM(0); }
    if (PHON(1) && IN(1)) { PB(); p1_modulate0(F); PE(1); SEAM(1); }
    for (int layer = 0; layer < DEPTH; ++layer) {
        const int pb = 2 + NSLOT * layer, idx = layer >> 1; const bool last = layer == DEPTH - 1;
        const int Mpost = last ? NLAT : NTOK;
        if ((layer & 1) == 0) {
            if (PHON(2) && IN(pb + 0)) {
                unsigned char* const ws = opq(F.ws);
                pg8::Gemm g{(const bf16*)(ws + WS_HT), (const bf16*)(ws + WS_WGIN) + (size_t)idx * 4096 * D, D, 0, nullptr};
                pg8::StaticOrder S; S.init(Mpost, 4096, F.G, sopqi(F.bid));
                EpiGA E{(bf16*)(ws + WS_A1), (bf16*)(ws + WS_A2), (float*)(ws + WS_VST)};
                PB(); pg8::gemm_phase<EpiGA, pg8::StaticOrder, 0>(F.lds, g, S, E, F.wave); tail_convert(F, (Mpost / 256) * 16, layer == 0 ? CV_GA0 : CV_GA2, layer == 0 ? CV_GC0 : CV_GC2); PE(2); SEAM(pb + 0); }
            if (PHON(3) && IN(pb + 1)) { PB(); gate_phase(F, idx); PE(3); SEAM(pb + 1); }
            if (PHON(4) && IN(pb + 2)) {
                unsigned char* const ws = opq(F.ws);
                const float* g1base = (const float*)(ws + WS_MOD) + (size_t)layer * 5 * 12288 + 2 * D;
                pg8::Gemm g{(const bf16*)(ws + WS_A3), (const bf16*)(ws + WS_WGOUT) + (size_t)idx * D * D, D, 0, nullptr};
                pg8::StaticOrder S; S.init(Mpost, D, F.G, sopqi(F.bid));
                EpiRes E{(bf16*)(ws + WS_X), g1base, 0, (const bf16*)(ws + WS_WR) + (size_t)layer * 5 * 32 * D, (float*)(ws + WS_RP)};
                PB(); pg8::gemm_phase<EpiRes, pg8::StaticOrder, 0>(F.lds, g, S, E, F.wave); tail_convert(F, (Mpost / 256) * 8, layer == 0 ? CV_GC0 : CV_GC2, layer == 0 ? CV_M0 : CV_M2); PE(4); SEAM(pb + 2); }
        } else {
            const int perm = (idx & 1);
            if (PHON(5) && IN(pb + 0)) {
                unsigned char* const ws = opq(F.ws);
                pg8::Gemm g{(const bf16*)(ws + WS_HT), (const bf16*)(ws + WS_WMIN) + (size_t)idx * 6400 * D, D, 0, nullptr};
                pg8::StaticOrder S; S.init(NTOK, 6400, F.G, sopqi(F.bid));
                EpiLA E{ws, inp(F, I_MLGB) + idx * 16, perm};
                PB(); pg8::gemm_phase<EpiLA, pg8::StaticOrder, 0>(F.lds, g, S, E, F.wave); tail_convert(F, (NTOK / 256) * 25, layer == 1 ? CV_LA1 : CV_LA3, layer == 1 ? CV_LC1 : CV_P0B); PE(5); SEAM(pb + 0); }
            if (PHON(6) && IN(pb + 1)) { PB(); conv_phase(F, idx); PE(6); SEAM(pb + 1); }
            if (PHON(7) && IN(pb + 2)) { PB(); scan_phase(F, last ? 0 : 1, pacc); PE(7); SEAM(pb + 2); }
            if (PHON(8) && IN(pb + 3)) { PB(); comb_phase(F, idx, Mpost); PE(8); SEAM(pb + 3); }
            if (PHON(9) && IN(pb + 4)) {
                unsigned char* const ws = opq(F.ws);
                const float* g1base = (const float*)(ws + WS_MOD) + (size_t)layer * 5 * 12288 + 2 * D;
                pg8::Gemm g{(const bf16*)(ws + WS_ZL), (const bf16*)(ws + WS_WMOUT) + (size_t)idx * D * D, D, 0, nullptr};
                pg8::StaticOrder S; S.init(Mpost, D, F.G, sopqi(F.bid));
                EpiRes E{(bf16*)(ws + WS_X), g1base, perm, (const bf16*)(ws + WS_WR) + (size_t)layer * 5 * 32 * D, (float*)(ws + WS_RP)};
                PB(); pg8::gemm_phase<EpiRes, pg8::StaticOrder, 0>(F.lds, g, S, E, F.wave); if (layer == 1) tail_convert(F, (Mpost / 256) * 8, CV_LC1, CV_M1); PE(9); SEAM(pb + 4); }
        }
        if (PHON(10) && IN(pb + 5)) { PB(); ln1_phase(F, layer, Mpost); PE(10); SEAM(pb + 5); }
        if (IN(pb + 6)) {
            unsigned char* const ws = opq(F.ws);
            LAS int* const cl = (LAS int*)(F.lds + pg8::STAGE_BYTES + 1024); LAS int* const plan = (LAS int*)(F.lds + pg8::STAGE_BYTES + 2048);
            unsigned* const done = (unsigned*)(ws + WS_CTL) + CW_DONE + layer * 2048;
            const int bidq = sopqi(F.bid), NX = (F.G & 7) == 0 ? 8 : 1, slots = F.G / NX, xg = bidq % NX, slot = bidq / NX;
            if (F.wave == 0) { const int l_ = lane_id();
                if (l_ < 16) cl[l_] = (int)__hip_atomic_load((unsigned*)(ws + WS_CTL) + CW_CNT + layer * 1024 + 64 * l_, __ATOMIC_RELAXED, __HIP_MEMORY_SCOPE_AGENT);
                LDS_WAIT(); moe_plan(cl, plan, NX, slots, l_); }
            __syncthreads();
            const int T = __builtin_amdgcn_readfirstlane(plan[PL_T]), nready = __builtin_amdgcn_readfirstlane(plan[PL_NREADY]), nlate = __builtin_amdgcn_readfirstlane(plan[PL_NLATE]);
            int cpx1 = (4 * T + NX - 1) / NX; cpx1 = cpx1 < 1 ? 1 : cpx1;
            int s2 = cpx1 - slots; s2 = s2 < 0 ? 0 : s2; if (s2 >= slots) s2 = 0;
            if (PHON(11)) {
                pg8::Gemm g{(const bf16*)(ws + WS_HT), (const bf16*)(ws + WS_WEGU) + (size_t)layer * 16 * 1024 * D, D, (size_t)1024 * D * 2, (const int*)(ws + WS_TOKL)};
                pg8::PlanOrderSig S{plan + PL_TILE, 4 * T, 2, slots, slot, xg, cpx1, done, (LAS unsigned*)(plan + PL_WCNT)};
                EpiMoE1 E{(bf16*)(ws + WS_HM), (const float*)(ws + WS_WL)};
                PB(); pg8::gemm_phase<EpiMoE1, pg8::PlanOrderSig, 1>(F.lds, g, S, E, F.wave); PE(11); }
            if (PHON(12)) {
#pragma unroll 1
                for (int call = 0; call < 2; ++call) {
                    const int N = 8 * (call ? nlate : nready), W = call ? slots : slots - s2, sl = call ? slot : slot - s2;
                    pg8::PlanOrder S{plan + (call ? PL_LATE : PL_READY), N, 3, W, sl, xg, (N + NX - 1) / NX, nullptr, nullptr};
                    PB();
                    if (F.wave == 0) { unsigned* const bw = (unsigned*)opq((unsigned char*)bar.bar);
                        for (int i = lane_id(); ; i += 64) { const int pm = S.tile_at(i); if (pm < 0) break; XB_SPIN(xb_ld(done + 16 * pm) < 4u, bw); }
                        __builtin_amdgcn_fence(__ATOMIC_ACQUIRE, "agent"); asm volatile("s_waitcnt vmcnt(0)" ::: "memory"); }
                    __syncthreads();
                    pg8::Gemm g{(const bf16*)(ws + WS_HM), (const bf16*)(ws + WS_WED) + (size_t)layer * 16 * D * 512, 512, (size_t)D * 512 * 2, nullptr};
                    EpiMoE2 E{(bf16*)(ws + WS_YM), (const int*)(ws + WS_TOKL)};
                    pg8::gemm_phase<EpiMoE2, pg8::PlanOrder, 0>(F.lds, g, S, E, F.wave); PE(12); }
            }
            if (layer < 3) {
                const int cpxL = (8 * nlate + NX - 1) / NX;
                const bool all = cpxL >= slots;
                if (all || slot >= cpxL) convert_range(F, layer == 0 ? CV_M0 : (layer == 1 ? CV_M1 : CV_M2), layer == 0 ? CV_LA1 : (layer == 1 ? CV_GA2 : CV_LA3), all ? bidq : (slot - cpxL) * NX + xg, all ? F.G : (slots - cpxL) * NX); }
            SEAM(pb + 6);
        }
        if (PHON(13) && IN(pb + 9)) { PB(); ln2_phase(F, layer, Mpost); PE(13); SEAM(pb + 9); }
    }
    if ((PROBE_MASK >> 15) & 1) { XcdBarrier bq = bar; bq.bar = (unsigned*)opq((unsigned char*)bar.bar); xcd_barrier(bq, F.wave == 0 && lane_id() == 0);
        if (F.bid == PROBE_BID) { unsigned* pm_ = (unsigned*)(opq(F.ws) + WS_CTL) + 2048; for (int k = 0; k < NPH; ++k) { const unsigned v = __hip_atomic_load(pm_ + k, __ATOMIC_RELAXED, __HIP_MEMORY_SCOPE_AGENT); if (v) pacc += (1u << 20) - v; } } }
    if (PROBE_MASK && F.bid == PROBE_BID) { const unsigned long long tgt = RT() + (unsigned long long)PROBE_AMP * pacc; while (RT() < tgt) __builtin_amdgcn_s_sleep(16); }
#undef IN
#undef SEAM
}

extern "C" void kernel_launch(void* const* d_in, const int* in_sizes, int n_in, void* d_out, int out_size, void* d_ws, size_t ws_size, hipStream_t stream) {
    static int grid = 0;
    if (grid == 0) {
        if (n_in != 26 || out_size != NLAT * D || ws_size < WS_END) { fprintf(stderr, "kernel_launch: unexpected problem: n_in %d out %d ws %zu (need %zu)\n", n_in, out_size, ws_size, (size_t)WS_END); grid = -1; return; }
        int dev = 0, cus = 0, per_cu = 0;
        if (hipGetDevice(&dev) != hipSuccess || hipDeviceGetAttribute(&cus, hipDeviceAttributeMultiprocessorCount, dev) != hipSuccess) { grid = -1; return; }
        if (hipFuncSetAttribute((const void*)fwd, hipFuncAttributeMaxDynamicSharedMemorySize, LDS_BYTES) != hipSuccess) { fprintf(stderr, "kernel_launch: hipFuncSetAttribute failed\n"); grid = -1; return; }
        if (hipOccupancyMaxActiveBlocksPerMultiprocessor(&per_cu, (const void*)fwd, NWAVES * 64, LDS_BYTES) != hipSuccess || per_cu < 1) fprintf(stderr, "kernel_launch: occupancy query says %d\n", per_cu);
        (void)hipGetLastError();
        grid = cus;
    }
    if (grid < 0) return;
    if (hipMemsetAsync((char*)d_ws + WS_CTL, 0, CTL_ZERO_BYTES, stream) != hipSuccess) return;
    Args a{};
    for (int i = 0; i < 26; ++i) a.in[i] = (const float*)d_in[i];
    a.out = (float*)d_out; a.ws = (unsigned char*)d_ws;
#if MK_ONE_LAUNCH
    a.ph_lo = 0; a.ph_hi = NPH;
    hipLaunchKernelGGL(fwd, dim3(grid), dim3(NWAVES * 64), LDS_BYTES, stream, a);
#else
    for (int p = 0; p < NPH; ++p) { if (!phase_exists(p)) continue; a.ph_lo = p; a.ph_hi = p + 1; hipLaunchKernelGGL(fwd, dim3(grid), dim3(NWAVES * 64), LDS_BYTES, stream, a); }
#endif
}
```

```cpp
#include <hip/hip_runtime.h>
#include <cstdio>
#include <cstdint>

#ifndef ONLY
#define ONLY -1
#endif
#define PHON(x) (ONLY < 0 || ONLY == (x))
#ifndef PROBE_MASK
#define PROBE_MASK 0
#endif
#ifndef PROBE_SEAMSEL
#define PROBE_SEAMSEL 0xfff
#endif
#ifndef PROBE_BID
#define PROBE_BID 0
#endif
#ifndef PROBE_AMP
#define PROBE_AMP 4
#endif
#ifndef MK_ONE_LAUNCH
#define MK_ONE_LAUNCH 1
#endif

#define GAS __attribute__((address_space(1)))
#define LAS __attribute__((address_space(3)))
typedef unsigned short bf16;
typedef float f32x4 __attribute__((ext_vector_type(4)));
struct __attribute__((packed, aligned(4))) f32x3 { float x, y, z; };
typedef float f32x2 __attribute__((ext_vector_type(2)));
typedef short bf16x8 __attribute__((ext_vector_type(8)));
typedef unsigned u32x4 __attribute__((ext_vector_type(4)));
typedef unsigned u32x2 __attribute__((ext_vector_type(2)));
typedef short v4i16_t __attribute__((ext_vector_type(4)));

constexpr int D = 2048, NLAT = 8192, NCTX = 1024, NTOK = NLAT + NCTX, DEPTH = 4;
constexpr int LCAP = 9216;
constexpr float ALPHA = 1.681792830507429f;
constexpr float LN_EPS = 1e-5f, RMS_EPS = 1e-6f;
constexpr int MLIN = 6160;
constexpr int NWAVES = 8;

__device__ __forceinline__ unsigned f2bf(float f) { unsigned u = __builtin_bit_cast(unsigned, f); return (u + 0x7fffu + ((u >> 16) & 1u)) >> 16; }
typedef float f32x2_t __attribute__((ext_vector_type(2)));
typedef __bf16 bf16x2_t __attribute__((ext_vector_type(2)));
__device__ __forceinline__ unsigned pk2(float lo, float hi) { const f32x2_t v = {lo, hi}; const bf16x2_t b = __builtin_convertvector(v, bf16x2_t); return __builtin_bit_cast(unsigned, b); }
__device__ __forceinline__ float bf2f(unsigned short b) { return __builtin_bit_cast(float, ((unsigned)b) << 16); }
__device__ __forceinline__ float bflo(unsigned w) { return __builtin_bit_cast(float, w << 16); }
__device__ __forceinline__ float bfhi(unsigned w) { return __builtin_bit_cast(float, w & 0xffff0000u); }
__device__ __forceinline__ float sigm(float x) { return __builtin_amdgcn_rcpf(1.f + __expf(-x)); }
__device__ __forceinline__ float siluf(float x) { return x * sigm(x); }
__device__ __forceinline__ float gelu_tanh(float x) { return x * sigm(1.5957691216057308f * (x + 0.044715f * x * x * x)); }
template <int CTRL, int ROWMASK> __device__ __forceinline__ float dppz(float v, int zero) { return __builtin_bit_cast(float, __builtin_amdgcn_update_dpp(zero, __builtin_bit_cast(int, v), CTRL, ROWMASK, 0xf, false)); }
template <int CTRL, int ROWMASK> __device__ __forceinline__ float dpp0(float v) { return __builtin_bit_cast(float, __builtin_amdgcn_update_dpp(0, __builtin_bit_cast(int, v), CTRL, ROWMASK, 0xf, false)); }
__device__ __forceinline__ float wave_sum(float v) {
    v += dpp0<0x111, 0xf>(v); v += dpp0<0x112, 0xf>(v); v += dpp0<0x114, 0xf>(v); v += dpp0<0x118, 0xf>(v);
    v += dpp0<0x142, 0xa>(v); v += dpp0<0x143, 0xc>(v);
    return __builtin_bit_cast(float, __builtin_amdgcn_readlane(__builtin_bit_cast(int, v), 63));
}
__device__ __forceinline__ int permrow(int r) {
    if (r >= NLAT) return r; const int b = r & ~2047, s = r & 2047; return b + ((s & 63) << 5) + (s >> 6);
}
__device__ __forceinline__ int invpermrow(int r) {
    if (r >= NLAT) return r; const int b = r & ~2047, p = r & 2047; return b + ((p & 31) << 6) + (p >> 5);
}
__device__ __forceinline__ LAS unsigned char* vopq(LAS unsigned char* p) { asm volatile("" : "+v"(p)); return p; }
__device__ __forceinline__ int vopqi(int v) { asm volatile("" : "+v"(v)); return v; }
__device__ __forceinline__ int sopqi(int v) { asm volatile("" : "+s"(v)); return v; }
__device__ __forceinline__ int lane_id() { int l; asm volatile("v_mbcnt_lo_u32_b32 %0, -1, 0\n\tv_mbcnt_hi_u32_b32 %0, -1, %0" : "=v"(l)); return l; }
__device__ __forceinline__ float shfl_lane(float v, int src) { return __builtin_bit_cast(float, __builtin_amdgcn_ds_bpermute(src << 2, __builtin_bit_cast(int, v))); }
#define VM_WAIT() asm volatile("s_waitcnt vmcnt(0)" ::: "memory")
#define LDS_WAIT() asm volatile("s_waitcnt lgkmcnt(0)" ::: "memory")

namespace pg8 {
#define PG8_LAS __attribute__((address_space(3)))
constexpr int BM = 256, BK = 64, HALF = 128, HTB = HALF * BK * 2, STAGE_BYTES = 8 * HTB, NXCD = 8, WGM = 8;
__host__ __device__ __forceinline__ int lds_byte(int r, int c) { const int st = (r >> 4) * 2 + (c >> 5), rr = r & 15, cc = c & 31, ob = rr * 64 + cc * 2; return st * 1024 + (ob ^ (((ob >> 9) & 1) << 5)); }
__host__ __device__ __forceinline__ void stage_rc(int b, int& R, int& C) { const int st = b / 1024, sb = b % 1024, swz = sb ^ (((sb >> 9) & 1) << 5); R = (st >> 1) * 16 + swz / 64; C = (st & 1) * 32 + (swz % 64) / 2; }
__host__ __device__ __forceinline__ int perm32(int rho) { const int n = rho >> 4, i = rho & 15; return 8 * (i >> 2) + 4 * n + (i & 3); }

struct Unit { int pm, pn, e, rt, nv; };
struct Gemm { const bf16* A; const bf16* Bt; int K; size_t estride; const int* lst; };

struct StaticOrder {
    static constexpr bool SIGNAL = false;
    int nM, nN, nwg, G, c;
    __device__ void init(int M, int N, int G_, int c_) { nM = M / BM; nN = N / BM; nwg = nM * nN; G = G_; c = c_; }
    __device__ bool next(int i, Unit& u) const {
        const long L = (long)i * G + c; if (L >= nwg) return false;
        int wgid = (int)L; { const int q = nwg / NXCD, r = nwg % NXCD, xcd = wgid % NXCD, off = wgid / NXCD; wgid = (xcd < r ? xcd * (q + 1) : r * (q + 1) + (xcd - r) * q) + off; }
        const int nig = WGM * nN, gid = wgid / nig, fm = gid * WGM, gsz = (nM - fm) < WGM ? (nM - fm) : WGM;
        u.pm = __builtin_amdgcn_readfirstlane(fm + ((wgid % nig) % gsz)); u.pn = __builtin_amdgcn_readfirstlane((wgid % nig) / gsz); u.e = 0; u.rt = 0; u.nv = 256; return true;
    }
};
template <bool SIG> struct PlanOrderT {
    static constexpr bool SIGNAL = SIG;
    const PG8_LAS int* arr; int N, cs, W, sl, x, cpx; unsigned* done; PG8_LAS unsigned* wcnt;
    __device__ __forceinline__ bool next(int i, Unit& u) const {
        if (sl < 0) return false;
        const int li = sl + i * W; if (li >= cpx) return false;
        const int L = x * cpx + li; if (L >= N) return false;
        const int info = __builtin_amdgcn_readfirstlane(arr[L >> cs]);
        u.e = info & 15; u.rt = (info >> 4) & 127; u.nv = (info >> 11) & 511; u.pm = (info >> 20) & 127; u.pn = L & ((1 << cs) - 1); return true;
    }
    __device__ __forceinline__ int tile_at(int i) const {
        if (sl < 0) return -1;
        const int li = sl + i * W; if (li >= cpx) return -1;
        const int L = x * cpx + li; if (L >= N) return -1;
        return (arr[L >> cs] >> 20) & 127;
    }
    __device__ __forceinline__ void signal(const Unit& u, int ui, int lane) const {
        asm volatile("s_waitcnt vmcnt(0)" ::: "memory");
        if (lane == 0) {
            const unsigned old = __hip_atomic_fetch_add(wcnt, 1u, __ATOMIC_RELAXED, __HIP_MEMORY_SCOPE_WORKGROUP);
            if (old == 8u * (unsigned)ui + 7u) { __builtin_amdgcn_fence(__ATOMIC_RELEASE, "agent"); __hip_atomic_fetch_add(done + 16 * u.pm, 1u, __ATOMIC_RELAXED, __HIP_MEMORY_SCOPE_AGENT); }
        }
    }
};
using PlanOrder = PlanOrderT<false>; using PlanOrderSig = PlanOrderT<true>;
template <int AMODE> __device__ __forceinline__ void a_off(const Gemm& g, const Unit& u, int R0, int C0, int R1, int C1, unsigned (&h0)[2], unsigned (&h1)[2]) {
    const int K = g.K;
    if constexpr (AMODE == 0) {
        h0[0] = (unsigned)(R0 * K + C0) * 2u; h0[1] = (unsigned)(R1 * K + C1) * 2u;
        h1[0] = (unsigned)((R0 + HALF) * K + C0) * 2u; h1[1] = (unsigned)((R1 + HALF) * K + C1) * 2u;
    } else {
        const int* l = g.lst + u.e * LCAP + u.rt * 256;
        const int v00 = l[R0 < u.nv ? R0 : 0], v01 = l[R1 < u.nv ? R1 : 0], v10 = l[(R0 + HALF) < u.nv ? R0 + HALF : 0], v11 = l[(R1 + HALF) < u.nv ? R1 + HALF : 0];
        const int t00 = R0 < u.nv ? (v00 >> 1) : 0, t01 = R1 < u.nv ? (v01 >> 1) : 0;
        const int t10 = (R0 + HALF) < u.nv ? (v10 >> 1) : 0, t11 = (R1 + HALF) < u.nv ? (v11 >> 1) : 0;
        h0[0] = (unsigned)(t00 * K + C0) * 2u; h0[1] = (unsigned)(t01 * K + C1) * 2u;
        h1[0] = (unsigned)(t10 * K + C0) * 2u; h1[1] = (unsigned)(t11 * K + C1) * 2u;
    }
}

template <class Epi, class Sched, int AMODE>
__device__ __forceinline__ void gemm_phase(PG8_LAS unsigned char* lds, const Gemm g, const Sched& S, const Epi& E, int wave_id) {
    const int wid = sopqi(wave_id), lane = vopqi(lane_id()), tid = wid * 64 + lane, wr = wid >> 2, wc = wid & 3, fr = lane & 15, fq = lane >> 4;
    const int K = g.K, nt = K / BK;
    int R0, C0, R1, C1; stage_rc(tid * 16, R0, C0); stage_rc(tid * 16 + 8192, R1, C1);
    unsigned voffB[2];
    { const int Rb0 = Epi::PERM ? ((R0 & ~31) + perm32(R0 & 31)) : R0, Rb1 = Epi::PERM ? ((R1 & ~31) + perm32(R1 & 31)) : R1;
      voffB[0] = (unsigned)(Rb0 * K + C0) * 2u; voffB[1] = (unsigned)(Rb1 * K + C1) * 2u; }
    const size_t kstep = (size_t)(BK * 2);
    const size_t hstep = (size_t)HALF * K * 2;
    const size_t tstep = 2 * hstep;
    const unsigned ldsw = (unsigned)wid * 1024u;
    const int aoff = lds_byte(wr * 64 + fr, fq * 8), boff = lds_byte(wc * 32 + fr, fq * 8);
#define PG8_SA(b, h) (((b) * 2 + (h)) * HTB)
#define PG8_SB(b, h) ((4 + (b) * 2 + (h)) * HTB)
#define PG8_STAGE(bufoff, gbase, voff) do { _Pragma("unroll") for (int _i = 0; _i < 2; ++_i) \
        __builtin_amdgcn_global_load_lds((const unsigned*)((const char*)(gbase) + (voff)[_i]), (PG8_LAS unsigned*)(lds + (bufoff) + ldsw + _i * 8192), 16, 0, 0); } while (0)
#define PG8_LDA(dst, b, h) do { _Pragma("unroll") for (int m = 0; m < 4; ++m) _Pragma("unroll") for (int k = 0; k < 2; ++k) dst[m][k] = *(const PG8_LAS bf16x8*)(lds + PG8_SA(b, h) + aoff + m * 2048 + k * 1024); } while (0)
#define PG8_LDB(dst, b, h) do { _Pragma("unroll") for (int n = 0; n < 2; ++n) _Pragma("unroll") for (int k = 0; k < 2; ++k) dst[n][k] = *(const PG8_LAS bf16x8*)(lds + PG8_SB(b, h) + boff + n * 2048 + k * 1024); } while (0)
#define PG8_MMA(ai, bj, At, Bt) do { __builtin_amdgcn_s_setprio(1); _Pragma("unroll") for (int m = 0; m < 4; ++m) _Pragma("unroll") for (int n = 0; n < 2; ++n) _Pragma("unroll") for (int k = 0; k < 2; ++k) \
        acc[ai][bj][m][n] = __builtin_amdgcn_mfma_f32_16x16x32_bf16(Bt[n][k], At[m][k], acc[ai][bj][m][n], 0, 0, 0); __builtin_amdgcn_s_setprio(0); } while (0)
#define PG8_WAIT_V(n) asm volatile("s_waitcnt vmcnt(" #n ")" ::: "memory")
#define PG8_WAIT_L(n) asm volatile("s_waitcnt lgkmcnt(" #n ")" ::: "memory")
#define PG8_BAR __builtin_amdgcn_s_barrier()
#define PG8_SCHED __builtin_amdgcn_sched_barrier(0)
    Unit cur, nxt; int ui = 0;
    if (!S.next(0, cur)) return;
    f32x4 acc[2][2][4][2];
#pragma unroll
    for (int a = 0; a < 2; ++a)
#pragma unroll
        for (int b = 0; b < 2; ++b)
#pragma unroll
            for (int m = 0; m < 4; ++m)
#pragma unroll
                for (int n = 0; n < 2; ++n) acc[a][b][m][n] = (f32x4){0.f, 0.f, 0.f, 0.f};
    bf16x8 At[4][2], B0[2][2], B1[2][2];
    unsigned vh0[2], vh1[2];
    const char* cA = AMODE ? (const char*)g.A : (const char*)g.A + (size_t)cur.pm * tstep;
    const char* cB = (const char*)g.Bt + (size_t)cur.e * g.estride + (size_t)cur.pn * tstep;
    PG8_STAGE(PG8_SB(0, 0), cB, voffB); PG8_STAGE(PG8_SB(0, 1), cB + hstep, voffB);
    a_off<AMODE>(g, cur, R0, C0, R1, C1, vh0, vh1);
    PG8_STAGE(PG8_SA(0, 0), cA, vh0); PG8_STAGE(PG8_SA(0, 1), cA, vh1);
    if (wr == 1) PG8_BAR;
    PG8_WAIT_V(2); PG8_BAR;
    PG8_STAGE(PG8_SB(1, 0), cB + kstep, voffB); PG8_STAGE(PG8_SA(1, 0), cA + kstep, vh0); PG8_STAGE(PG8_SB(1, 1), cB + hstep + kstep, voffB);
    PG8_WAIT_V(6); PG8_BAR;
    for (;;) {
        const bool has_next = S.next(ui + 1, nxt);
        const char* nA = cA; const char* nB = cB;
        if (has_next) {
            nA = AMODE ? (const char*)g.A : (const char*)g.A + (size_t)nxt.pm * tstep;
            nB = (const char*)g.Bt + (size_t)nxt.e * g.estride + (size_t)nxt.pn * tstep;
            if constexpr (AMODE != 0) { if (tid < 256) { const int* l = g.lst + nxt.e * LCAP + nxt.rt * 256; const int tv = l[(unsigned)(tid < nxt.nv ? tid : 0)]; ((PG8_LAS unsigned*)(lds + STAGE_BYTES))[tid] = (unsigned)((tid < nxt.nv ? (tv >> 1) : 0) * K) * 2u; } }
        }
        for (int t = 0; t < nt; t += 2) {
            const bool last = (t == nt - 2);
            const char* a1 = cA + (size_t)(t + 1) * kstep;
            const char* a2 = last ? nA : cA + (size_t)(t + 2) * kstep; const char* b2 = last ? nB : cB + (size_t)(t + 2) * kstep;
            const char* a3 = a2 + kstep; const char* b3 = b2 + kstep;
            PG8_LDB(B0, 0, 0); PG8_LDB(B1, 0, 1); PG8_SCHED; PG8_LDA(At, 0, 0); PG8_STAGE(PG8_SA(1, 1), a1, vh1);
            if constexpr (AMODE != 0) { if (last && has_next) { const PG8_LAS unsigned* gt = (const PG8_LAS unsigned*)(lds + STAGE_BYTES);
                vh0[0] = gt[R0] + (unsigned)C0 * 2u; vh0[1] = gt[R1] + (unsigned)C1 * 2u; vh1[0] = gt[R0 + HALF] + (unsigned)C0 * 2u; vh1[1] = gt[R1 + HALF] + (unsigned)C1 * 2u; } }
            PG8_WAIT_V(8); PG8_WAIT_L(0); PG8_BAR; PG8_MMA(0, 0, At, B0); PG8_MMA(0, 1, At, B1); PG8_BAR; PG8_SCHED;
            PG8_LDA(At, 0, 1); PG8_STAGE(PG8_SB(0, 0), b2, voffB); PG8_STAGE(PG8_SB(0, 1), b2 + hstep, voffB); PG8_STAGE(PG8_SA(0, 0), a2, vh0);
            PG8_WAIT_V(8); PG8_WAIT_L(0); PG8_BAR; PG8_MMA(1, 0, At, B0); PG8_MMA(1, 1, At, B1); PG8_BAR; PG8_SCHED;
            PG8_LDB(B0, 1, 0); PG8_LDB(B1, 1, 1); PG8_SCHED; PG8_LDA(At, 1, 0); PG8_STAGE(PG8_SA(0, 1), a2, vh1);
            PG8_WAIT_V(8); PG8_WAIT_L(0); PG8_BAR; PG8_MMA(0, 0, At, B0); PG8_MMA(0, 1, At, B1); PG8_BAR; PG8_SCHED;
            PG8_LDA(At, 1, 1); PG8_STAGE(PG8_SB(1, 0), b3, voffB); PG8_STAGE(PG8_SB(1, 1), b3 + hstep, voffB); PG8_STAGE(PG8_SA(1, 0), a3, vh0);
            PG8_WAIT_V(8); PG8_WAIT_L(0); PG8_BAR; PG8_MMA(1, 0, At, B0); PG8_MMA(1, 1, At, B1); PG8_BAR; PG8_SCHED;
        }
        if (wr == 0) PG8_BAR;
        E(acc, cur, wr, wc, fr, fq);
        if constexpr (Sched::SIGNAL) S.signal(cur, ui, lane);
        if (!has_next) break;
#pragma unroll
        for (int a = 0; a < 2; ++a)
#pragma unroll
            for (int b = 0; b < 2; ++b)
#pragma unroll
                for (int m = 0; m < 4; ++m)
#pragma unroll
                    for (int n = 0; n < 2; ++n) acc[a][b][m][n] = (f32x4){0.f, 0.f, 0.f, 0.f};
        cur = nxt; cA = nA; cB = nB; ++ui;
        if (wr == 1) PG8_BAR;
    }
    PG8_WAIT_V(0);
    PG8_BAR;
#undef PG8_SA
#undef PG8_SB
#undef PG8_STAGE
#undef PG8_LDA
#undef PG8_LDB
#undef PG8_MMA
#undef PG8_WAIT_V
#undef PG8_WAIT_L
#undef PG8_BAR
#undef PG8_SCHED
}
}
using pg8::Unit;

constexpr size_t MiB = 1u << 20;
constexpr size_t WS_CTL = 0, CTL_ZERO_BYTES = 128 * 1024;
constexpr size_t WS_MOD = 1 * MiB;
constexpr size_t WS_VST = 2 * MiB;
constexpr size_t WS_G = 5 * MiB;
constexpr size_t WS_TOKL = 6 * MiB;
constexpr size_t WS_WL = 7 * MiB;
constexpr size_t WS_WSB = 8 * MiB;
constexpr size_t WS_GS = 9 * MiB;
constexpr size_t WS_WR = 10 * MiB;
constexpr size_t WS_RC = 13 * MiB;
constexpr size_t WS_RP = 552 * MiB;
constexpr size_t WS_WGIN = 16 * MiB;
constexpr size_t WS_WGOUT = 48 * MiB;
constexpr size_t WS_WMIN = 966 * MiB;
constexpr size_t WS_WMOUT = 112 * MiB;
constexpr size_t WS_WEGU = 128 * MiB;
constexpr size_t WS_WED = 384 * MiB;
constexpr size_t WS_X = 512 * MiB;
constexpr size_t WS_HT = 584 * MiB;
constexpr size_t WS_A1 = 620 * MiB;
constexpr size_t WS_A2 = 656 * MiB;
constexpr size_t WS_A3 = 692 * MiB;
constexpr size_t WS_A4 = 728 * MiB;
constexpr size_t WS_HSF = 764 * MiB;
constexpr size_t WS_HSB = 800 * MiB;
constexpr size_t WS_ZL = 836 * MiB;
constexpr size_t WS_HM = 872 * MiB;
constexpr size_t WS_YM = 894 * MiB;
constexpr size_t WS_END = 1018 * MiB;
constexpr int CW_BAR = 4096;
constexpr int CW_CNT = 16384;

struct EpiGA {
    static constexpr bool PERM = true;
    bf16* U; bf16* V; float* vst;
    __device__ __forceinline__ void operator()(const f32x4 (&acc)[2][2][4][2], const Unit& u, int wr, int wc, int fr, int fq) const {
        const bool isv = u.pn >= 8; bf16* base = isv ? V : U;
        const int col0 = (u.pn & 7) * 256 + wc * 32 + 8 * fq, row0 = u.pm * 256 + wr * 64 + fr;
#pragma unroll
        for (int ai = 0; ai < 2; ++ai)
#pragma unroll
            for (int m = 0; m < 4; ++m) {
                const int row = row0 + ai * 128 + m * 16; float s = 0.f, q = 0.f; bf16* rp = base + (size_t)row * D + col0;
#pragma unroll
                for (int bj = 0; bj < 2; ++bj) {
                    f32x4 a = acc[ai][bj][m][0], b = acc[ai][bj][m][1];
#pragma unroll
                    for (int j = 0; j < 4; ++j) { a[j] = gelu_tanh(a[j]); b[j] = gelu_tanh(b[j]); s += a[j] + b[j]; q += a[j] * a[j] + b[j] * b[j]; }
                    u32x4 w; w.x = pk2(a[0], a[1]); w.y = pk2(a[2], a[3]); w.z = pk2(b[0], b[1]); w.w = pk2(b[2], b[3]);
                    *(u32x4*)(rp + bj * 128) = w;
                }
                if (isv) { const int ln = 16 * fq + fr; s += shfl_lane(s, ln ^ 16); s += shfl_lane(s, ln ^ 32); q += shfl_lane(q, ln ^ 16); q += shfl_lane(q, ln ^ 32);
                    if (fq == 0) *(f32x2*)(vst + ((size_t)row * 32 + (u.pn - 8) * 4 + wc) * 2) = (f32x2){s, q}; }
            }
    }
};
struct EpiLA {
    static constexpr bool PERM = true;
    unsigned char* ws; const float* gate_b; int perm;
    __device__ __forceinline__ void operator()(const f32x4 (&acc)[2][2][4][2], const Unit& u, int wr, int wc, int fr, int fq) const {
        const int seg = u.pn >> 3, row0 = u.pm * 256 + wr * 64 + fr;
        if (seg == 3) {
            if (wc == 0 && fq < 2) { float* G = (float*)(ws + WS_G); const f32x4 b0 = *(const f32x4*)(gate_b + 8 * fq), b1 = *(const f32x4*)(gate_b + 8 * fq + 4);
#pragma unroll
                for (int ai = 0; ai < 2; ++ai)
#pragma unroll
                    for (int m = 0; m < 4; ++m) { const int row = row0 + ai * 128 + m * 16, drow = perm ? permrow(row) : row; float* gp = G + (size_t)drow * 16 + 8 * fq;
                        *(f32x4*)gp = acc[ai][0][m][0] + b0; *(f32x4*)(gp + 4) = acc[ai][0][m][1] + b1; } }
            return; }
        bf16* base = (bf16*)(ws + WS_A1 + (size_t)seg * (WS_A3 - WS_A1) - (seg == 2 ? (WS_A3 - WS_A1) - (WS_A4 - WS_A3) : 0));
        const int col0 = (u.pn & 7) * 256 + wc * 32 + 8 * fq;
#pragma unroll
        for (int ai = 0; ai < 2; ++ai)
#pragma unroll
            for (int m = 0; m < 4; ++m) {
                const int row = row0 + ai * 128 + m * 16, drow = perm ? permrow(row) : row; bf16* rp = base + (size_t)drow * D + col0;
#pragma unroll
                for (int bj = 0; bj < 2; ++bj) {
                    f32x4 a = acc[ai][bj][m][0], b = acc[ai][bj][m][1];
                    if (seg == 2) {
#pragma unroll
                        for (int j = 0; j < 4; ++j) { a[j] = sigm(a[j]); b[j] = sigm(b[j]); } }
                    u32x4 w; w.x = pk2(a[0], a[1]); w.y = pk2(a[2], a[3]); w.z = pk2(b[0], b[1]); w.w = pk2(b[2], b[3]);
                    *(u32x4*)(rp + bj * 128) = w;
                }
            }
    }
};
struct EpiRes {
    static constexpr bool PERM = true;
    bf16* X; const float* g1base; int unperm;
    const bf16* wr; float* rp;
    __device__ __forceinline__ void operator()(const f32x4 (&acc)[2][2][4][2], const Unit& u, int wr_, int wc, int fr, int fq) const {
        const int mi = u.pm < 32 ? (u.pm >> 3) : 4; const float* g1 = g1base + (size_t)mi * 12288;
        const int col0 = u.pn * 256 + wc * 32 + 8 * fq, row0 = u.pm * 256 + wr_ * 64 + fr;
        f32x4 gv[2][2]; bf16x8 bh[2], bl[2];
        const bf16* wb = wr + (size_t)(mi * 32 + fr) * D + col0;
#pragma unroll
        for (int bj = 0; bj < 2; ++bj) {
#pragma unroll
            for (int n = 0; n < 2; ++n) gv[bj][n] = *(const f32x4*)(g1 + col0 + bj * 128 + n * 4);
            bh[bj] = *(const bf16x8*)(wb + bj * 128); bl[bj] = *(const bf16x8*)(wb + 16 * D + bj * 128); }
        float* const pp = rp + (u.pn * 4 + wc) * 16 + fr;
        const bool pz = unperm && u.pm < 32;
        const int s1 = pz ? 1024 : 16, s2 = pz ? 1 : 32, s3 = pz ? 4 : 128;
        const int rbase = pz ? ((u.pm & ~7) * 256 + (fr << 6) + (u.pm & 7) * 8 + wr_ * 2) : row0;
        bf16* const xb = X + (unsigned)(rbase * D + col0);
        u32x4 xa[4][2], ob[4][2];
#define ER_LOAD(ai) _Pragma("unroll") for (int m = 0; m < 4; ++m) { const bf16* xp = xb + (unsigned)(((m & 1) * s1 + (m >> 1) * s2 + (ai) * s3) * D); \
            xa[m][0] = *(const u32x4*)xp; xa[m][1] = *(const u32x4*)(xp + 128); }
#define ER_COMP(ai) _Pragma("unroll") for (int m = 0; m < 4; ++m) _Pragma("unroll") for (int bj = 0; bj < 2; ++bj) { const u32x4 xin = xa[m][bj]; \
            const f32x4 a = (f32x4){bflo(xin.x), bfhi(xin.x), bflo(xin.y), bfhi(xin.y)} * ALPHA + gv[bj][0] * acc[ai][bj][m][0]; \
            const f32x4 b = (f32x4){bflo(xin.z), bfhi(xin.z), bflo(xin.w), bfhi(xin.w)} * ALPHA + gv[bj][1] * acc[ai][bj][m][1]; \
            u32x4 o; o.x = pk2(a[0], a[1]); o.y = pk2(a[2], a[3]); o.z = pk2(b[0], b[1]); o.w = pk2(b[2], b[3]); ob[m][bj] = o; }
#define ER_EMIT(ai) _Pragma("unroll") for (int m = 0; m < 4; ++m) { bf16* xp = xb + (unsigned)(((m & 1) * s1 + (m >> 1) * s2 + (ai) * s3) * D); \
            f32x4 pl = (f32x4){0.f, 0.f, 0.f, 0.f}; \
            _Pragma("unroll") for (int bj = 0; bj < 2; ++bj) { *(u32x4*)(xp + bj * 128) = ob[m][bj]; const bf16x8 af = __builtin_bit_cast(bf16x8, ob[m][bj]); \
                pl = __builtin_amdgcn_mfma_f32_16x16x32_bf16(af, bh[bj], pl, 0, 0, 0); pl = __builtin_amdgcn_mfma_f32_16x16x32_bf16(af, bl[bj], pl, 0, 0, 0); } \
            const int rb0 = u.pm * 256 + wr_ * 64 + (ai) * 128 + m * 16 + 4 * fq;       \
            _Pragma("unroll") for (int reg = 0; reg < 4; ++reg) pp[(unsigned)((rb0 + reg) * 512)] = pl[reg]; }
        ER_LOAD(0); ER_COMP(0); ER_LOAD(1); ER_EMIT(0); ER_COMP(1); ER_EMIT(1);
#undef ER_LOAD
#undef ER_COMP
#undef ER_EMIT
    }
};
struct EpiMoE1 {
    static constexpr bool PERM = true;
    bf16* Hm; const float* wl;
    __device__ __forceinline__ void operator()(const f32x4 (&acc)[2][2][4][2], const Unit& u, int wr, int wc, int fr, int fq) const {
        const int col0 = u.pn * 128 + wc * 32 + 8 * fq; const float* wp = wl + u.e * LCAP + u.rt * 256;
        float wv[2][4];
#pragma unroll
        for (int ai = 0; ai < 2; ++ai)
#pragma unroll
            for (int m = 0; m < 4; ++m) { const int rl = ai * 128 + wr * 64 + m * 16 + fr; wv[ai][m] = wp[rl < u.nv ? rl : 0]; }
#pragma unroll
        for (int ai = 0; ai < 2; ++ai)
#pragma unroll
            for (int m = 0; m < 4; ++m) {
                const int rl = ai * 128 + wr * 64 + m * 16 + fr;
                if (rl < u.nv) {
                    const float w = wv[ai][m]; f32x4 g0 = acc[ai][0][m][0], g1 = acc[ai][0][m][1]; const f32x4 u0 = acc[ai][1][m][0], u1 = acc[ai][1][m][1];
#pragma unroll
                    for (int j = 0; j < 4; ++j) { g0[j] = siluf(g0[j]) * u0[j] * w; g1[j] = siluf(g1[j]) * u1[j] * w; }
                    u32x4 o; o.x = pk2(g0[0], g0[1]); o.y = pk2(g0[2], g0[3]); o.z = pk2(g1[0], g1[1]); o.w = pk2(g1[2], g1[3]);
                    *(u32x4*)(Hm + (size_t)(u.pm * 256 + rl) * 512 + col0) = o;
                }
            }
    }
};
struct EpiMoE2 {
    static constexpr bool PERM = true;
    bf16* YM; const int* lst;
    __device__ __forceinline__ void operator()(const f32x4 (&acc)[2][2][4][2], const Unit& u, int wr, int wc, int fr, int fq) const {
        const int col0 = u.pn * 256 + wc * 32 + 8 * fq; const int* lp = lst + u.e * LCAP + u.rt * 256;
        int tkv[2][4];
#pragma unroll
        for (int ai = 0; ai < 2; ++ai)
#pragma unroll
            for (int m = 0; m < 4; ++m) { const int rl = ai * 128 + wr * 64 + m * 16 + fr; tkv[ai][m] = lp[rl < u.nv ? rl : 0]; }
#pragma unroll
        for (int ai = 0; ai < 2; ++ai)
#pragma unroll
            for (int m = 0; m < 4; ++m) {
                const int rl = ai * 128 + wr * 64 + m * 16 + fr;
                if (rl < u.nv) {
                    const int tk = tkv[ai][m]; bf16* rp = YM + (size_t)tk * D + col0;
#pragma unroll
                    for (int bj = 0; bj < 2; ++bj) { const f32x4 a = acc[ai][bj][m][0], b = acc[ai][bj][m][1];
                        u32x4 o; o.x = pk2(a[0], a[1]); o.y = pk2(a[2], a[3]); o.z = pk2(b[0], b[1]); o.w = pk2(b[2], b[3]);
                        *(u32x4*)(rp + bj * 128) = o; }
                }
            }
    }
};

constexpr int LDS_BYTES = 155648, MISC_OFF = LDS_BYTES - 512, PTAB_OFF = LDS_BYTES - 256;

#define XB_TMO      128
#define XB_XCNT(j)  (256  + 64 * (j))
#define XB_XSUB(j)  (1280 + 64 * (j))
#define XB_XGEN(j)  (2304 + 64 * (j))
#define XB_TOP      3328
#define XB_TOPGEN   3392
#define XCD_BAR_WORDS 3456
#define XB_SPIN_CAP (1u << 18)
__device__ __forceinline__ unsigned xb_ld(unsigned* p)              { return __hip_atomic_load(p, __ATOMIC_RELAXED, __HIP_MEMORY_SCOPE_AGENT); }
__device__ __forceinline__ unsigned xb_add(unsigned* p, unsigned v) { return __hip_atomic_fetch_add(p, v, __ATOMIC_RELAXED, __HIP_MEMORY_SCOPE_AGENT); }
__device__ __forceinline__ unsigned xb_xcc_id() { return (unsigned)__builtin_amdgcn_s_getreg((3 << 11) | 20) & 0xFu; }
#define XB_SPIN(cond, bar) do { unsigned _sp = 0; while (cond) { __builtin_amdgcn_s_sleep(1); \
    if ((++_sp & 255u) == 0u) { if (xb_ld(&(bar)[XB_TMO])) break; if (_sp > XB_SPIN_CAP) { atomicAdd(&(bar)[XB_TMO], 1u); break; } } } } while (0)
struct XcdBarrier { unsigned* bar; unsigned x; volatile LAS unsigned* st; };
__device__ __forceinline__ XcdBarrier xcd_barrier_post(unsigned* bar, volatile LAS unsigned* st, bool t0) {
    XcdBarrier b; b.bar = bar; b.x = xb_xcc_id(); b.st = st;
    if (t0) (void)xb_add(&bar[XB_XCNT(b.x)], 1u);
    return b;
}
__device__ __forceinline__ void xcd_barrier_complete(unsigned* bar, unsigned x, unsigned& nloc, unsigned& nx) {
    const unsigned G = gridDim.x * gridDim.y * gridDim.z;
    unsigned sum, cnt, mine, sp = 0u;
    for (;;) {
        sum = 0u; cnt = 0u; mine = 0u;
#pragma unroll
        for (unsigned j = 0; j < 16; ++j) { const unsigned c = xb_ld(&bar[XB_XCNT(j)]); sum += c; cnt += (c > 0u) ? 1u : 0u; mine = (j == x) ? c : mine; }
        if (sum == G) break;
        __builtin_amdgcn_s_sleep(1);
        if ((++sp & 255u) == 0u) { if (xb_ld(&bar[XB_TMO])) break; if (sp > XB_SPIN_CAP) { atomicAdd(&bar[XB_TMO], 1u); break; } }
    }
    nloc = mine > 0u ? mine : 1u; nx = cnt > 0u ? cnt : 1u;
}
__device__ __forceinline__ void xcd_barrier(const XcdBarrier& b, bool t0) {
    asm volatile("s_waitcnt vmcnt(0)" ::: "memory");
    __syncthreads();
    if (t0) {
        unsigned* bar = b.bar;
        __builtin_amdgcn_s_waitcnt(0);
        unsigned nloc = b.st[0], nx = b.st[1];
        if (nloc == 0u) { xcd_barrier_complete(bar, b.x, nloc, nx); b.st[0] = nloc; b.st[1] = nx; }
        const unsigned old = xb_add(&bar[XB_XSUB(b.x)], 1u);
        const unsigned gen = old / nloc;
        if (old + 1u == (gen + 1u) * nloc) {
            __builtin_amdgcn_fence(__ATOMIC_RELEASE, "agent");
            asm volatile("s_waitcnt vmcnt(0)" ::: "memory");
            asm volatile("buffer_inv sc1" ::: "memory");
            const unsigned og = xb_add(&bar[XB_TOP], 1u);
            const unsigned tg = og / nx;
            if (og + 1u == (tg + 1u) * nx) xb_add(&bar[XB_TOPGEN], 1u);
            else XB_SPIN(xb_ld(&bar[XB_TOPGEN]) == tg, bar);
            xb_add(&bar[XB_XGEN(b.x)], 1u);
            asm volatile("s_waitcnt vmcnt(0)" ::: "memory");
        } else {
            asm volatile("buffer_inv sc1" ::: "memory");
            XB_SPIN(xb_ld(&bar[XB_XGEN(b.x)]) == gen, bar);
            asm volatile("s_waitcnt vmcnt(0)" ::: "memory");
        }
    }
    __syncthreads();
}

struct Args { const float* in[26]; float* out; unsigned char* ws; int ph_lo, ph_hi; };
struct Frame {
    LAS unsigned char* lds; int tid, lane, wave, G, bid;
    unsigned char* ws; float* out;
};
__device__ __forceinline__ const float* inp(const Frame& F, int i) {
    const LAS unsigned* t = (const LAS unsigned*)(F.lds + PTAB_OFF) + 2 * i;
    const unsigned lo = (unsigned)__builtin_amdgcn_readfirstlane((int)t[0]), hi = (unsigned)__builtin_amdgcn_readfirstlane((int)t[1]);
    return (const float*)(const GAS float*)(((unsigned long long)hi << 32) | lo);
}
__device__ __forceinline__ unsigned char* opq(unsigned char* p) { GAS unsigned char* g = (GAS unsigned char*)p; asm volatile("" : "+s"(g)); return (unsigned char*)g; }

enum { I_X = 0, I_C, I_CTX, I_CCTX, I_ADAW, I_ADAB, I_GMWIN, I_GMLNG, I_GMLNB, I_GMWS, I_GMBS, I_GMWOUT, I_MLWIN, I_MLCONV, I_MLGB, I_MLNG, I_MLWOUT,
       I_LN1G, I_LN1B, I_LN2G, I_LN2B, I_RW, I_RB, I_EXG, I_EXU, I_EXD };

__device__ __forceinline__ void p0_transpose_item(const float* W, int ldw, int Kout, bf16* WT, int out_row0, LAS float* scr, int k0, int n0, int lane) {
#pragma unroll 8
    for (int i = 0; i < 32; ++i) { const int kk = 2 * i + (lane >> 5); scr[kk * 33 + (lane & 31)] = W[(size_t)(k0 + kk) * ldw + n0 + (lane & 31)]; }
    LDS_WAIT(); asm volatile("" ::: "memory");
    const int c = lane & 7;
#pragma unroll
    for (int j = 0; j < 4; ++j) { const int n = (lane >> 3) + 8 * j; const LAS float* s = scr + (8 * c) * 33 + n;
        u32x4 o; o.x = pk2(s[0 * 33], s[1 * 33]); o.y = pk2(s[2 * 33], s[3 * 33]); o.z = pk2(s[4 * 33], s[5 * 33]); o.w = pk2(s[6 * 33], s[7 * 33]);
        *(u32x4*)(WT + (size_t)(out_row0 + n) * Kout + k0 + 8 * c) = o; }
    LDS_WAIT(); asm volatile("" ::: "memory");
}
constexpr int CV_B0 = 0, CV_B1 = 30720, CV_B2 = 63488, CV_B3 = 94208, CV_END = 126976;
constexpr int CV_GA0 = 4096, CV_GC0 = 18096, CV_M0 = 35096, CV_LA1 = 43696, CV_LC1 = 52696, CV_M1 = 69696, CV_GA2 = 78296, CV_GC2 = 92296, CV_M2 = 109296, CV_LA3 = 117896, CV_P0B = 126976;
struct CvItem { const float* src; bf16* dst; int ldw, kout; };
__device__ __forceinline__ CvItem cv_decode(const Frame& F, unsigned char* ws, int seq) {
    const int blk = seq >= CV_B3 ? 3 : (seq >= CV_B2 ? 2 : (seq >= CV_B1 ? 1 : 0)), idx = blk >> 1;
    int r = seq - (blk == 3 ? CV_B3 : (blk == 2 ? CV_B2 : (blk == 1 ? CV_B1 : 0)));
    const int n_in = (blk & 1) ? 6144 : 4096;
    const float* W; bf16* WT; int ldw, kout, orow, k0, n0;
    if (r < n_in) {
        if (blk & 1) { W = inp(F, I_MLWIN) + (size_t)idx * D * MLIN; ldw = MLIN; kout = D; WT = (bf16*)(ws + WS_WMIN) + (size_t)idx * 6400 * D; n0 = (r % 192) * 32; k0 = (r / 192) * 64; orow = n0; }
        else { W = inp(F, I_GMWIN) + (size_t)idx * D * 4096; ldw = 4096; kout = D; WT = (bf16*)(ws + WS_WGIN) + (size_t)idx * 4096 * D; n0 = (r & 127) * 32; k0 = (r >> 7) * 64; orow = n0; }
    } else if (r < n_in + 2048) { r -= n_in; W = inp(F, (blk & 1) ? I_MLWOUT : I_GMWOUT) + (size_t)idx * D * D; ldw = D; kout = D; WT = (bf16*)(ws + ((blk & 1) ? WS_WMOUT : WS_WGOUT)) + (size_t)idx * D * D; n0 = (r & 63) * 32; k0 = (r >> 6) * 64; orow = n0;
    } else { r -= n_in + 2048; const int which = r >> 13, rr = r & 8191, le = blk * 16 + (rr >> 9), q = rr & 511;
        if (which < 2) { n0 = (q & 15) * 32; k0 = (q >> 4) * 64; W = inp(F, which ? I_EXU : I_EXG) + (size_t)le * D * 512; ldw = 512; kout = D; WT = (bf16*)(ws + WS_WEGU) + (size_t)le * 1024 * D; orow = (n0 >> 7) * 256 + (n0 & 127) + which * 128; }
        else { n0 = (q & 63) * 32; k0 = (q >> 6) * 64; W = inp(F, I_EXD) + (size_t)le * 512 * D; ldw = D; kout = 512; WT = (bf16*)(ws + WS_WED) + (size_t)le * D * 512; orow = n0; } }
    CvItem it; it.src = W + (size_t)k0 * ldw + n0; it.dst = WT + (size_t)orow * kout + k0; it.ldw = ldw; it.kout = kout; return it;
}
__device__ __forceinline__ void cv_load(const CvItem& it, int lane, float (&v)[32]) {
    const float* p = it.src + (unsigned)((lane >> 5) * it.ldw + (lane & 31));
#pragma unroll
    for (int i = 0; i < 32; ++i) v[i] = __builtin_nontemporal_load(p + (unsigned)(2 * i * it.ldw));
}
__device__ __forceinline__ void cv_store(const CvItem& it, int lane, LAS float* scr, const float (&v)[32]) {
#pragma unroll
    for (int i = 0; i < 32; ++i) scr[(2 * i + (lane >> 5)) * 33 + (lane & 31)] = v[i];
    LDS_WAIT(); asm volatile("" ::: "memory");
    const int c = lane & 7;
#pragma unroll
    for (int j = 0; j < 4; ++j) { const int n = (lane >> 3) + 8 * j; const LAS float* s = scr + (8 * c) * 33 + n;
        u32x4 o; o.x = pk2(s[0 * 33], s[1 * 33]); o.y = pk2(s[2 * 33], s[3 * 33]); o.z = pk2(s[4 * 33], s[5 * 33]); o.w = pk2(s[6 * 33], s[7 * 33]);
        __builtin_nontemporal_store(o, (u32x4*)(it.dst + (unsigned)(n * it.kout + 8 * c))); }
    LDS_WAIT(); asm volatile("" ::: "memory");
}
template <class SeqFn> __device__ __forceinline__ void convert_items(const Frame& F0, int n, int rank, int nranks, SeqFn seqf) {
    Frame F = F0; F.wave = sopqi(F0.wave); F.lane = vopqi(lane_id());
    unsigned char* const ws = opq(F.ws);
    LAS float* scr = (LAS float*)(F.lds + F.wave * 8448);
    int i = rank * NWAVES + F.wave; const int step = nranks * NWAVES;
    if (i >= n) return;
    float cur[32], nxt[32]; CvItem ic = cv_decode(F, ws, seqf(i)), in_ = ic; cv_load(ic, F.lane, cur);
#pragma unroll 1
    for (; i < n; i += step) {
        const bool more = i + step < n;
        if (more) { in_ = cv_decode(F, ws, seqf(i + step)); cv_load(in_, F.lane, nxt); }
        cv_store(ic, F.lane, scr, cur);
        if (more) { ic = in_;
#pragma unroll
            for (int k = 0; k < 32; ++k) cur[k] = nxt[k]; }
    }
}
struct SeqRange { int lo; __device__ int operator()(int i) const { return lo + i; } };
struct SeqP0 { __device__ int operator()(int i) const { return i < CV_GA0 ? i : CV_P0B + (i - CV_GA0); } };
__device__ __forceinline__ void convert_range(const Frame& F, int lo, int hi, int rank, int nranks) { convert_items(F, hi - lo, rank, nranks, SeqRange{lo}); }
__device__ __forceinline__ void tail_convert(const Frame& F, int nunits, int lo, int hi) {
    const int rem = nunits % F.G;
    if (rem == 0) convert_range(F, lo, hi, F.bid, F.G);
    else if (F.bid >= rem) convert_range(F, lo, hi, F.bid - rem, F.G - rem);
}
__device__ __forceinline__ void p0_prologue(const Frame& F0) {
    Frame F = F0; F.wave = sopqi(F0.wave); F.lane = vopqi(lane_id()); F.tid = F.wave * 64 + F.lane; F.bid = sopqi(F0.bid);
    unsigned char* const ws = opq(F.ws);
    LAS float* cs = (LAS float*)F.lds;
    LAS float* red = (LAS float*)(F.lds + 65536);
    { const float* pc = inp(F, I_C); const float* pcc = inp(F, I_CCTX);
    for (int i = F.tid; i < 2048 * 8; i += 512) { const int k = i >> 3, j = i & 7; float v = 0.f;
        if (j < 4) v = siluf(pc[j * D + k]); else if (j == 4) v = siluf(pcc[k]); cs[i] = v; } }
    const float* adaw = inp(F, I_ADAW); const float* adab = inp(F, I_ADAB);
    __syncthreads();
    for (int u = F.bid; u < 256; u += F.G) {
        const int l = u >> 6, n0 = (u & 63) * 192;
        const float* W = adaw + (size_t)l * D * 12288 + n0 + 3 * F.lane;
        float acc[5][3];
#pragma unroll
        for (int j = 0; j < 5; ++j) { acc[j][0] = 0.f; acc[j][1] = 0.f; acc[j][2] = 0.f; }
        const int kb = F.wave * 256;
        for (int k0 = 0; k0 < 256; k0 += 8) {
            f32x3 w[8];
#pragma unroll
            for (int i = 0; i < 8; ++i) { const float* wp_ = W + (size_t)(kb + k0 + i) * 12288; w[i].x = __builtin_nontemporal_load(wp_); w[i].y = __builtin_nontemporal_load(wp_ + 1); w[i].z = __builtin_nontemporal_load(wp_ + 2); }
#pragma unroll
            for (int i = 0; i < 8; ++i) { const f32x4 c0 = *(const LAS f32x4*)(cs + (kb + k0 + i) * 8); const float c4 = cs[(kb + k0 + i) * 8 + 4];
                acc[0][0] += c0.x * w[i].x; acc[0][1] += c0.x * w[i].y; acc[0][2] += c0.x * w[i].z;
                acc[1][0] += c0.y * w[i].x; acc[1][1] += c0.y * w[i].y; acc[1][2] += c0.y * w[i].z;
                acc[2][0] += c0.z * w[i].x; acc[2][1] += c0.z * w[i].y; acc[2][2] += c0.z * w[i].z;
                acc[3][0] += c0.w * w[i].x; acc[3][1] += c0.w * w[i].y; acc[3][2] += c0.w * w[i].z;
                acc[4][0] += c4 * w[i].x;   acc[4][1] += c4 * w[i].y;   acc[4][2] += c4 * w[i].z; }
        }
#pragma unroll
        for (int j = 0; j < 5; ++j)
#pragma unroll
            for (int c = 0; c < 3; ++c) red[(F.wave * 64 + F.lane) * 15 + j * 3 + c] = acc[j][c];
        __syncthreads();
        for (int idx = F.tid; idx < 960; idx += 512) { const int ln = idx / 15, q = idx % 15, j = q / 3, cc = q % 3; float s = 0.f;
#pragma unroll
            for (int w = 0; w < 8; ++w) s += red[(w * 64 + ln) * 15 + q];
            const int n = n0 + 3 * ln + cc; ((float*)(ws + WS_MOD))[(size_t)(l * 5 + j) * 12288 + n] = s + adab[l * 12288 + n]; }
        __syncthreads();
    }
    __syncthreads();
    convert_items(F, CV_GA0 + (CV_END - CV_P0B), F.bid, F.G, SeqP0{});
    const float* p_mlwin = inp(F, I_MLWIN);
    for (int i = F.bid * 512 + F.tid; i < 2 * 256 * 2048; i += F.G * 512) { const int l = i >> 19, rr = (i >> 11) & 255, k = i & 2047;
        ((bf16*)(ws + WS_WMIN))[(size_t)(l * 6400 + 6144 + rr) * D + k] = (bf16)(rr < 16 ? f2bf(p_mlwin[(size_t)l * D * MLIN + (size_t)k * MLIN + 6144 + rr]) : 0u); }
    { const float* src = inp(F, I_GMWS); bf16* dst = (bf16*)(ws + WS_WSB);
      for (int i = F.bid * 512 + F.tid; i < 2 * 8 * 128 * 128 / 2; i += F.G * 512) ((unsigned*)dst)[i] = pk2(src[2 * i], src[2 * i + 1]); }
}

__device__ __forceinline__ const float* modp(unsigned char* ws, int l, int mi, int chunk) { return (const float*)(ws + WS_MOD) + ((size_t)(l * 5 + mi) * 6 + chunk) * D; }
__device__ __forceinline__ void load_row(const float* p, int lane, f32x4 (&v)[8]) {
    const f32x4* q = (const f32x4*)p + lane;
#pragma unroll
    for (int j = 0; j < 8; ++j) v[j] = q[64 * j];
}
__device__ __forceinline__ void load_row_bf16(const bf16* p, int lane, f32x4 (&v)[8]) {
    const u32x2* q = (const u32x2*)p + lane;
#pragma unroll
    for (int j = 0; j < 8; ++j) { const u32x2 w = q[64 * j]; v[j] = (f32x4){bflo(w.x), bfhi(w.x), bflo(w.y), bfhi(w.y)}; }
}
__device__ __forceinline__ void load_row_raw(const bf16* p, int lane, u32x2 (&r)[8]) {
    const u32x2* q = (const u32x2*)p + lane;
#pragma unroll
    for (int j = 0; j < 8; ++j) r[j] = q[64 * j];
}
__device__ __forceinline__ void cvt_row(const u32x2 (&r)[8], f32x4 (&v)[8]) {
#pragma unroll
    for (int j = 0; j < 8; ++j) v[j] = (f32x4){bflo(r[j].x), bfhi(r[j].x), bflo(r[j].y), bfhi(r[j].y)};
}
__device__ __forceinline__ void store_row(float* p, int lane, const f32x4 (&v)[8]) {
    f32x4* q = (f32x4*)p + lane;
#pragma unroll
    for (int j = 0; j < 8; ++j) q[64 * j] = v[j];
}
__device__ __forceinline__ void store_row_bf16(bf16* p, int lane, const f32x4 (&v)[8]) {
    u32x2* q = (u32x2*)p + lane;
#pragma unroll
    for (int j = 0; j < 8; ++j) { u32x2 o; o.x = pk2(v[j].x, v[j].y); o.y = pk2(v[j].z, v[j].w); q[64 * j] = o; }
}
__device__ __forceinline__ void layer_norm_row(f32x4 (&v)[8], const float* g, const float* b, int lane) {
    float s = 0.f;
#pragma unroll
    for (int j = 0; j < 8; ++j) s += (v[j].x + v[j].y) + (v[j].z + v[j].w);
    const float mean = wave_sum(s) * (1.f / D); float q = 0.f;
#pragma unroll
    for (int j = 0; j < 8; ++j) { v[j] = v[j] - mean; q += (v[j].x * v[j].x + v[j].y * v[j].y) + (v[j].z * v[j].z + v[j].w * v[j].w); }
    const float rstd = 1.f / sqrtf(wave_sum(q) * (1.f / D) + LN_EPS);
    const f32x4* gp = (const f32x4*)g + lane; const f32x4* bp = (const f32x4*)b + lane;
#pragma unroll
    for (int j = 0; j < 8; ++j) v[j] = v[j] * rstd * gp[64 * j] + bp[64 * j];
}
__device__ __forceinline__ void modulate_row(f32x4 (&v)[8], const float* sc, const float* sh, int lane) {
    const f32x4* cp = (const f32x4*)sc + lane; const f32x4* hp = (const f32x4*)sh + lane;
#pragma unroll
    for (int j = 0; j < 8; ++j) v[j] = v[j] * (cp[64 * j] + 1.0f) + hp[64 * j];
}
__device__ __forceinline__ int mod_index(int r) { return r < NLAT ? (r >> 11) : 4; }

__device__ __forceinline__ void p1_modulate0(const Frame& F0) {
    Frame F = F0; F.wave = sopqi(F0.wave); F.lane = vopqi(lane_id()); F.tid = F.wave * 64 + F.lane; F.bid = sopqi(F0.bid);
    unsigned char* const ws = opq(F.ws);
    const int gw = F.bid * NWAVES + F.wave, NGW = F.G * NWAVES;
    const float* xl = inp(F, I_X); const float* xc = inp(F, I_CTX);
#pragma unroll 1
    for (int sg = gw; sg < 2048 + 1024; sg += NGW) {
        const int row0 = sg < 2048 ? 4 * sg : NLAT + (sg - 2048), nrows = sg < 2048 ? 4 : 1;
        const int mi = mod_index(row0);
        f32x4 sc[8], sh[8], nx[8];
        { const f32x4* cp = (const f32x4*)modp(ws, 0, mi, 1) + F.lane; const f32x4* hp = (const f32x4*)modp(ws, 0, mi, 0) + F.lane;
#pragma unroll
          for (int j = 0; j < 8; ++j) { sc[j] = cp[64 * j] + 1.0f; sh[j] = hp[64 * j]; } }
        load_row(row0 < NLAT ? xl + (size_t)row0 * D : xc + (size_t)(row0 - NLAT) * D, F.lane, nx);
#pragma unroll 1
        for (int rr = 0; rr < nrows; ++rr) {
            const int r = row0 + rr;
            f32x4 v[8];
#pragma unroll
            for (int j = 0; j < 8; ++j) v[j] = nx[j];
            if (rr + 1 < nrows) load_row(xl + (size_t)(r + 1) * D, F.lane, nx);
            store_row_bf16((bf16*)(ws + WS_X) + (size_t)r * D, F.lane, v);
#pragma unroll
            for (int j = 0; j < 8; ++j) v[j] = v[j] * sc[j] + sh[j];
            store_row_bf16((bf16*)(ws + WS_HT) + (size_t)r * D, F.lane, v); }
    }
    { const float* rw = inp(F, I_RW); float* rc = (float*)(ws + WS_RC);
#pragma unroll 1
      for (int t = gw; t < DEPTH * 5 * 16 * 8; t += NGW) {
          const int j = t & 7, e = (t >> 3) & 15, lm = t >> 7, l = lm / 5;
          const int k = 256 * j + 4 * F.lane;
          const f32x4 gg = *(const f32x4*)(inp(F, I_LN1G) + l * D + k), bb = *(const f32x4*)(inp(F, I_LN1B) + l * D + k);
          const f32x4 s4 = *(const f32x4*)((const float*)(ws + WS_MOD) + ((size_t)lm * 6 + 4) * D + k) + 1.0f, h4 = *(const f32x4*)((const float*)(ws + WS_MOD) + ((size_t)lm * 6 + 3) * D + k);
          float r4[4];
#pragma unroll
          for (int i = 0; i < 4; ++i) r4[i] = rw[(k + i) * 16 + e];
          unsigned hi[4], lo[4]; float c1 = 0.f, c2 = 0.f;
#pragma unroll
          for (int i = 0; i < 4; ++i) { const float w = gg[i] * s4[i] * r4[i]; hi[i] = f2bf(w); lo[i] = f2bf(w - bf2f((unsigned short)hi[i]));
              c1 += bf2f((unsigned short)hi[i]) + bf2f((unsigned short)lo[i]); c2 += (bb[i] * s4[i] + h4[i]) * r4[i]; }
          bf16* whi = (bf16*)(ws + WS_WR) + (size_t)(lm * 32 + e) * D + k;
          *(u32x2*)whi = (u32x2){hi[0] | (hi[1] << 16), hi[2] | (hi[3] << 16)}; *(u32x2*)(whi + 16 * D) = (u32x2){lo[0] | (lo[1] << 16), lo[2] | (lo[3] << 16)};
          c1 = wave_sum(c1); c2 = wave_sum(c2);
          if (F.lane == 0) { rc[((lm * 2 + 0) * 8 + j) * 16 + e] = c1; rc[((lm * 2 + 1) * 8 + j) * 16 + e] = c2; } } }
}
__device__ __forceinline__ void ln1_phase(const Frame& F0, int layer, int Mrows) {
    Frame F = F0; F.wave = sopqi(F0.wave); F.lane = vopqi(lane_id()); F.tid = F.wave * 64 + F.lane; F.bid = sopqi(F0.bid);
    unsigned char* const ws = opq(F.ws);
    LAS float* lgl = (LAS float*)(F.lds + 131072); LAS float* lbl = (LAS float*)(F.lds + 139264);
    LAS unsigned* cntl = (LAS unsigned*)(F.lds + 147456 + 64); LAS unsigned* basel = cntl + 16;
    LAS int* rinfo = (LAS int*)(F.lds + 147456 + 256) + F.wave * 64;
    { const f32x4 a = ((const f32x4*)(inp(F, I_LN1G) + layer * D))[F.tid], b = ((const f32x4*)(inp(F, I_LN1B) + layer * D))[F.tid]; ((LAS f32x4*)lgl)[F.tid] = a; ((LAS f32x4*)lbl)[F.tid] = b; }
    if (F.tid < 16) cntl[F.tid] = 0u;
    LAS float* rcl = (LAS float*)(F.lds + 150016);
    if (F.tid < 160) { const int mi = F.tid >> 5, which = (F.tid >> 4) & 1, e = F.tid & 15; const float* p = (const float*)(ws + WS_RC) + ((layer * 5 + mi) * 2 + which) * 128 + e;
        float a = which ? inp(F, I_RB)[e] : 0.f; float pv[8];
#pragma unroll
        for (int j = 0; j < 8; ++j) pv[j] = p[j * 16];
        asm volatile("" : "+v"(pv[0]), "+v"(pv[1]), "+v"(pv[2]), "+v"(pv[3]), "+v"(pv[4]), "+v"(pv[5]), "+v"(pv[6]), "+v"(pv[7]));
#pragma unroll
        for (int j = 0; j < 8; ++j) a += pv[j];
        rcl[F.tid] = a; }
    __syncthreads();
    const int gw = F.bid * NWAVES + F.wave, NGW = F.G * NWAVES;
    bf16* X = (bf16*)(ws + WS_X); bf16* T = (bf16*)(ws + WS_HT);
    const float* RP = (const float*)(ws + WS_RP) + (F.lane & 31) * 16 + (F.lane >> 5) * 8;
    int nr = 0; const int perm = (layer & 1) ? ((layer >> 1) & 1) : 0;
#pragma unroll 1
    for (int sg = gw; sg < 2048 + 1024; sg += NGW) {
        const int row0 = sg < 2048 ? 4 * sg : NLAT + (sg - 2048), nrows = sg < 2048 ? 4 : 1;
        if (row0 >= Mrows) break;
        const int mi = mod_index(row0);
        f32x4 sc[8], sh[8];
        { const f32x4* cp = (const f32x4*)modp(ws, layer, mi, 4) + F.lane; const f32x4* hp = (const f32x4*)modp(ws, layer, mi, 3) + F.lane;
#pragma unroll
          for (int j = 0; j < 8; ++j) { sc[j] = cp[64 * j] + 1.0f; sh[j] = hp[64 * j]; } }
        const LAS float* rcp = rcl + mi * 32;
        u32x2 nx[8]; load_row_raw(X + (size_t)row0 * D, F.lane, nx);
        f32x4 pa = *(const f32x4*)(RP + (size_t)(perm ? permrow(row0) : row0) * 512), pb = *(const f32x4*)(RP + (size_t)(perm ? permrow(row0) : row0) * 512 + 4);
#pragma unroll 1
        for (int rr = 0; rr < nrows; ++rr) {
            const int r = row0 + rr;
            f32x4 v[8]; cvt_row(nx, v);
            float sp[8] = {pa.x, pa.y, pa.z, pa.w, pb.x, pb.y, pb.z, pb.w};
            if (rr + 1 < nrows) { load_row_raw(X + (size_t)(r + 1) * D, F.lane, nx); const int pr = perm ? permrow(r + 1) : r + 1; pa = *(const f32x4*)(RP + (size_t)pr * 512); pb = *(const f32x4*)(RP + (size_t)pr * 512 + 4); }
            float s = 0.f;
#pragma unroll
            for (int j = 0; j < 8; ++j) s += (v[j].x + v[j].y) + (v[j].z + v[j].w);
            const float mean = wave_sum(s) * (1.f / D); float q = 0.f;
#pragma unroll
            for (int j = 0; j < 8; ++j) { v[j] = v[j] - mean; q += (v[j].x * v[j].x + v[j].y * v[j].y) + (v[j].z * v[j].z + v[j].w * v[j].w); }
            const float rstd = 1.f / sqrtf(wave_sum(q) * (1.f / D) + LN_EPS);
            u32x2* xo = (u32x2*)(X + (size_t)r * D) + F.lane; u32x2* to = (u32x2*)(T + (size_t)r * D) + F.lane;
#pragma unroll
            for (int j = 0; j < 8; ++j) { const f32x4 g = *(const LAS f32x4*)(lgl + 256 * j + 4 * F.lane), b = *(const LAS f32x4*)(lbl + 256 * j + 4 * F.lane);
                const f32x4 xn = v[j] * rstd * g + b; { u32x2 ox; ox.x = pk2(xn.x, xn.y); ox.y = pk2(xn.z, xn.w); xo[64 * j] = ox; } v[j] = xn * sc[j] + sh[j];
                u32x2 o; o.x = pk2(v[j].x, v[j].y); o.y = pk2(v[j].z, v[j].w); to[64 * j] = o; }
            { const int zr = vopqi(0);
#pragma unroll
              for (int e = 0; e < 8; ++e) sp[e] += dppz<0x111, 0xf>(sp[e], zr);
#pragma unroll
              for (int e = 0; e < 8; ++e) sp[e] += dppz<0x112, 0xf>(sp[e], zr);
#pragma unroll
              for (int e = 0; e < 8; ++e) sp[e] += dppz<0x114, 0xf>(sp[e], zr);
#pragma unroll
              for (int e = 0; e < 8; ++e) sp[e] += dppz<0x118, 0xf>(sp[e], zr);
#pragma unroll
              for (int e = 0; e < 8; ++e) sp[e] += dppz<0x142, 0xa>(sp[e], zr); }
            float lg[16];
#pragma unroll
            for (int e = 0; e < 8; ++e) { lg[e] = __builtin_bit_cast(float, __builtin_amdgcn_readlane(__builtin_bit_cast(int, sp[e]), 31)); lg[e + 8] = __builtin_bit_cast(float, __builtin_amdgcn_readlane(__builtin_bit_cast(int, sp[e]), 63)); }
            float mx = -3.0e38f;
#pragma unroll
            for (int e = 0; e < 16; ++e) { lg[e] = rstd * (lg[e] - mean * rcp[e]) + rcp[16 + e]; mx = fmaxf(mx, lg[e]); }
#pragma unroll
            for (int e = 0; e < 16; ++e) lg[e] = __expf(lg[e] - mx);
            float best = -1.f; int gs = 0;
#pragma unroll
            for (int g = 0; g < 4; ++g) { const float a = lg[4 * g], b = lg[4 * g + 1], c = lg[4 * g + 2], d = lg[4 * g + 3];
                const float h1 = fmaxf(a, b), l1 = fminf(a, b), h2 = fmaxf(c, d), l2 = fminf(c, d);
                const float scr = fmaxf(h1, h2) + fmaxf(fminf(h1, h2), fmaxf(l1, l2)); if (scr > best) { best = scr; gs = g; } }
            float q0 = 0.f, q1 = 0.f, q2 = 0.f, q3 = 0.f;
#pragma unroll
            for (int g = 0; g < 4; ++g) if (g == gs) { q0 = lg[4 * g]; q1 = lg[4 * g + 1]; q2 = lg[4 * g + 2]; q3 = lg[4 * g + 3]; }
            int i1 = 0; float p1 = q0; if (q1 > p1) { p1 = q1; i1 = 1; } if (q2 > p1) { p1 = q2; i1 = 2; } if (q3 > p1) { p1 = q3; i1 = 3; }
            int i2 = 0; float p2 = -1.f;
            if (i1 != 0 && q0 > p2) { p2 = q0; i2 = 0; } if (i1 != 1 && q1 > p2) { p2 = q1; i2 = 1; } if (i1 != 2 && q2 > p2) { p2 = q2; i2 = 2; } if (i1 != 3 && q3 > p2) { p2 = q3; i2 = 3; }
            const float inv = 1.f / (p1 + p2);
            if (F.lane == 0 && nr < 10) { const int e0 = 4 * gs + i1, e1 = 4 * gs + i2;
                rinfo[nr * 6 + 0] = e0; rinfo[nr * 6 + 1] = e1;
                rinfo[nr * 6 + 2] = (int)atomicAdd((unsigned*)&cntl[e0], 1u); rinfo[nr * 6 + 3] = (int)atomicAdd((unsigned*)&cntl[e1], 1u);
                rinfo[nr * 6 + 4] = __builtin_bit_cast(int, p1 * inv); rinfo[nr * 6 + 5] = __builtin_bit_cast(int, p2 * inv); }
            ++nr;
        }
    }
    __syncthreads();
    unsigned* gcnt = (unsigned*)(ws + WS_CTL) + CW_CNT + layer * 1024;
    if (F.tid < 16) { const unsigned c = cntl[F.tid]; basel[F.tid] = c ? __hip_atomic_fetch_add(gcnt + 64 * F.tid, c, __ATOMIC_RELAXED, __HIP_MEMORY_SCOPE_AGENT) : 0u; }
    __syncthreads();
    int* tokl = (int*)(ws + WS_TOKL); float* wl = (float*)(ws + WS_WL);
    if (F.lane == 0) {
        int k = 0;
        for (int sg = gw; sg < 2048 + 1024; sg += NGW) {
            const int row0 = sg < 2048 ? 4 * sg : NLAT + (sg - 2048), nrows = sg < 2048 ? 4 : 1;
            if (row0 >= Mrows) break;
            for (int rr = 0; rr < nrows; ++rr, ++k) { if (k >= 10) break;
                const int r = row0 + rr, e0 = rinfo[k * 6 + 0], e1 = rinfo[k * 6 + 1];
                const int p0 = (int)basel[e0] + rinfo[k * 6 + 2], p1 = (int)basel[e1] + rinfo[k * 6 + 3];
                tokl[e0 * LCAP + p0] = r * 2; wl[e0 * LCAP + p0] = __builtin_bit_cast(float, rinfo[k * 6 + 4]);
                tokl[e1 * LCAP + p1] = r * 2 + 1; wl[e1 * LCAP + p1] = __builtin_bit_cast(float, rinfo[k * 6 + 5]); }
        }
    }
}
__device__ __forceinline__ void ln2_phase(const Frame& F0, int layer, int Mrows) {
    Frame F = F0; F.wave = sopqi(F0.wave); F.lane = vopqi(lane_id()); F.tid = F.wave * 64 + F.lane; F.bid = sopqi(F0.bid);
    unsigned char* const ws = opq(F.ws);
    const bool last = layer == DEPTH - 1; const int nl = last ? layer : layer + 1;
    LAS float* lgl = (LAS float*)F.lds; LAS float* lbl = lgl + 2048; LAS float* vec = lgl + 4096;
    bf16* X = (bf16*)(ws + WS_X); const bf16* YM = (const bf16*)(ws + WS_YM); bf16* H = (bf16*)(ws + WS_HT); float* const outp = F.out;
    const float* lng = inp(F, I_LN2G) + layer * D; const float* lnb = inp(F, I_LN2B) + layer * D;
#pragma unroll 1
    for (int vb = F.bid; vb < 256; vb += F.G) {
        __syncthreads();
        { const int mil = vb >> 6;
          f32x4 tv[8]; tv[0] = ((const f32x4*)lng)[F.tid]; tv[1] = ((const f32x4*)lnb)[F.tid];
#pragma unroll
          for (int kind = 0; kind < 2; ++kind) { const int mi = kind ? 4 : mil;
              tv[2 + 3 * kind] = ((const f32x4*)modp(ws, layer, mi, 5))[F.tid]; tv[3 + 3 * kind] = ((const f32x4*)modp(ws, nl, mi, 1))[F.tid]; tv[4 + 3 * kind] = ((const f32x4*)modp(ws, nl, mi, 0))[F.tid]; }
          asm volatile("" : "+v"(tv[0]), "+v"(tv[1]), "+v"(tv[2]), "+v"(tv[3]), "+v"(tv[4]), "+v"(tv[5]), "+v"(tv[6]), "+v"(tv[7]));
          ((LAS f32x4*)lgl)[F.tid] = tv[0]; ((LAS f32x4*)lbl)[F.tid] = tv[1];
#pragma unroll
          for (int kind = 0; kind < 2; ++kind) { LAS f32x4* d = (LAS f32x4*)(vec + kind * 6144);
              d[F.tid] = tv[2 + 3 * kind]; d[512 + F.tid] = tv[3 + 3 * kind] + 1.0f; d[1024 + F.tid] = tv[4 + 3 * kind]; } }
        __syncthreads();
        const int gwv = vb * NWAVES + F.wave;
#pragma unroll 1
        for (int kind = 0; kind < 2; ++kind) {
            const int row0 = kind ? NLAT + gwv : 4 * gwv, nrows = kind ? 1 : 4;
            if (kind && (gwv >= 1024 || row0 >= Mrows)) break;
            const LAS float* vg = vec + kind * 6144;
            u32x2 nx[8], na[8], nb[8];
            { load_row_raw(X + (size_t)row0 * D, F.lane, nx);
              const u32x2* y0 = (const u32x2*)(YM + (size_t)(2 * row0) * D) + F.lane; const u32x2* y1 = (const u32x2*)(YM + (size_t)(2 * row0 + 1) * D) + F.lane;
#pragma unroll
              for (int j = 0; j < 8; ++j) { na[j] = y0[64 * j]; nb[j] = y1[64 * j]; } }
#pragma unroll 1
            for (int rr = 0; rr < nrows; ++rr) {
                const int r = row0 + rr;
                f32x4 v[8];
#pragma unroll
                for (int j = 0; j < 8; ++j) { const u32x2 a = na[j], b = nb[j]; const f32x4 g2 = *(const LAS f32x4*)(vg + 256 * j + 4 * F.lane);
                    const f32x4 y = (f32x4){bflo(a.x) + bflo(b.x), bfhi(a.x) + bfhi(b.x), bflo(a.y) + bflo(b.y), bfhi(a.y) + bfhi(b.y)};
                    v[j] = (f32x4){bflo(nx[j].x), bfhi(nx[j].x), bflo(nx[j].y), bfhi(nx[j].y)} * ALPHA + g2 * y; }
                if (rr + 1 < nrows) { const int rn = r + 1; load_row_raw(X + (size_t)rn * D, F.lane, nx);
                    const u32x2* y0 = (const u32x2*)(YM + (size_t)(2 * rn) * D) + F.lane; const u32x2* y1 = (const u32x2*)(YM + (size_t)(2 * rn + 1) * D) + F.lane;
#pragma unroll
                    for (int j = 0; j < 8; ++j) { na[j] = y0[64 * j]; nb[j] = y1[64 * j]; } }
                float s = 0.f;
#pragma unroll
                for (int j = 0; j < 8; ++j) s += (v[j].x + v[j].y) + (v[j].z + v[j].w);
                const float mean = wave_sum(s) * (1.f / D); float q = 0.f;
#pragma unroll
                for (int j = 0; j < 8; ++j) { v[j] = v[j] - mean; q += (v[j].x * v[j].x + v[j].y * v[j].y) + (v[j].z * v[j].z + v[j].w * v[j].w); }
                const float rstd = 1.f / sqrtf(wave_sum(q) * (1.f / D) + LN_EPS);
                if (last) { f32x4* oo = (f32x4*)(outp + (size_t)r * D) + F.lane;
#pragma unroll
                    for (int j = 0; j < 8; ++j) { const f32x4 g = *(const LAS f32x4*)(lgl + 256 * j + 4 * F.lane), b = *(const LAS f32x4*)(lbl + 256 * j + 4 * F.lane); oo[64 * j] = v[j] * rstd * g + b; }
                } else { u32x2* xo = (u32x2*)(X + (size_t)r * D) + F.lane; u32x2* ho = (u32x2*)(H + (size_t)r * D) + F.lane;
#pragma unroll
                    for (int j = 0; j < 8; ++j) { const f32x4 g = *(const LAS f32x4*)(lgl + 256 * j + 4 * F.lane), b = *(const LAS f32x4*)(lbl + 256 * j + 4 * F.lane);
                        const f32x4 xn = v[j] * rstd * g + b; { u32x2 ox; ox.x = pk2(xn.x, xn.y); ox.y = pk2(xn.z, xn.w); xo[64 * j] = ox; }
                        const f32x4 hh = xn * *(const LAS f32x4*)(vg + 2048 + 256 * j + 4 * F.lane) + *(const LAS f32x4*)(vg + 4096 + 256 * j + 4 * F.lane);
                        u32x2 o; o.x = pk2(hh.x, hh.y); o.y = pk2(hh.z, hh.w); ho[64 * j] = o; } }
            }
        }
    }
}
__device__ __forceinline__ float wave_incl_sum(float v, int lane) {
#pragma unroll
    for (int o = 1; o < 64; o <<= 1) { const float t = shfl_lane(v, lane >= o ? lane - o : lane); if (lane >= o) v += t; }
    return v;
}
__device__ __forceinline__ float wave_incl_max(float v, int lane) {
#pragma unroll
    for (int o = 1; o < 64; o <<= 1) { const float t = shfl_lane(v, lane >= o ? lane - o : lane); if (lane >= o) v = fmaxf(v, t); }
    return v;
}
__device__ __forceinline__ float log_sigmoid(float x) { return fminf(x, 0.f) - log1pf(__expf(-fabsf(x))); }
__device__ __forceinline__ void conv_phase(const Frame& F0, int idx) {
    Frame F = F0; F.wave = sopqi(F0.wave); F.lane = vopqi(lane_id()); F.tid = F.wave * 64 + F.lane; F.bid = sopqi(F0.bid);
    unsigned char* const ws = opq(F.ws);
    const bf16* P = (const bf16*)(ws + WS_A1); bf16* Q = (bf16*)(ws + WS_A2); const float* cw = inp(F, I_MLCONV) + (size_t)idx * 3 * D;
    const int NIT = (NTOK / 8) * 256, cg = F.tid & 255, c0 = cg * 8;
    float w0[8], w1[8], w2[8];
    { const f32x4 a0 = *(const f32x4*)(cw + c0), a1 = *(const f32x4*)(cw + c0 + 4), b0 = *(const f32x4*)(cw + D + c0), b1 = *(const f32x4*)(cw + D + c0 + 4), d0 = *(const f32x4*)(cw + 2 * D + c0), d1 = *(const f32x4*)(cw + 2 * D + c0 + 4);
#pragma unroll
      for (int j = 0; j < 4; ++j) { w0[j] = a0[j]; w0[4 + j] = a1[j]; w1[j] = b0[j]; w1[4 + j] = b1[j]; w2[j] = d0[j]; w2[4 + j] = d1[j]; } }
    const float ksc = c0 >= 1024 ? 0.0625f : 1.0f;
    u32x4 nrow[10];
#define LB_LOAD(itx) do { const int r0_ = ((itx) >> 8) * 8; const int seqlen_ = r0_ < NLAT ? 2048 : 256, p0_ = r0_ < NLAT ? (r0_ & 2047) : ((r0_ - NLAT) & 255); \
        const bf16* pp_ = P + (unsigned)(r0_ * D + c0); \
        nrow[0] = *(const u32x4*)(pp_ - (p0_ > 0 ? D : 0)); nrow[9] = *(const u32x4*)(pp_ + (p0_ + 8 < seqlen_ ? 8 * D : 0)); \
        _Pragma("unroll") for (int i = 0; i < 8; ++i) nrow[i + 1] = *(const u32x4*)(pp_ + i * D); \
        if (!(p0_ > 0)) nrow[0] = (u32x4){0u, 0u, 0u, 0u}; if (!(p0_ + 8 < seqlen_)) nrow[9] = (u32x4){0u, 0u, 0u, 0u}; } while (0)
    int it = F.bid * 512 + F.tid;
    if (it < NIT) LB_LOAD(it);
#pragma unroll 1
    for (; it < NIT; it += F.G * 512) {
        const int r0 = (it >> 8) * 8;
        u32x4 rows[10];
#pragma unroll
        for (int i = 0; i < 10; ++i) rows[i] = nrow[i];
        if (it + F.G * 512 < NIT) LB_LOAD(it + F.G * 512);
#pragma unroll
        for (int i = 0; i < 8; ++i) {
            const u32x4 prev = rows[i], curv = rows[i + 1], nxtv = rows[i + 2];
            float o[8];
#pragma unroll
            for (int j = 0; j < 4; ++j) {
                const float a0 = bflo(prev[j]), a1 = bfhi(prev[j]), b0 = bflo(curv[j]), b1 = bfhi(curv[j]), d0 = bflo(nxtv[j]), d1 = bfhi(nxtv[j]);
                o[2 * j] = siluf(w0[2 * j] * a0 + w1[2 * j] * b0 + w2[2 * j] * d0) * ksc;
                o[2 * j + 1] = siluf(w0[2 * j + 1] * a1 + w1[2 * j + 1] * b1 + w2[2 * j + 1] * d1) * ksc; }
            u32x4 ov; ov.x = pk2(o[0], o[1]); ov.y = pk2(o[2], o[3]); ov.z = pk2(o[4], o[5]); ov.w = pk2(o[6], o[7]);
            *(u32x4*)(Q + (unsigned)((r0 + i) * D + c0)) = ov;
        }
    }
#undef LB_LOAD
    { const float* G = (const float*)(ws + WS_G); float* GS = (float*)(ws + WS_GS);
      for (int task = F.bid * NWAVES + F.wave; task < 72 * 8; task += F.G * NWAVES) {
        const int dir = task & 1, h = (task >> 1) & 3, base = (task >> 3) * 128, j0 = 2 * F.lane;
        const int ra = base + (dir ? 127 - j0 : j0), rb = base + (dir ? 126 - j0 : j0 + 1);
        const float i0 = G[ra * 16 + dir * 8 + h], f0 = log_sigmoid(G[ra * 16 + dir * 8 + 4 + h]), i1 = G[rb * 16 + dir * 8 + h], f1 = log_sigmoid(G[rb * 16 + dir * 8 + 4 + h]);
        const float incl = wave_incl_sum(f0 + f1, F.lane), b1 = incl, b0 = incl - f1;
        const float u0 = i0 - b0, u1 = i1 - b1;
        const float pin = wave_incl_max(fmaxf(u0, u1), F.lane); float pex = shfl_lane(pin, F.lane > 0 ? F.lane - 1 : 0); if (F.lane == 0) pex = -3.0e38f;
        float* o = GS + (size_t)task * 384 + j0;
        *(f32x2*)o = (f32x2){u0, u1}; *(f32x2*)(o + 128) = (f32x2){fmaxf(pex, u0), pin}; *(f32x2*)(o + 256) = (f32x2){b0, b1};
      } }
}
__device__ __forceinline__ void comb_phase(const Frame& F0, int idx, int Mrows) {
    Frame F = F0; F.wave = sopqi(F0.wave); F.lane = vopqi(lane_id()); F.tid = F.wave * 64 + F.lane; F.bid = sopqi(F0.bid);
    unsigned char* const ws = opq(F.ws);
    const bf16* HF = (const bf16*)(ws + WS_HSF); const bf16* HB = (const bf16*)(ws + WS_HSB); const bf16* PO = (const bf16*)(ws + WS_A4); bf16* ZL = (bf16*)(ws + WS_ZL);
    f32x4 ngv[8];
    { const f32x4* ng = (const f32x4*)(inp(F, I_MLNG) + (size_t)idx * D) + F.lane;
#pragma unroll
      for (int j = 0; j < 8; ++j) ngv[j] = ng[64 * j]; }
    const int gw = F.bid * NWAVES + F.wave, NGW = F.G * NWAVES;
    u32x2 pa[8], pb[8], pc[8];
    if (gw < Mrows) { const u32x2* hf = (const u32x2*)(HF + (size_t)gw * D) + F.lane; const u32x2* hb = (const u32x2*)(HB + (size_t)gw * D) + F.lane; const u32x2* po = (const u32x2*)(PO + (size_t)gw * D) + F.lane;
#pragma unroll
        for (int j = 0; j < 8; ++j) { pa[j] = hf[64 * j]; pb[j] = hb[64 * j]; pc[j] = po[64 * j]; } }
#pragma unroll 1
    for (int r = gw; r < Mrows; r += NGW) {
        f32x4 v[8]; u32x2 po[8];
#pragma unroll
        for (int j = 0; j < 8; ++j) { const u32x2 a = pa[j], b = pb[j]; po[j] = pc[j]; v[j] = (f32x4){bflo(a.x) + bflo(b.x), bfhi(a.x) + bfhi(b.x), bflo(a.y) + bflo(b.y), bfhi(a.y) + bfhi(b.y)}; }
        const int rn = r + NGW;
        if (rn < Mrows) { const u32x2* hf = (const u32x2*)(HF + (size_t)rn * D) + F.lane; const u32x2* hb = (const u32x2*)(HB + (size_t)rn * D) + F.lane; const u32x2* pq = (const u32x2*)(PO + (size_t)rn * D) + F.lane;
#pragma unroll
            for (int j = 0; j < 8; ++j) { pa[j] = hf[64 * j]; pb[j] = hb[64 * j]; pc[j] = pq[64 * j]; } }
#pragma unroll
        for (int h = 0; h < 4; ++h) { float q = 0.f;
#pragma unroll
            for (int jj = 0; jj < 2; ++jj) { const f32x4 x = v[2 * h + jj]; q += (x.x * x.x + x.y * x.y) + (x.z * x.z + x.w * x.w); }
            const float rs = 1.f / sqrtf(wave_sum(q) * (1.f / 512.f) + RMS_EPS);
#pragma unroll
            for (int jj = 0; jj < 2; ++jj) { const int j = 2 * h + jj; const u32x2 o = po[j]; const f32x4 sg = (f32x4){bflo(o.x), bfhi(o.x), bflo(o.y), bfhi(o.y)}; v[j] = v[j] * rs * ngv[j] * sg; } }
        store_row_bf16(ZL + (size_t)r * D, F.lane, v);
    }
}
__device__ __forceinline__ void gate_phase(const Frame& F0, int idx) {
    Frame F = F0; F.wave = sopqi(F0.wave); F.lane = vopqi(lane_id()); F.tid = F.wave * 64 + F.lane; F.bid = sopqi(F0.bid);
    unsigned char* const ws = opq(F.ws);
    constexpr int VT_STRIDE = 272, SS_STRIDE = 132, VT_OFF = 0, SS_OFF = 34816;
    const bf16* U = (const bf16*)(ws + WS_A1); const bf16* V = (const bf16*)(ws + WS_A2); bf16* Z = (bf16*)(ws + WS_A3);
    const float* vst = (const float*)(ws + WS_VST); const bf16* Wsb = (const bf16*)(ws + WS_WSB) + (size_t)idx * 8 * 128 * 128;
    const float* lg = inp(F, I_GMLNG) + (size_t)idx * D; const float* lb = inp(F, I_GMLNB) + (size_t)idx * D; const float* bs = inp(F, I_GMBS) + (size_t)idx * 8 * 128;
    const int fr = F.lane & 15, fq = F.lane >> 4, w = F.wave;
    LAS float* lgl = (LAS float*)(F.lds + 106496); LAS float* lbl = lgl + 2048;
    { const f32x4 ga_ = ((const f32x4*)lg)[F.tid], gb_ = ((const f32x4*)lb)[F.tid]; ((LAS f32x4*)lgl)[F.tid] = ga_; ((LAS f32x4*)lbl)[F.tid] = gb_; }
    u32x4 xvn[4], uvn[4]; f32x4 stn[4];
#define GB_PREFETCH(unx) do { const int n_ = (unx) >> 4, jb_ = (unx) & 15, R0_ = n_ * 128, C0_ = jb_ * 128, q_ = F.tid >> 2, seg_ = F.tid & 3; \
        const float* sp_ = vst + (unsigned)((R0_ + q_) * 64 + seg_ * 16); const bf16* vp_ = V + (unsigned)((R0_ + q_) * D + C0_ + seg_ * 32); \
        const bf16* up_ = U + (unsigned)((R0_ + 16 * w + (F.lane >> 2)) * D + C0_ + (F.lane & 3) * 32); \
        _Pragma("unroll") for (int i = 0; i < 4; ++i) { stn[i] = *(const f32x4*)(sp_ + 4 * i); xvn[i] = *(const u32x4*)(vp_ + 8 * i); uvn[i] = *(const u32x4*)(up_ + 8 * i); } } while (0)
    if (F.bid < 72 * 16) GB_PREFETCH(F.bid);
    bf16x8 af[4] = {}; float bsv[4] = {0.f, 0.f, 0.f, 0.f}; int gcur = -1;
    for (int un = F.bid; un < 72 * 16; un += F.G) {
        const int n = un >> 4, jb = un & 15, g = jb >> 1, R0 = n * 128, C0 = jb * 128;
        __syncthreads();
        u32x4 uv[4];
        {
            const int q = F.tid >> 2, seg = F.tid & 3;
            float s = 0.f, ss = 0.f;
#pragma unroll
            for (int i = 0; i < 4; ++i) { s += stn[i].x + stn[i].z; ss += stn[i].y + stn[i].w; uv[i] = uvn[i]; }
            s += dpp0<0xB1, 0xf>(s); ss += dpp0<0xB1, 0xf>(ss); s += dpp0<0x4E, 0xf>(s); ss += dpp0<0x4E, 0xf>(ss);
            const float mean = s * (1.f / D), rstd = 1.f / sqrtf(ss * (1.f / D) - mean * mean + LN_EPS);
#pragma unroll
            for (int i = 0; i < 4; ++i) { const u32x4 x = xvn[i]; const int c = seg * 32 + 8 * i;
                const f32x4 ga = *(const LAS f32x4*)(lgl + C0 + c), gb = *(const LAS f32x4*)(lgl + C0 + c + 4), ba = *(const LAS f32x4*)(lbl + C0 + c), bb_ = *(const LAS f32x4*)(lbl + C0 + c + 4);
#pragma unroll
                for (int j = 0; j < 4; ++j) { const f32x4 gg = (j >> 1) ? gb : ga, bb = (j >> 1) ? bb_ : ba;
                    const float a = (bflo(x[j]) - mean) * rstd * gg[2 * (j & 1)] + bb[2 * (j & 1)], b = (bfhi(x[j]) - mean) * rstd * gg[2 * (j & 1) + 1] + bb[2 * (j & 1) + 1];
                    *(LAS bf16*)(F.lds + VT_OFF + (c + 2 * j) * VT_STRIDE + q * 2) = (bf16)f2bf(a); *(LAS bf16*)(F.lds + VT_OFF + (c + 2 * j + 1) * VT_STRIDE + q * 2) = (bf16)f2bf(b); } }
        }
        if (un + F.G < 72 * 16) GB_PREFETCH(un + F.G);
        if (g != gcur) { gcur = g;
#pragma unroll
            for (int ks = 0; ks < 4; ++ks) af[ks] = *(const bf16x8*)(Wsb + ((size_t)g * 128 + 16 * w + fr) * 128 + 32 * ks + 8 * fq);
#pragma unroll
            for (int reg = 0; reg < 4; ++reg) bsv[reg] = bs[g * 128 + 16 * w + 4 * fq + reg]; }
        __syncthreads();
        f32x4 acc[8];
#pragma unroll
        for (int nt = 0; nt < 8; ++nt) { acc[nt] = (f32x4){0.f, 0.f, 0.f, 0.f};
#pragma unroll
            for (int ks = 0; ks < 4; ++ks) { const bf16x8 bfr = *(const LAS bf16x8*)(F.lds + VT_OFF + (16 * nt + fr) * VT_STRIDE + (32 * ks + 8 * fq) * 2);
                acc[nt] = __builtin_amdgcn_mfma_f32_16x16x32_bf16(af[ks], bfr, acc[nt], 0, 0, 0); } }
        LAS float* SS = (LAS float*)(F.lds + SS_OFF);
#pragma unroll
        for (int reg = 0; reg < 4; ++reg) { const int p = 16 * w + 4 * fq + reg; const float b = bsv[reg];
#pragma unroll
            for (int nt = 0; nt < 8; ++nt) SS[p * SS_STRIDE + 16 * nt + fr] = acc[nt][reg] + b; }
        LDS_WAIT(); asm volatile("" ::: "memory");
        {
            const int p = 16 * w + (F.lane >> 2), seg = F.lane & 3; bf16* zp = Z + (size_t)(R0 + p) * D + C0 + seg * 32;
#pragma unroll
            for (int i = 0; i < 4; ++i) { const u32x4 x = uv[i]; const LAS float* sp = SS + p * SS_STRIDE + seg * 32 + 8 * i;
                const f32x4 s0 = *(const LAS f32x4*)sp, s1 = *(const LAS f32x4*)(sp + 4);
                u32x4 o; o.x = pk2(bflo(x.x) * s0.x, bfhi(x.x) * s0.y); o.y = pk2(bflo(x.y) * s0.z, bfhi(x.y) * s0.w); o.z = pk2(bflo(x.z) * s1.x, bfhi(x.z) * s1.y); o.w = pk2(bflo(x.w) * s1.z, bfhi(x.w) * s1.w);
                *(u32x4*)(zp + 8 * i) = o; }
        }
    }
}
__device__ __forceinline__ void scan_phase(const Frame& F0, int write_ctx, unsigned long long& pacc) {
    unsigned long long spt = 0ull; (void)spt;
#define SPB() do { if (PROBE_MASK >> 16) spt = __builtin_amdgcn_s_memrealtime(); } while (0)
#define SPE(k) do { if ((PROBE_MASK >> (16 + (k))) & 1) pacc += __builtin_amdgcn_s_memrealtime() - spt; } while (0)
    Frame F = F0; F.wave = sopqi(F0.wave); F.lane = vopqi(lane_id()); F.tid = F.wave * 64 + F.lane; F.bid = sopqi(F0.bid);
    unsigned char* const ws = opq(F.ws);
    constexpr int KS_OFF = 0, KS_STRIDE = 528, VT_OFF = 67584, VT_STRIDE = 272, R1_OFF = 89344, CT_STRIDE = 528, SP_STRIDE = 272, GU_OFF = 131584, HST_OFF = 135680;
    static_assert(HST_OFF + 8 * 16 * 144 <= MISC_OFF, "scan LDS map");
    const bf16* QK = (const bf16*)(ws + WS_A2); const bf16* PV = (const bf16*)(ws + WS_A3); const float* GS = (const float*)(ws + WS_GS);
    const int w = F.wave, tid0 = F.tid;
#define IDS const int tid = vopqi(tid0), lane = tid & 63, fr = lane & 15, fq = lane >> 4; (void)tid; (void)lane; (void)fr; (void)fq
    const int tau = w < 4 ? w : 11 - w;
    for (int uid = F.bid; uid < 256; uid += F.G) {
        const int sl = uid & 7, dir = (uid >> 3) & 1, h = (uid >> 4) & 3, b = uid >> 6;
        bf16* HS = (bf16*)(ws + (dir ? WS_HSB : WS_HSF));
        __syncthreads();
        { IDS;
        for (int i = tid; i < 16 * 128; i += 512) { const int e = 64 + (i >> 7), s = i & 127; *(LAS bf16*)(F.lds + VT_OFF + e * VT_STRIDE + s * 2) = (bf16)(e == 64 ? 0x3f80u : 0u); }
        for (int i = tid; i < 80 * 128; i += 512) { const int e = i >> 7, d4 = i & 127; *(LAS unsigned*)(F.lds + R1_OFF + e * CT_STRIDE + d4 * 4) = 0u; } }
        f32x4 Cst[2][5];
#pragma unroll
        for (int mt = 0; mt < 2; ++mt)
#pragma unroll
            for (int nt = 0; nt < 5; ++nt) Cst[mt][nt] = (f32x4){0.f, 0.f, 0.f, 0.f};
        float m_prev = 0.f;
#define CHUNK_BASE(ci) ((ci) < 2 ? (NLAT + b * 256 + (dir ? 1 - (ci) : (ci)) * 128) : (b * 2048 + (dir ? 17 - (ci) : (ci) - 2) * 128))
#define ROW_OF(base, j) ((base) + (dir ? 127 - (j) : (j)))
        u32x4 kpre[8], vpre[2]; float gi = 0.f, gf = 0.f, gb_ = 0.f; bf16x8 Qf[8];
        {   IDS; const int base = CHUNK_BASE(0);
#pragma unroll
            for (int i = 0; i < 8; ++i) { const int p = tid + 512 * i, j = p >> 5, c16 = p & 31; kpre[i] = *(const u32x4*)(QK + (unsigned)(ROW_OF(base, j) * D + 1024 + h * 256 + c16 * 8)); }
#pragma unroll
            for (int i = 0; i < 2; ++i) { const int p = tid + 512 * i, j = p >> 3, e8 = p & 7; vpre[i] = *(const u32x4*)(PV + (unsigned)(ROW_OF(base, j) * D + h * 512 + sl * 64 + e8 * 8)); }
            if (tid < 128) { const float* gp = GS + (unsigned)((((base >> 7) * 4 + h) * 2 + dir) * 384 + tid); gi = gp[0]; gf = gp[128]; gb_ = gp[256]; }
#pragma unroll
            for (int ks = 0; ks < 8; ++ks) Qf[ks] = *(const bf16x8*)(QK + (unsigned)(ROW_OF(base, 16 * tau + fr) * D + h * 256 + 32 * ks + 8 * fq));
        }
        for (int ci = 0; ci < 18; ++ci) {
            const int base = CHUNK_BASE(ci);
            SPB();
            { IDS; LAS unsigned char* const L = vopq(F.lds);
#pragma unroll
            for (int i = 0; i < 8; ++i) { const int p = tid + 512 * i, j = p >> 5, c16 = p & 31; *(LAS u32x4*)(L + KS_OFF + j * KS_STRIDE + c16 * 16) = kpre[i]; }
#pragma unroll
            for (int i = 0; i < 2; ++i) { const int p = tid + 512 * i, j = p >> 3, e8 = p & 7;
#pragma unroll
                for (int q = 0; q < 4; ++q) { *(LAS bf16*)(L + VT_OFF + (e8 * 8 + 2 * q) * VT_STRIDE + j * 2) = (bf16)(vpre[i][q] & 0xffffu); *(LAS bf16*)(L + VT_OFF + (e8 * 8 + 2 * q + 1) * VT_STRIDE + j * 2) = (bf16)(vpre[i][q] >> 16); } }
            if (tid < 128) { LAS float* tt = (LAS float*)(L + GU_OFF); tt[tid] = gi; tt[512 + tid] = gf; tt[640 + tid] = gb_; } }
            __syncthreads();
            SPE(0); SPB();
            if (ci + 1 < 18) {
                IDS; const int nb = CHUNK_BASE(ci + 1);
#pragma unroll
                for (int i = 0; i < 8; ++i) { const int p = tid + 512 * i, j = p >> 5, c16 = p & 31; kpre[i] = *(const u32x4*)(QK + (unsigned)(ROW_OF(nb, j) * D + 1024 + h * 256 + c16 * 8)); }
#pragma unroll
                for (int i = 0; i < 2; ++i) { const int p = tid + 512 * i, j = p >> 3, e8 = p & 7; vpre[i] = *(const u32x4*)(PV + (unsigned)(ROW_OF(nb, j) * D + h * 512 + sl * 64 + e8 * 8)); }
                if (tid < 128) { const float* gp = GS + (unsigned)((((nb >> 7) * 4 + h) * 2 + dir) * 384 + tid); gi = gp[0]; gf = gp[128]; gb_ = gp[256]; }
            }
            if (tid0 < 128) { IDS; LAS float* const gu = (LAS float*)(vopq(F.lds) + GU_OFF);
                const float pm127 = gu[512 + 127], bL = gu[640 + 127], M127 = fmaxf(m_prev, pm127), u = gu[tid], pm = gu[512 + tid], bb = gu[640 + tid];
                gu[128 + tid] = fmaxf(m_prev, pm); gu[256 + tid] = bb; gu[384 + tid] = __expf(u - M127);
                if (tid == 0) { gu[768] = bL + M127; gu[769] = __expf(m_prev - M127); } }
            f32x4 acc3[5];
#pragma unroll
            for (int nt = 0; nt < 5; ++nt) acc3[nt] = (f32x4){0.f, 0.f, 0.f, 0.f};
            { IDS; LAS unsigned char* L = vopq(F.lds) + R1_OFF + fr * CT_STRIDE + fq * 16;
#pragma unroll
            for (int ks = 0; ks < 8; ++ks)
            {
#pragma unroll
                for (int nt = 0; nt < 5; ++nt) { const bf16x8 bfr = *(const LAS bf16x8*)(L + 16 * nt * CT_STRIDE + 64 * ks);
                    acc3[nt] = __builtin_amdgcn_mfma_f32_16x16x32_bf16(Qf[ks], bfr, acc3[nt], 0, 0, 0);
                    if (nt == 0) asm volatile("" : "+v"(L) : "v"(acc3[0])); }
            } }
            __syncthreads();
            SPE(1); SPB();
            float m_new, a_dec, Mt[4], bt[4];
            { IDS; LAS float* const gu = (LAS float*)(vopq(F.lds) + GU_OFF); m_new = gu[768]; a_dec = gu[769];
#pragma unroll
            for (int reg = 0; reg < 4; ++reg) { Mt[reg] = gu[128 + 16 * tau + 4 * fq + reg]; bt[reg] = gu[256 + 16 * tau + 4 * fq + reg]; } }
#pragma unroll 1
            for (int nt = 0; nt < 8; ++nt) {
                IDS; const int s = 16 * nt + fr; LAS unsigned char* const L = vopq(F.lds);
                if (nt <= tau) {
                    f32x4 a = (f32x4){0.f, 0.f, 0.f, 0.f};
#pragma unroll
                    for (int ks = 0; ks < 8; ++ks) { const bf16x8 kf = *(const LAS bf16x8*)(L + KS_OFF + s * KS_STRIDE + (32 * ks + 8 * fq) * 2);
                        a = __builtin_amdgcn_mfma_f32_16x16x32_bf16(Qf[ks], kf, a, 0, 0, 0); }
                    const float us = ((const LAS float*)(L + GU_OFF))[s];
#pragma unroll
                    for (int reg = 0; reg < 4; ++reg) { const int t = 16 * tau + 4 * fq + reg; const float val = (s <= t) ? a[reg] * __expf(us - Mt[reg]) : 0.f;
                        *(LAS bf16*)(L + R1_OFF + t * SP_STRIDE + s * 2) = (bf16)f2bf(val); }
                } else {
#pragma unroll
                    for (int reg = 0; reg < 4; ++reg) { const int t = 16 * tau + 4 * fq + reg; *(LAS bf16*)(L + R1_OFF + t * SP_STRIDE + s * 2) = (bf16)0u; }
                }
            }
            if (ci + 1 < 18) { IDS; const int nb = CHUNK_BASE(ci + 1);
#pragma unroll
                for (int ks = 0; ks < 8; ++ks) Qf[ks] = *(const bf16x8*)(QK + (unsigned)(ROW_OF(nb, 16 * tau + fr) * D + h * 256 + 32 * ks + 8 * fq)); }
            LDS_WAIT(); asm volatile("" ::: "memory");
            __syncthreads();
            SPE(2); SPB();
            f32x4 acc2[5];
#pragma unroll
            for (int nt = 0; nt < 5; ++nt) acc2[nt] = (f32x4){0.f, 0.f, 0.f, 0.f};
#pragma unroll 1
            for (int ks = 0; ks < 4; ++ks) if (2 * ks <= tau) {
                IDS; LAS unsigned char* const L = vopq(F.lds);
                const bf16x8 af = *(const LAS bf16x8*)(L + R1_OFF + (16 * tau + fr) * SP_STRIDE + (32 * ks + 8 * fq) * 2);
#pragma unroll
                for (int nt = 0; nt < 5; ++nt) { const bf16x8 bfr = *(const LAS bf16x8*)(L + VT_OFF + (16 * nt + fr) * VT_STRIDE + (32 * ks + 8 * fq) * 2);
                    acc2[nt] = __builtin_amdgcn_mfma_f32_16x16x32_bf16(af, bfr, acc2[nt], 0, 0, 0); } }
            __syncthreads();
            SPE(3); SPB();
            {
                IDS; const bool wr_out = (ci >= 2) || write_ctx;
                LAS unsigned char* const hst = vopq(F.lds) + HST_OFF + w * (16 * 144);
#pragma unroll
                for (int reg = 0; reg < 4; ++reg) {
                    const float dec = __expf(m_prev - Mt[reg]);
                    float den = dec * acc3[4][reg] + acc2[4][reg]; den = __shfl(den, lane & 48);
                    const float dn = fmaxf(fabsf(den), __expf(-(bt[reg] + Mt[reg]))), inv = 1.f / dn;
#pragma unroll
                    for (int nt = 0; nt < 4; ++nt) *(LAS bf16*)(hst + (4 * fq + reg) * 144 + (16 * nt + fr) * 2) = (bf16)f2bf((dec * acc3[nt][reg] + acc2[nt][reg]) * inv);
                }
                LDS_WAIT(); asm volatile("" ::: "memory");
                if (wr_out) { const int tl = lane >> 2, c = lane & 3, t = 16 * tau + tl;
                    const u32x4 v0 = *(const LAS u32x4*)(hst + tl * 144 + c * 32), v1 = *(const LAS u32x4*)(hst + tl * 144 + c * 32 + 16);
                    bf16* hp = HS + (unsigned)(ROW_OF(base, t) * D + h * 512 + sl * 64 + c * 16);
                    *(u32x4*)hp = v0; *(u32x4*)(hp + 8) = v1; }
            }
            SPE(4); SPB();
#pragma unroll
            for (int mt = 0; mt < 2; ++mt)
#pragma unroll
                for (int nt = 0; nt < 5; ++nt) Cst[mt][nt] = Cst[mt][nt] * a_dec;
#pragma unroll 1
            for (int ks = 0; ks < 4; ++ks) {
                IDS; LAS unsigned char* const L = vopq(F.lds);
                float wv8[8];
#pragma unroll
                for (int j = 0; j < 8; ++j) wv8[j] = ((const LAS float*)(L + GU_OFF))[384 + 32 * ks + 8 * fq + j];
                bf16x8 afr[2];
#pragma unroll
                for (int mt = 0; mt < 2; ++mt) { const int d = 32 * w + 16 * mt + fr; unsigned pk[4];
#pragma unroll
                    for (int j = 0; j < 4; ++j) { const float k0 = bf2f(*(const LAS bf16*)(L + KS_OFF + (32 * ks + 8 * fq + 2 * j) * KS_STRIDE + d * 2)) * wv8[2 * j];
                        const float k1 = bf2f(*(const LAS bf16*)(L + KS_OFF + (32 * ks + 8 * fq + 2 * j + 1) * KS_STRIDE + d * 2)) * wv8[2 * j + 1]; pk[j] = pk2(k0, k1); }
                    afr[mt] = __builtin_bit_cast(bf16x8, (u32x4){pk[0], pk[1], pk[2], pk[3]}); }
#pragma unroll
                for (int nt = 0; nt < 5; ++nt) { const bf16x8 bfr = *(const LAS bf16x8*)(L + VT_OFF + (16 * nt + fr) * VT_STRIDE + (32 * ks + 8 * fq) * 2);
#pragma unroll
                    for (int mt = 0; mt < 2; ++mt) Cst[mt][nt] = __builtin_amdgcn_mfma_f32_16x16x32_bf16(afr[mt], bfr, Cst[mt][nt], 0, 0, 0); }
                __builtin_amdgcn_sched_barrier(0);
            }
            __syncthreads();
            SPE(5); SPB();
            { IDS; LAS unsigned char* const L = vopq(F.lds);
#pragma unroll
            for (int mt = 0; mt < 2; ++mt)
#pragma unroll
                for (int nt = 0; nt < 5; ++nt) { const int e = 16 * nt + fr, d0 = 32 * w + 16 * mt + 4 * fq; u32x2 o; o.x = pk2(Cst[mt][nt][0], Cst[mt][nt][1]); o.y = pk2(Cst[mt][nt][2], Cst[mt][nt][3]);
                    *(LAS u32x2*)(L + R1_OFF + e * CT_STRIDE + d0 * 2) = o; } }
            m_prev = m_new;
            SPE(6);
        }
#undef CHUNK_BASE
#undef ROW_OF
#undef IDS
#undef SPB
#undef SPE
    }
}

constexpr int NSLOT = 10, NPH = 2 + NSLOT * DEPTH;
constexpr int PL_TILE = 0, PL_READY = 128, PL_LATE = 256, PL_T = 384, PL_NREADY = 385, PL_NLATE = 386, PL_WCNT = 400;
constexpr int CW_DONE = 24576;
__device__ __forceinline__ void moe_plan(const LAS int* cl, LAS int* plan, int NX, int slots, int lane) {
    int n[16], t0[16], T = 0;
#pragma unroll
    for (int e = 0; e < 16; ++e) { n[e] = __builtin_amdgcn_readfirstlane(cl[e]); t0[e] = T; T += (n[e] + 255) >> 8; }
    int cpx1 = (4 * T + NX - 1) / NX; cpx1 = cpx1 < 1 ? 1 : cpx1;
    int nready = 0, nlate = 0;
#pragma unroll
    for (int pass = 0; pass < 2; ++pass) {
        const int tau = lane + 64 * pass; const bool valid = tau < T;
        int e = 0, base = 0, ne = n[0];
#pragma unroll
        for (int k = 1; k < 16; ++k) if (tau >= t0[k]) { e = k; base = t0[k]; ne = n[k]; }
        const int rt = tau - base; int nv = ne - 256 * rt; nv = nv > 256 ? 256 : (nv < 0 ? 0 : nv);
        const unsigned L0 = 4u * (unsigned)tau, q = L0 / (unsigned)cpx1; const int r = (int)(L0 - q * (unsigned)cpx1); bool late = false;
#pragma unroll
        for (int j = 0; j < 4; ++j) { int rj = r + j; if (rj >= cpx1) rj -= cpx1; late = late || (rj >= slots); }
        const int info = e | (rt << 4) | (nv << 11) | (tau << 20);
        if (valid) plan[PL_TILE + tau] = info;
        const unsigned long long mr = __ballot(valid && !late), ml = __ballot(valid && late), below = (1ull << lane) - 1ull;
        if (valid && !late) plan[PL_READY + nready + __popcll(mr & below)] = info;
        if (valid && late) plan[PL_LATE + nlate + __popcll(ml & below)] = info;
        nready += __popcll(mr); nlate += __popcll(ml);
    }
    if (lane == 0) { plan[PL_T] = T; plan[PL_NREADY] = nready; plan[PL_NLATE] = nlate; plan[PL_WCNT] = 0; }
}
__host__ __device__ inline bool phase_exists(int id) { if (id < 2) return true; const int L = (id - 2) / NSLOT, s = (id - 2) % NSLOT; return !(((L & 1) == 0 && (s == 3 || s == 4)) || s == 7 || s == 8); }

__global__ void __launch_bounds__(NWAVES * 64, 2) fwd(Args args) {
    extern __shared__ __attribute__((aligned(16))) unsigned char lds_raw[];
    Frame F;
    F.lds = (LAS unsigned char*)lds_raw; F.tid = threadIdx.x; F.lane = F.tid & 63; F.wave = __builtin_amdgcn_readfirstlane(F.tid >> 6); F.G = gridDim.x; F.bid = blockIdx.x;
    F.ws = args.ws; F.out = args.out;
    if (F.tid < 26) { const unsigned long long pv = (unsigned long long)args.in[F.tid]; LAS unsigned* t = (LAS unsigned*)(F.lds + PTAB_OFF) + 2 * F.tid; t[0] = (unsigned)pv; t[1] = (unsigned)(pv >> 32); }
    volatile LAS unsigned* MISC = (volatile LAS unsigned*)(F.lds + MISC_OFF);
    if (F.tid < 64) MISC[F.tid] = 0u;
    __syncthreads();
    unsigned* ctl = (unsigned*)(F.ws + WS_CTL);
    XcdBarrier bar; bar.bar = ctl + CW_BAR; bar.x = 0; bar.st = nullptr;
    const int lo = args.ph_lo, hi = args.ph_hi;
    const bool multi = (hi - lo) > 1;
    if (multi) bar = xcd_barrier_post(ctl + CW_BAR, MISC + 8, F.tid == 0);
#define IN(k) (lo <= (k) && (k) < hi)
#define RT() __builtin_amdgcn_s_memrealtime()
    unsigned long long pacc = 0ull, pt0 = 0ull; (void)pacc; (void)pt0;
#define PB() do { if (PROBE_MASK) pt0 = RT(); } while (0)
#define PE(ty) do { if ((PROBE_MASK >> (ty)) & 1) pacc += RT() - pt0; } while (0)
#define SEAM(k) do { if ((k) + 1 < hi) { if ((PROBE_MASK >> 14) & 3) pt0 = RT(); { XcdBarrier bq = bar; bq.bar = (unsigned*)opq((unsigned char*)bar.bar); xcd_barrier(bq, F.wave == 0 && lane_id() == 0); } if (((PROBE_MASK >> 14) & 1) && ((PROBE_SEAMSEL >> ((k) < 2 ? 10 + (k) : ((k) - 2) % NSLOT)) & 1)) pacc += RT() - pt0; \
    if ((PROBE_MASK >> 15) & 1) { if (F.wave == 0 && lane_id() == 0) atomicMax((unsigned*)(opq(F.ws) + WS_CTL) + 2048 + (k), (1u << 20) - (unsigned)(RT() - pt0)); } } } while (0)

    if (PHON(0) && IN(0)) { PB(); p0_prologue(F); PE(0); SEAM(0); }
    if (PHON(1) && IN(1)) { PB(); p1_modulate0(F); PE(1); SEAM(1); }
    for (int layer = 0; layer < DEPTH; ++layer) {
        const int pb = 2 + NSLOT * layer, idx = layer >> 1; const bool last = layer == DEPTH - 1;
        const int Mpost = last ? NLAT : NTOK;
        if ((layer & 1) == 0) {
            if (PHON(2) && IN(pb + 0)) {
                unsigned char* const ws = opq(F.ws);
                pg8::Gemm g{(const bf16*)(ws + WS_HT), (const bf16*)(ws + WS_WGIN) + (size_t)idx * 4096 * D, D, 0, nullptr};
                pg8::StaticOrder S; S.init(Mpost, 4096, F.G, sopqi(F.bid));
                EpiGA E{(bf16*)(ws + WS_A1), (bf16*)(ws + WS_A2), (float*)(ws + WS_VST)};
                PB(); pg8::gemm_phase<EpiGA, pg8::StaticOrder, 0>(F.lds, g, S, E, F.wave); tail_convert(F, (Mpost / 256) * 16, layer == 0 ? CV_GA0 : CV_GA2, layer == 0 ? CV_GC0 : CV_GC2); PE(2); SEAM(pb + 0); }
            if (PHON(3) && IN(pb + 1)) { PB(); gate_phase(F, idx); PE(3); SEAM(pb + 1); }
            if (PHON(4) && IN(pb + 2)) {
                unsigned char* const ws = opq(F.ws);
                const float* g1base = (const float*)(ws + WS_MOD) + (size_t)layer * 5 * 12288 + 2 * D;
                pg8::Gemm g{(const bf16*)(ws + WS_A3), (const bf16*)(ws + WS_WGOUT) + (size_t)idx * D * D, D, 0, nullptr};
                pg8::StaticOrder S; S.init(Mpost, D, F.G, sopqi(F.bid));
                EpiRes E{(bf16*)(ws + WS_X), g1base, 0, (const bf16*)(ws + WS_WR) + (size_t)layer * 5 * 32 * D, (float*)(ws + WS_RP)};
                PB(); pg8::gemm_phase<EpiRes, pg8::StaticOrder, 0>(F.lds, g, S, E, F.wave); tail_convert(F, (Mpost / 256) * 8, layer == 0 ? CV_GC0 : CV_GC2, layer == 0 ? CV_M0 : CV_M2); PE(4); SEAM(pb + 2); }
        } else {
            const int perm = (idx & 1);
            if (PHON(5) && IN(pb + 0)) {
                unsigned char* const ws = opq(F.ws);
                pg8::Gemm g{(const bf16*)(ws + WS_HT), (const bf16*)(ws + WS_WMIN) + (size_t)idx * 6400 * D, D, 0, nullptr};
                pg8::StaticOrder S; S.init(NTOK, 6400, F.G, sopqi(F.bid));
                EpiLA E{ws, inp(F, I_MLGB) + idx * 16, perm};
                PB(); pg8::gemm_phase<EpiLA, pg8::StaticOrder, 0>(F.lds, g, S, E, F.wave); tail_convert(F, (NTOK / 256) * 25, layer == 1 ? CV_LA1 : CV_LA3, layer == 1 ? CV_LC1 : CV_P0B); PE(5); SEAM(pb + 0); }
            if (PHON(6) && IN(pb + 1)) { PB(); conv_phase(F, idx); PE(6); SEAM(pb + 1); }
            if (PHON(7) && IN(pb + 2)) { PB(); scan_phase(F, last ? 0 : 1, pacc); PE(7); SEAM(pb + 2); }
            if (PHON(8) && IN(pb + 3)) { PB(); comb_phase(F, idx, Mpost); PE(8); SEAM(pb + 3); }
            if (PHON(9) && IN(pb + 4)) {
                unsigned char* const ws = opq(F.ws);
                const float* g1base = (const float*)(ws + WS_MOD) + (size_t)layer * 5 * 12288 + 2 * D;
                pg8::Gemm g{(const bf16*)(ws + WS_ZL), (const bf16*)(ws + WS_WMOUT) + (size_t)idx * D * D, D, 0, nullptr};
                pg8::StaticOrder S; S.init(Mpost, D, F.G, sopqi(F.bid));
                EpiRes E{(bf16*)(ws + WS_X), g1base, perm, (const bf16*)(ws + WS_WR) + (size_t)layer * 5 * 32 * D, (float*)(ws + WS_RP)};
                PB(); pg8::gemm_phase<EpiRes, pg8::StaticOrder, 0>(F.lds, g, S, E, F.wave); if (layer == 1) tail_convert(F, (Mpost / 256) * 8, CV_LC1, CV_M1); PE(9); SEAM(pb + 4); }
        }
        if (PHON(10) && IN(pb + 5)) { PB(); ln1_phase(F, layer, Mpost); PE(10); SEAM(pb + 5); }
        if (IN(pb + 6)) {
            unsigned char* const ws = opq(F.ws);
            LAS int* const cl = (LAS int*)(F.lds + pg8::STAGE_BYTES + 1024); LAS int* const plan = (LAS int*)(F.lds + pg8::STAGE_BYTES + 2048);
            unsigned* const done = (unsigned*)(ws + WS_CTL) + CW_DONE + layer * 2048;
            const int bidq = sopqi(F.bid), NX = (F.G & 7) == 0 ? 8 : 1, slots = F.G / NX, xg = bidq % NX, slot = bidq / NX;
            if (F.wave == 0) { const int l_ = lane_id();
                if (l_ < 16) cl[l_] = (int)__hip_atomic_load((unsigned*)(ws + WS_CTL) + CW_CNT + layer * 1024 + 64 * l_, __ATOMIC_RELAXED, __HIP_MEMORY_SCOPE_AGENT);
                LDS_WAIT(); moe_plan(cl, plan, NX, slots, l_); }
            __syncthreads();
            const int T = __builtin_amdgcn_readfirstlane(plan[PL_T]), nready = __builtin_amdgcn_readfirstlane(plan[PL_NREADY]), nlate = __builtin_amdgcn_readfirstlane(plan[PL_NLATE]);
            int cpx1 = (4 * T + NX - 1) / NX; cpx1 = cpx1 < 1 ? 1 : cpx1;
            int s2 = cpx1 - slots; s2 = s2 < 0 ? 0 : s2; if (s2 >= slots) s2 = 0;
            if (PHON(11)) {
                pg8::Gemm g{(const bf16*)(ws + WS_HT), (const bf16*)(ws + WS_WEGU) + (size_t)layer * 16 * 1024 * D, D, (size_t)1024 * D * 2, (const int*)(ws + WS_TOKL)};
                pg8::PlanOrderSig S{plan + PL_TILE, 4 * T, 2, slots, slot, xg, cpx1, done, (LAS unsigned*)(plan + PL_WCNT)};
                EpiMoE1 E{(bf16*)(ws + WS_HM), (const float*)(ws + WS_WL)};
                PB(); pg8::gemm_phase<EpiMoE1, pg8::PlanOrderSig, 1>(F.lds, g, S, E, F.wave); PE(11); }
            if (PHON(12)) {
#pragma unroll 1
                for (int call = 0; call < 2; ++call) {
                    const int N = 8 * (call ? nlate : nready), W = call ? slots : slots - s2, sl = call ? slot : slot - s2;
                    pg8::PlanOrder S{plan + (call ? PL_LATE : PL_READY), N, 3, W, sl, xg, (N + NX - 1) / NX, nullptr, nullptr};
                    PB();
                    if (F.wave == 0) { unsigned* const bw = (unsigned*)opq((unsigned char*)bar.bar);
                        for (int i = lane_id(); ; i += 64) { const int pm = S.tile_at(i); if (pm < 0) break; XB_SPIN(xb_ld(done + 16 * pm) < 4u, bw); }
                        __builtin_amdgcn_fence(__ATOMIC_ACQUIRE, "agent"); asm volatile("s_waitcnt vmcnt(0)" ::: "memory"); }
                    __syncthreads();
                    pg8::Gemm g{(const bf16*)(ws + WS_HM), (const bf16*)(ws + WS_WED) + (size_t)layer * 16 * D * 512, 512, (size_t)D * 512 * 2, nullptr};
                    EpiMoE2 E{(bf16*)(ws + WS_YM), (const int*)(ws + WS_TOKL)};
                    pg8::gemm_phase<EpiMoE2, pg8::PlanOrder, 0>(F.lds, g, S, E, F.wave); PE(12); }
            }
            if (layer < 3) {
                const int cpxL = (8 * nlate + NX - 1) / NX;
                const bool all = cpxL >= slots;
                if (all || slot >= cpxL) convert_range(F, layer == 0 ? CV_M0 : (layer == 1 ? CV_M1 : CV_M2), layer == 0 ? CV_LA1 : (layer == 1 ? CV_GA2 : CV_LA3), all ? bidq : (slot - cpxL) * NX + xg, all ? F.G : (slots - cpxL) * NX); }
            SEAM(pb + 6);
        }
        if (PHON(13) && IN(pb + 9)) { PB(); ln2_phase(F, layer, Mpost); PE(13); SEAM(pb + 9); }
    }
    if ((PROBE_MASK >> 15) & 1) { XcdBarrier bq = bar; bq.bar = (unsigned*)opq((unsigned char*)bar.bar); xcd_barrier(bq, F.wave == 0 && lane_id() == 0);
        if (F.bid == PROBE_BID) { unsigned* pm_ = (unsigned*)(opq(F.ws) + WS_CTL) + 2048; for (int k = 0; k < NPH; ++k) { const unsigned v = __hip_atomic_load(pm_ + k, __ATOMIC_RELAXED, __HIP_MEMORY_SCOPE_AGENT); if (v) pacc += (1u << 20) - v; } } }
    if (PROBE_MASK && F.bid == PROBE_BID) { const unsigned long long tgt = RT() + (unsigned long long)PROBE_AMP * pacc; while (RT() < tgt) __builtin_amdgcn_s_sleep(16); }
#undef IN
#undef SEAM
}

extern "C" void kernel_launch(void* const* d_in, const int* in_sizes, int n_in, void* d_out, int out_size, void* d_ws, size_t ws_size, hipStream_t stream) {
    static int grid = 0;
    if (grid == 0) {
        if (n_in != 26 || out_size != NLAT * D || ws_size < WS_END) { fprintf(stderr, "kernel_launch: unexpected problem: n_in %d out %d ws %zu (need %zu)\n", n_in, out_size, ws_size, (size_t)WS_END); grid = -1; return; }
        int dev = 0, cus = 0, per_cu = 0;
        if (hipGetDevice(&dev) != hipSuccess || hipDeviceGetAttribute(&cus, hipDeviceAttributeMultiprocessorCount, dev) != hipSuccess) { grid = -1; return; }
        if (hipFuncSetAttribute((const void*)fwd, hipFuncAttributeMaxDynamicSharedMemorySize, LDS_BYTES) != hipSuccess) { fprintf(stderr, "kernel_launch: hipFuncSetAttribute failed\n"); grid = -1; return; }
        if (hipOccupancyMaxActiveBlocksPerMultiprocessor(&per_cu, (const void*)fwd, NWAVES * 64, LDS_BYTES) != hipSuccess || per_cu < 1) fprintf(stderr, "kernel_launch: occupancy query says %d\n", per_cu);
        (void)hipGetLastError();
        grid = cus;
    }
    if (grid < 0) return;
    if (hipMemsetAsync((char*)d_ws + WS_CTL, 0, CTL_ZERO_BYTES, stream) != hipSuccess) return;
    Args a{};
    for (int i = 0; i < 26; ++i) a.in[i] = (const float*)d_in[i];
    a.out = (float*)d_out; a.ws = (unsigned char*)d_ws;
#if MK_ONE_LAUNCH
    a.ph_lo = 0; a.ph_hi = NPH;
    hipLaunchKernelGGL(fwd, dim3(grid), dim3(NWAVES * 64), LDS_BYTES, stream, a);
#else
    for (int p = 0; p < NPH; ++p) { if (!phase_exists(p)) continue; a.ph_lo = p; a.ph_hi = p + 1; hipLaunchKernelGGL(fwd, dim3(grid), dim3(NWAVES * 64), LDS_BYTES, stream, a); }
#endif
}
```

```cpp
#include <hip/hip_runtime.h>
#include <cstdio>
#include <cstdint>

#ifndef ONLY
#define ONLY -1
#endif
#define PHON(x) (ONLY < 0 || ONLY == (x))
#ifndef PROBE_MASK
#define PROBE_MASK 0
#endif
#ifndef PROBE_SEAMSEL
#define PROBE_SEAMSEL 0xfff
#endif
#ifndef PROBE_BID
#define PROBE_BID 0
#endif
#ifndef PROBE_AMP
#define PROBE_AMP 4
#endif
#ifndef MK_ONE_LAUNCH
#define MK_ONE_LAUNCH 1
#endif

#define GAS __attribute__((address_space(1)))
#define LAS __attribute__((address_space(3)))
typedef unsigned short bf16;
typedef float f32x4 __attribute__((ext_vector_type(4)));
struct __attribute__((packed, aligned(4))) f32x3 { float x, y, z; };
typedef float f32x2 __attribute__((ext_vector_type(2)));
typedef short bf16x8 __attribute__((ext_vector_type(8)));
typedef unsigned u32x4 __attribute__((ext_vector_type(4)));
typedef unsigned u32x2 __attribute__((ext_vector_type(2)));
typedef short v4i16_t __attribute__((ext_vector_type(4)));

constexpr int D = 2048, NLAT = 8192, NCTX = 1024, NTOK = NLAT + NCTX, DEPTH = 4;
constexpr int LCAP = 9216;
constexpr float ALPHA = 1.681792830507429f;
constexpr float LN_EPS = 1e-5f, RMS_EPS = 1e-6f;
constexpr int MLIN = 6160;
constexpr int NWAVES = 8;

__device__ __forceinline__ unsigned f2bf(float f) { unsigned u = __builtin_bit_cast(unsigned, f); return (u + 0x7fffu + ((u >> 16) & 1u)) >> 16; }
typedef float f32x2_t __attribute__((ext_vector_type(2)));
typedef __bf16 bf16x2_t __attribute__((ext_vector_type(2)));
__device__ __forceinline__ unsigned pk2(float lo, float hi) { const f32x2_t v = {lo, hi}; const bf16x2_t b = __builtin_convertvector(v, bf16x2_t); return __builtin_bit_cast(unsigned, b); }
__device__ __forceinline__ float bf2f(unsigned short b) { return __builtin_bit_cast(float, ((unsigned)b) << 16); }
__device__ __forceinline__ float bflo(unsigned w) { return __builtin_bit_cast(float, w << 16); }
__device__ __forceinline__ float bfhi(unsigned w) { return __builtin_bit_cast(float, w & 0xffff0000u); }
__device__ __forceinline__ float sigm(float x) { return __builtin_amdgcn_rcpf(1.f + __expf(-x)); }
__device__ __forceinline__ float siluf(float x) { return x * sigm(x); }
__device__ __forceinline__ float gelu_tanh(float x) { return x * sigm(1.5957691216057308f * (x + 0.044715f * x * x * x)); }
template <int CTRL, int ROWMASK> __device__ __forceinline__ float dppz(float v, int zero) { return __builtin_bit_cast(float, __builtin_amdgcn_update_dpp(zero, __builtin_bit_cast(int, v), CTRL, ROWMASK, 0xf, false)); }
template <int CTRL, int ROWMASK> __device__ __forceinline__ float dpp0(float v) { return __builtin_bit_cast(float, __builtin_amdgcn_update_dpp(0, __builtin_bit_cast(int, v), CTRL, ROWMASK, 0xf, false)); }
__device__ __forceinline__ float wave_sum(float v) {
    v += dpp0<0x111, 0xf>(v); v += dpp0<0x112, 0xf>(v); v += dpp0<0x114, 0xf>(v); v += dpp0<0x118, 0xf>(v);
    v += dpp0<0x142, 0xa>(v); v += dpp0<0x143, 0xc>(v);
    return __builtin_bit_cast(float, __builtin_amdgcn_readlane(__builtin_bit_cast(int, v), 63));
}
__device__ __forceinline__ int permrow(int r) {
    if (r >= NLAT) return r; const int b = r & ~2047, s = r & 2047; return b + ((s & 63) << 5) + (s >> 6);
}
__device__ __forceinline__ int invpermrow(int r) {
    if (r >= NLAT) return r; const int b = r & ~2047, p = r & 2047; return b + ((p & 31) << 6) + (p >> 5);
}
__device__ __forceinline__ LAS unsigned char* vopq(LAS unsigned char* p) { asm volatile("" : "+v"(p)); return p; }
__device__ __forceinline__ int vopqi(int v) { asm volatile("" : "+v"(v)); return v; }
__device__ __forceinline__ int sopqi(int v) { asm volatile("" : "+s"(v)); return v; }
__device__ __forceinline__ int lane_id() { int l; asm volatile("v_mbcnt_lo_u32_b32 %0, -1, 0\n\tv_mbcnt_hi_u32_b32 %0, -1, %0" : "=v"(l)); return l; }
__device__ __forceinline__ float shfl_lane(float v, int src) { return __builtin_bit_cast(float, __builtin_amdgcn_ds_bpermute(src << 2, __builtin_bit_cast(int, v))); }
#define VM_WAIT() asm volatile("s_waitcnt vmcnt(0)" ::: "memory")
#define LDS_WAIT() asm volatile("s_waitcnt lgkmcnt(0)" ::: "memory")

namespace pg8 {
#define PG8_LAS __attribute__((address_space(3)))
constexpr int BM = 256, BK = 64, HALF = 128, HTB = HALF * BK * 2, STAGE_BYTES = 8 * HTB, NXCD = 8, WGM = 8;
__host__ __device__ __forceinline__ int lds_byte(int r, int c) { const int st = (r >> 4) * 2 + (c >> 5), rr = r & 15, cc = c & 31, ob = rr * 64 + cc * 2; return st * 1024 + (ob ^ (((ob >> 9) & 1) << 5)); }
__host__ __device__ __forceinline__ void stage_rc(int b, int& R, int& C) { const int st = b / 1024, sb = b % 1024, swz = sb ^ (((sb >> 9) & 1) << 5); R = (st >> 1) * 16 + swz / 64; C = (st & 1) * 32 + (swz % 64) / 2; }
__host__ __device__ __forceinline__ int perm32(int rho) { const int n = rho >> 4, i = rho & 15; return 8 * (i >> 2) + 4 * n + (i & 3); }

struct Unit { int pm, pn, e, rt, nv; };
struct Gemm { const bf16* A; const bf16* Bt; int K; size_t estride; const int* lst; };

struct StaticOrder {
    static constexpr bool SIGNAL = false;
    int nM, nN, nwg, G, c;
    __device__ void init(int M, int N, int G_, int c_) { nM = M / BM; nN = N / BM; nwg = nM * nN; G = G_; c = c_; }
    __device__ bool next(int i, Unit& u) const {
        const long L = (long)i * G + c; if (L >= nwg) return false;
        int wgid = (int)L; { const int q = nwg / NXCD, r = nwg % NXCD, xcd = wgid % NXCD, off = wgid / NXCD; wgid = (xcd < r ? xcd * (q + 1) : r * (q + 1) + (xcd - r) * q) + off; }
        const int nig = WGM * nN, gid = wgid / nig, fm = gid * WGM, gsz = (nM - fm) < WGM ? (nM - fm) : WGM;
        u.pm = __builtin_amdgcn_readfirstlane(fm + ((wgid % nig) % gsz)); u.pn = __builtin_amdgcn_readfirstlane((wgid % nig) / gsz); u.e = 0; u.rt = 0; u.nv = 256; return true;
    }
};
template <bool SIG> struct PlanOrderT {
    static constexpr bool SIGNAL = SIG;
    const PG8_LAS int* arr; int N, cs, W, sl, x, cpx; unsigned* done; PG8_LAS unsigned* wcnt;
    __device__ __forceinline__ bool next(int i, Unit& u) const {
        if (sl < 0) return false;
        const int li = sl + i * W; if (li >= cpx) return false;
        const int L = x * cpx + li; if (L >= N) return false;
        const int info = __builtin_amdgcn_readfirstlane(arr[L >> cs]);
        u.e = info & 15; u.rt = (info >> 4) & 127; u.nv = (info >> 11) & 511; u.pm = (info >> 20) & 127; u.pn = L & ((1 << cs) - 1); return true;
    }
    __device__ __forceinline__ int tile_at(int i) const {
        if (sl < 0) return -1;
        const int li = sl + i * W; if (li >= cpx) return -1;
        const int L = x * cpx + li; if (L >= N) return -1;
        return (arr[L >> cs] >> 20) & 127;
    }
    __device__ __forceinline__ void signal(const Unit& u, int ui, int lane) const {
        asm volatile("s_waitcnt vmcnt(0)" ::: "memory");
        if (lane == 0) {
            const unsigned old = __hip_atomic_fetch_add(wcnt, 1u, __ATOMIC_RELAXED, __HIP_MEMORY_SCOPE_WORKGROUP);
            if (old == 8u * (unsigned)ui + 7u) { __builtin_amdgcn_fence(__ATOMIC_RELEASE, "agent"); __hip_atomic_fetch_add(done + 16 * u.pm, 1u, __ATOMIC_RELAXED, __HIP_MEMORY_SCOPE_AGENT); }
        }
    }
};
using PlanOrder = PlanOrderT<false>; using PlanOrderSig = PlanOrderT<true>;
template <int AMODE> __device__ __forceinline__ void a_off(const Gemm& g, const Unit& u, int R0, int C0, int R1, int C1, unsigned (&h0)[2], unsigned (&h1)[2]) {
    const int K = g.K;
    if constexpr (AMODE == 0) {
        h0[0] = (unsigned)(R0 * K + C0) * 2u; h0[1] = (unsigned)(R1 * K + C1) * 2u;
        h1[0] = (unsigned)((R0 + HALF) * K + C0) * 2u; h1[1] = (unsigned)((R1 + HALF) * K + C1) * 2u;
    } else {
        const int* l = g.lst + u.e * LCAP + u.rt * 256;
        const int v00 = l[R0 < u.nv ? R0 : 0], v01 = l[R1 < u.nv ? R1 : 0], v10 = l[(R0 + HALF) < u.nv ? R0 + HALF : 0], v11 = l[(R1 + HALF) < u.nv ? R1 + HALF : 0];
        const int t00 = R0 < u.nv ? (v00 >> 1) : 0, t01 = R1 < u.nv ? (v01 >> 1) : 0;
        const int t10 = (R0 + HALF) < u.nv ? (v10 >> 1) : 0, t11 = (R1 + HALF) < u.nv ? (v11 >> 1) : 0;
        h0[0] = (unsigned)(t00 * K + C0) * 2u; h0[1] = (unsigned)(t01 * K + C1) * 2u;
        h1[0] = (unsigned)(t10 * K + C0) * 2u; h1[1] = (unsigned)(t11 * K + C1) * 2u;
    }
}

template <class Epi, class Sched, int AMODE>
__device__ __forceinline__ void gemm_phase(PG8_LAS unsigned char* lds, const Gemm g, const Sched& S, const Epi& E, int wave_id) {
    const int wid = sopqi(wave_id), lane = vopqi(lane_id()), tid = wid * 64 + lane, wr = wid >> 2, wc = wid & 3, fr = lane & 15, fq = lane >> 4;
    const int K = g.K, nt = K / BK;
    int R0, C0, R1, C1; stage_rc(tid * 16, R0, C0); stage_rc(tid * 16 + 8192, R1, C1);
    unsigned voffB[2];
    { const int Rb0 = Epi::PERM ? ((R0 & ~31) + perm32(R0 & 31)) : R0, Rb1 = Epi::PERM ? ((R1 & ~31) + perm32(R1 & 31)) : R1;
      voffB[0] = (unsigned)(Rb0 * K + C0) * 2u; voffB[1] = (unsigned)(Rb1 * K + C1) * 2u; }
    const size_t kstep = (size_t)(BK * 2);
    const size_t hstep = (size_t)HALF * K * 2;
    const size_t tstep = 2 * hstep;
    const unsigned ldsw = (unsigned)wid * 1024u;
    const int aoff = lds_byte(wr * 64 + fr, fq * 8), boff = lds_byte(wc * 32 + fr, fq * 8);
#define PG8_SA(b, h) (((b) * 2 + (h)) * HTB)
#define PG8_SB(b, h) ((4 + (b) * 2 + (h)) * HTB)
#define PG8_STAGE(bufoff, gbase, voff) do { _Pragma("unroll") for (int _i = 0; _i < 2; ++_i) \
        __builtin_amdgcn_global_load_lds((const unsigned*)((const char*)(gbase) + (voff)[_i]), (PG8_LAS unsigned*)(lds + (bufoff) + ldsw + _i * 8192), 16, 0, 0); } while (0)
#define PG8_LDA(dst, b, h) do { _Pragma("unroll") for (int m = 0; m < 4; ++m) _Pragma("unroll") for (int k = 0; k < 2; ++k) dst[m][k] = *(const PG8_LAS bf16x8*)(lds + PG8_SA(b, h) + aoff + m * 2048 + k * 1024); } while (0)
#define PG8_LDB(dst, b, h) do { _Pragma("unroll") for (int n = 0; n < 2; ++n) _Pragma("unroll") for (int k = 0; k < 2; ++k) dst[n][k] = *(const PG8_LAS bf16x8*)(lds + PG8_SB(b, h) + boff + n * 2048 + k * 1024); } while (0)
#define PG8_MMA(ai, bj, At, Bt) do { __builtin_amdgcn_s_setprio(1); _Pragma("unroll") for (int m = 0; m < 4; ++m) _Pragma("unroll") for (int n = 0; n < 2; ++n) _Pragma("unroll") for (int k = 0; k < 2; ++k) \
        acc[ai][bj][m][n] = __builtin_amdgcn_mfma_f32_16x16x32_bf16(Bt[n][k], At[m][k], acc[ai][bj][m][n], 0, 0, 0); __builtin_amdgcn_s_setprio(0); } while (0)
#define PG8_WAIT_V(n) asm volatile("s_waitcnt vmcnt(" #n ")" ::: "memory")
#define PG8_WAIT_L(n) asm volatile("s_waitcnt lgkmcnt(" #n ")" ::: "memory")
#define PG8_BAR __builtin_amdgcn_s_barrier()
#define PG8_SCHED __builtin_amdgcn_sched_barrier(0)
    Unit cur, nxt; int ui = 0;
    if (!S.next(0, cur)) return;
    f32x4 acc[2][2][4][2];
#pragma unroll
    for (int a = 0; a < 2; ++a)
#pragma unroll
        for (int b = 0; b < 2; ++b)
#pragma unroll
            for (int m = 0; m < 4; ++m)
#pragma unroll
                for (int n = 0; n < 2; ++n) acc[a][b][m][n] = (f32x4){0.f, 0.f, 0.f, 0.f};
    bf16x8 At[4][2], B0[2][2], B1[2][2];
    unsigned vh0[2], vh1[2];
    const char* cA = AMODE ? (const char*)g.A : (const char*)g.A + (size_t)cur.pm * tstep;
    const char* cB = (const char*)g.Bt + (size_t)cur.e * g.estride + (size_t)cur.pn * tstep;
    PG8_STAGE(PG8_SB(0, 0), cB, voffB); PG8_STAGE(PG8_SB(0, 1), cB + hstep, voffB);
    a_off<AMODE>(g, cur, R0, C0, R1, C1, vh0, vh1);
    PG8_STAGE(PG8_SA(0, 0), cA, vh0); PG8_STAGE(PG8_SA(0, 1), cA, vh1);
    if (wr == 1) PG8_BAR;
    PG8_WAIT_V(2); PG8_BAR;
    PG8_STAGE(PG8_SB(1, 0), cB + kstep, voffB); PG8_STAGE(PG8_SA(1, 0), cA + kstep, vh0); PG8_STAGE(PG8_SB(1, 1), cB + hstep + kstep, voffB);
    PG8_WAIT_V(6); PG8_BAR;
    for (;;) {
        const bool has_next = S.next(ui + 1, nxt);
        const char* nA = cA; const char* nB = cB;
        if (has_next) {
            nA = AMODE ? (const char*)g.A : (const char*)g.A + (size_t)nxt.pm * tstep;
            nB = (const char*)g.Bt + (size_t)nxt.e * g.estride + (size_t)nxt.pn * tstep;
            if constexpr (AMODE != 0) { if (tid < 256) { const int* l = g.lst + nxt.e * LCAP + nxt.rt * 256; const int tv = l[(unsigned)(tid < nxt.nv ? tid : 0)]; ((PG8_LAS unsigned*)(lds + STAGE_BYTES))[tid] = (unsigned)((tid < nxt.nv ? (tv >> 1) : 0) * K) * 2u; } }
        }
        for (int t = 0; t < nt; t += 2) {
            const bool last = (t == nt - 2);
            const char* a1 = cA + (size_t)(t + 1) * kstep;
            const char* a2 = last ? nA : cA + (size_t)(t + 2) * kstep; const char* b2 = last ? nB : cB + (size_t)(t + 2) * kstep;
            const char* a3 = a2 + kstep; const char* b3 = b2 + kstep;
            PG8_LDB(B0, 0, 0); PG8_LDB(B1, 0, 1); PG8_SCHED; PG8_LDA(At, 0, 0); PG8_STAGE(PG8_SA(1, 1), a1, vh1);
            if constexpr (AMODE != 0) { if (last && has_next) { const PG8_LAS unsigned* gt = (const PG8_LAS unsigned*)(lds + STAGE_BYTES);
                vh0[0] = gt[R0] + (unsigned)C0 * 2u; vh0[1] = gt[R1] + (unsigned)C1 * 2u; vh1[0] = gt[R0 + HALF] + (unsigned)C0 * 2u; vh1[1] = gt[R1 + HALF] + (unsigned)C1 * 2u; } }
            PG8_WAIT_V(8); PG8_WAIT_L(0); PG8_BAR; PG8_MMA(0, 0, At, B0); PG8_MMA(0, 1, At, B1); PG8_BAR; PG8_SCHED;
            PG8_LDA(At, 0, 1); PG8_STAGE(PG8_SB(0, 0), b2, voffB); PG8_STAGE(PG8_SB(0, 1), b2 + hstep, voffB); PG8_STAGE(PG8_SA(0, 0), a2, vh0);
            PG8_WAIT_V(8); PG8_WAIT_L(0); PG8_BAR; PG8_MMA(1, 0, At, B0); PG8_MMA(1, 1, At, B1); PG8_BAR; PG8_SCHED;
            PG8_LDB(B0, 1, 0); PG8_LDB(B1, 1, 1); PG8_SCHED; PG8_LDA(At, 1, 0); PG8_STAGE(PG8_SA(0, 1), a2, vh1);
            PG8_WAIT_V(8); PG8_WAIT_L(0); PG8_BAR; PG8_MMA(0, 0, At, B0); PG8_MMA(0, 1, At, B1); PG8_BAR; PG8_SCHED;
            PG8_LDA(At, 1, 1); PG8_STAGE(PG8_SB(1, 0), b3, voffB); PG8_STAGE(PG8_SB(1, 1), b3 + hstep, voffB); PG8_STAGE(PG8_SA(1, 0), a3, vh0);
            PG8_WAIT_V(8); PG8_WAIT_L(0); PG8_BAR; PG8_MMA(1, 0, At, B0); PG8_MMA(1, 1, At, B1); PG8_BAR; PG8_SCHED;
        }
        if (wr == 0) PG8_BAR;
        E(acc, cur, wr, wc, fr, fq);
        if constexpr (Sched::SIGNAL) S.signal(cur, ui, lane);
        if (!has_next) break;
#pragma unroll
        for (int a = 0; a < 2; ++a)
#pragma unroll
            for (int b = 0; b < 2; ++b)
#pragma unroll
                for (int m = 0; m < 4; ++m)
#pragma unroll
                    for (int n = 0; n < 2; ++n) acc[a][b][m][n] = (f32x4){0.f, 0.f, 0.f, 0.f};
        cur = nxt; cA = nA; cB = nB; ++ui;
        if (wr == 1) PG8_BAR;
    }
    PG8_WAIT_V(0);
    PG8_BAR;
#undef PG8_SA
#undef PG8_SB
#undef PG8_STAGE
#undef PG8_LDA
#undef PG8_LDB
#undef PG8_MMA
#undef PG8_WAIT_V
#undef PG8_WAIT_L
#undef PG8_BAR
#undef PG8_SCHED
}
}
using pg8::Unit;

constexpr size_t MiB = 1u << 20;
constexpr size_t WS_CTL = 0, CTL_ZERO_BYTES = 128 * 1024;
constexpr size_t WS_MOD = 1 * MiB;
constexpr size_t WS_VST = 2 * MiB;
constexpr size_t WS_G = 5 * MiB;
constexpr size_t WS_TOKL = 6 * MiB;
constexpr size_t WS_WL = 7 * MiB;
constexpr size_t WS_WSB = 8 * MiB;
constexpr size_t WS_GS = 9 * MiB;
constexpr size_t WS_WR = 10 * MiB;
constexpr size_t WS_RC = 13 * MiB;
constexpr size_t WS_RP = 552 * MiB;
constexpr size_t WS_WGIN = 16 * MiB;
constexpr size_t WS_WGOUT = 48 * MiB;
constexpr size_t WS_WMIN = 966 * MiB;
constexpr size_t WS_WMOUT = 112 * MiB;
constexpr size_t WS_WEGU = 128 * MiB;
constexpr size_t WS_WED = 384 * MiB;
constexpr size_t WS_X = 512 * MiB;
constexpr size_t WS_HT = 584 * MiB;
constexpr size_t WS_A1 = 620 * MiB;
constexpr size_t WS_A2 = 656 * MiB;
constexpr size_t WS_A3 = 692 * MiB;
constexpr size_t WS_A4 = 728 * MiB;
constexpr size_t WS_HSF = 764 * MiB;
constexpr size_t WS_HSB = 800 * MiB;
constexpr size_t WS_ZL = 836 * MiB;
constexpr size_t WS_HM = 872 * MiB;
constexpr size_t WS_YM = 894 * MiB;
constexpr size_t WS_END = 1018 * MiB;
constexpr int CW_BAR = 4096;
constexpr int CW_CNT = 16384;

struct EpiGA {
    static constexpr bool PERM = true;
    bf16* U; bf16* V; float* vst;
    __device__ __forceinline__ void operator()(const f32x4 (&acc)[2][2][4][2], const Unit& u, int wr, int wc, int fr, int fq) const {
        const bool isv = u.pn >= 8; bf16* base = isv ? V : U;
        const int col0 = (u.pn & 7) * 256 + wc * 32 + 8 * fq, row0 = u.pm * 256 + wr * 64 + fr;
#pragma unroll
        for (int ai = 0; ai < 2; ++ai)
#pragma unroll
            for (int m = 0; m < 4; ++m) {
                const int row = row0 + ai * 128 + m * 16; float s = 0.f, q = 0.f; bf16* rp = base + (size_t)row * D + col0;
#pragma unroll
                for (int bj = 0; bj < 2; ++bj) {
                    f32x4 a = acc[ai][bj][m][0], b = acc[ai][bj][m][1];
#pragma unroll
                    for (int j = 0; j < 4; ++j) { a[j] = gelu_tanh(a[j]); b[j] = gelu_tanh(b[j]); s += a[j] + b[j]; q += a[j] * a[j] + b[j] * b[j]; }
                    u32x4 w; w.x = pk2(a[0], a[1]); w.y = pk2(a[2], a[3]); w.z = pk2(b[0], b[1]); w.w = pk2(b[2], b[3]);
                    *(u32x4*)(rp + bj * 128) = w;
                }
                if (isv) { const int ln = 16 * fq + fr; s += shfl_lane(s, ln ^ 16); s += shfl_lane(s, ln ^ 32); q += shfl_lane(q, ln ^ 16); q += shfl_lane(q, ln ^ 32);
                    if (fq == 0) *(f32x2*)(vst + ((size_t)row * 32 + (u.pn - 8) * 4 + wc) * 2) = (f32x2){s, q}; }
            }
    }
};
struct EpiLA {
    static constexpr bool PERM = true;
    unsigned char* ws; const float* gate_b; int perm;
    __device__ __forceinline__ void operator()(const f32x4 (&acc)[2][2][4][2], const Unit& u, int wr, int wc, int fr, int fq) const {
        const int seg = u.pn >> 3, row0 = u.pm * 256 + wr * 64 + fr;
        if (seg == 3) {
            if (wc == 0 && fq < 2) { float* G = (float*)(ws + WS_G); const f32x4 b0 = *(const f32x4*)(gate_b + 8 * fq), b1 = *(const f32x4*)(gate_b + 8 * fq + 4);
#pragma unroll
                for (int ai = 0; ai < 2; ++ai)
#pragma unroll
                    for (int m = 0; m < 4; ++m) { const int row = row0 + ai * 128 + m * 16, drow = perm ? permrow(row) : row; float* gp = G + (size_t)drow * 16 + 8 * fq;
                        *(f32x4*)gp = acc[ai][0][m][0] + b0; *(f32x4*)(gp + 4) = acc[ai][0][m][1] + b1; } }
            return; }
        bf16* base = (bf16*)(ws + WS_A1 + (size_t)seg * (WS_A3 - WS_A1) - (seg == 2 ? (WS_A3 - WS_A1) - (WS_A4 - WS_A3) : 0));
        const int col0 = (u.pn & 7) * 256 + wc * 32 + 8 * fq;
#pragma unroll
        for (int ai = 0; ai < 2; ++ai)
#pragma unroll
            for (int m = 0; m < 4; ++m) {
                const int row = row0 + ai * 128 + m * 16, drow = perm ? permrow(row) : row; bf16* rp = base + (size_t)drow * D + col0;
#pragma unroll
                for (int bj = 0; bj < 2; ++bj) {
                    f32x4 a = acc[ai][bj][m][0], b = acc[ai][bj][m][1];
                    if (seg == 2) {
#pragma unroll
                        for (int j = 0; j < 4; ++j) { a[j] = sigm(a[j]); b[j] = sigm(b[j]); } }
                    u32x4 w; w.x = pk2(a[0], a[1]); w.y = pk2(a[2], a[3]); w.z = pk2(b[0], b[1]); w.w = pk2(b[2], b[3]);
                    *(u32x4*)(rp + bj * 128) = w;
                }
            }
    }
};
struct EpiRes {
    static constexpr bool PERM = true;
    bf16* X; const float* g1base; int unperm;
    const bf16* wr; float* rp;
    __device__ __forceinline__ void operator()(const f32x4 (&acc)[2][2][4][2], const Unit& u, int wr_, int wc, int fr, int fq) const {
        const int mi = u.pm < 32 ? (u.pm >> 3) : 4; const float* g1 = g1base + (size_t)mi * 12288;
        const int col0 = u.pn * 256 + wc * 32 + 8 * fq, row0 = u.pm * 256 + wr_ * 64 + fr;
        f32x4 gv[2][2]; bf16x8 bh[2], bl[2];
        const bf16* wb = wr + (size_t)(mi * 32 + fr) * D + col0;
#pragma unroll
        for (int bj = 0; bj < 2; ++bj) {
#pragma unroll
            for (int n = 0; n < 2; ++n) gv[bj][n] = *(const f32x4*)(g1 + col0 + bj * 128 + n * 4);
            bh[bj] = *(const bf16x8*)(wb + bj * 128); bl[bj] = *(const bf16x8*)(wb + 16 * D + bj * 128); }
        float* const pp = rp + (u.pn * 4 + wc) * 16 + fr;
        const bool pz = unperm && u.pm < 32;
        const int s1 = pz ? 1024 : 16, s2 = pz ? 1 : 32, s3 = pz ? 4 : 128;
        const int rbase = pz ? ((u.pm & ~7) * 256 + (fr << 6) + (u.pm & 7) * 8 + wr_ * 2) : row0;
        bf16* const xb = X + (unsigned)(rbase * D + col0);
        u32x4 xa[4][2], ob[4][2];
#define ER_LOAD(ai) _Pragma("unroll") for (int m = 0; m < 4; ++m) { const bf16* xp = xb + (unsigned)(((m & 1) * s1 + (m >> 1) * s2 + (ai) * s3) * D); \
            xa[m][0] = *(const u32x4*)xp; xa[m][1] = *(const u32x4*)(xp + 128); }
#define ER_COMP(ai) _Pragma("unroll") for (int m = 0; m < 4; ++m) _Pragma("unroll") for (int bj = 0; bj < 2; ++bj) { const u32x4 xin = xa[m][bj]; \
            const f32x4 a = (f32x4){bflo(xin.x), bfhi(xin.x), bflo(xin.y), bfhi(xin.y)} * ALPHA + gv[bj][0] * acc[ai][bj][m][0]; \
            const f32x4 b = (f32x4){bflo(xin.z), bfhi(xin.z), bflo(xin.w), bfhi(xin.w)} * ALPHA + gv[bj][1] * acc[ai][bj][m][1]; \
            u32x4 o; o.x = pk2(a[0], a[1]); o.y = pk2(a[2], a[3]); o.z = pk2(b[0], b[1]); o.w = pk2(b[2], b[3]); ob[m][bj] = o; }
#define ER_EMIT(ai) _Pragma("unroll") for (int m = 0; m < 4; ++m) { bf16* xp = xb + (unsigned)(((m & 1) * s1 + (m >> 1) * s2 + (ai) * s3) * D); \
            f32x4 pl = (f32x4){0.f, 0.f, 0.f, 0.f}; \
            _Pragma("unroll") for (int bj = 0; bj < 2; ++bj) { *(u32x4*)(xp + bj * 128) = ob[m][bj]; const bf16x8 af = __builtin_bit_cast(bf16x8, ob[m][bj]); \
                pl = __builtin_amdgcn_mfma_f32_16x16x32_bf16(af, bh[bj], pl, 0, 0, 0); pl = __builtin_amdgcn_mfma_f32_16x16x32_bf16(af, bl[bj], pl, 0, 0, 0); } \
            const int rb0 = u.pm * 256 + wr_ * 64 + (ai) * 128 + m * 16 + 4 * fq;       \
            _Pragma("unroll") for (int reg = 0; reg < 4; ++reg) pp[(unsigned)((rb0 + reg) * 512)] = pl[reg]; }
        ER_LOAD(0); ER_COMP(0); ER_LOAD(1); ER_EMIT(0); ER_COMP(1); ER_EMIT(1);
#undef ER_LOAD
#undef ER_COMP
#undef ER_EMIT
    }
};
struct EpiMoE1 {
    static constexpr bool PERM = true;
    bf16* Hm; const float* wl;
    __device__ __forceinline__ void operator()(const f32x4 (&acc)[2][2][4][2], const Unit& u, int wr, int wc, int fr, int fq) const {
        const int col0 = u.pn * 128 + wc * 32 + 8 * fq; const float* wp = wl + u.e * LCAP + u.rt * 256;
        float wv[2][4];
#pragma unroll
        for (int ai = 0; ai < 2; ++ai)
#pragma unroll
            for (int m = 0; m < 4; ++m) { const int rl = ai * 128 + wr * 64 + m * 16 + fr; wv[ai][m] = wp[rl < u.nv ? rl : 0]; }
#pragma unroll
        for (int ai = 0; ai < 2; ++ai)
#pragma unroll
            for (int m = 0; m < 4; ++m) {
                const int rl = ai * 128 + wr * 64 + m * 16 + fr;
                if (rl < u.nv) {
                    const float w = wv[ai][m]; f32x4 g0 = acc[ai][0][m][0], g1 = acc[ai][0][m][1]; const f32x4 u0 = acc[ai][1][m][0], u1 = acc[ai][1][m][1];
#pragma unroll
                    for (int j = 0; j < 4; ++j) { g0[j] = siluf(g0[j]) * u0[j] * w; g1[j] = siluf(g1[j]) * u1[j] * w; }
                    u32x4 o; o.x = pk2(g0[0], g0[1]); o.y = pk2(g0[2], g0[3]); o.z = pk2(g1[0], g1[1]); o.w = pk2(g1[2], g1[3]);
                    *(u32x4*)(Hm + (size_t)(u.pm * 256 + rl) * 512 + col0) = o;
                }
            }
    }
};
struct EpiMoE2 {
    static constexpr bool PERM = true;
    bf16* YM; const int* lst;
    __device__ __forceinline__ void operator()(const f32x4 (&acc)[2][2][4][2], const Unit& u, int wr, int wc, int fr, int fq) const {
        const int col0 = u.pn * 256 + wc * 32 + 8 * fq; const int* lp = lst + u.e * LCAP + u.rt * 256;
        int tkv[2][4];
#pragma unroll
        for (int ai = 0; ai < 2; ++ai)
#pragma unroll
            for (int m = 0; m < 4; ++m) { const int rl = ai * 128 + wr * 64 + m * 16 + fr; tkv[ai][m] = lp[rl < u.nv ? rl : 0]; }
#pragma unroll
        for (int ai = 0; ai < 2; ++ai)
#pragma unroll
            for (int m = 0; m < 4; ++m) {
                const int rl = ai * 128 + wr * 64 + m * 16 + fr;
                if (rl < u.nv) {
                    const int tk = tkv[ai][m]; bf16* rp = YM + (size_t)tk * D + col0;
#pragma unroll
                    for (int bj = 0; bj < 2; ++bj) { const f32x4 a = acc[ai][bj][m][0], b = acc[ai][bj][m][1];
                        u32x4 o; o.x = pk2(a[0], a[1]); o.y = pk2(a[2], a[3]); o.z = pk2(b[0], b[1]); o.w = pk2(b[2], b[3]);
                        *(u32x4*)(rp + bj * 128) = o; }
                }
            }
    }
};

constexpr int LDS_BYTES = 155648, MISC_OFF = LDS_BYTES - 512, PTAB_OFF = LDS_BYTES - 256;

#define XB_TMO      128
#define XB_XCNT(j)  (256  + 64 * (j))
#define XB_XSUB(j)  (1280 + 64 * (j))
#define XB_XGEN(j)  (2304 + 64 * (j))
#define XB_TOP      3328
#define XB_TOPGEN   3392
#define XCD_BAR_WORDS 3456
#define XB_SPIN_CAP (1u << 18)
__device__ __forceinline__ unsigned xb_ld(unsigned* p)              { return __hip_atomic_load(p, __ATOMIC_RELAXED, __HIP_MEMORY_SCOPE_AGENT); }
__device__ __forceinline__ unsigned xb_add(unsigned* p, unsigned v) { return __hip_atomic_fetch_add(p, v, __ATOMIC_RELAXED, __HIP_MEMORY_SCOPE_AGENT); }
__device__ __forceinline__ unsigned xb_xcc_id() { return (unsigned)__builtin_amdgcn_s_getreg((3 << 11) | 20) & 0xFu; }
#define XB_SPIN(cond, bar) do { unsigned _sp = 0; while (cond) { __builtin_amdgcn_s_sleep(1); \
    if ((++_sp & 255u) == 0u) { if (xb_ld(&(bar)[XB_TMO])) break; if (_sp > XB_SPIN_CAP) { atomicAdd(&(bar)[XB_TMO], 1u); break; } } } } while (0)
struct XcdBarrier { unsigned* bar; unsigned x; volatile LAS unsigned* st; };
__device__ __forceinline__ XcdBarrier xcd_barrier_post(unsigned* bar, volatile LAS unsigned* st, bool t0) {
    XcdBarrier b; b.bar = bar; b.x = xb_xcc_id(); b.st = st;
    if (t0) (void)xb_add(&bar[XB_XCNT(b.x)], 1u);
    return b;
}
__device__ __forceinline__ void xcd_barrier_complete(unsigned* bar, unsigned x, unsigned& nloc, unsigned& nx) {
    const unsigned G = gridDim.x * gridDim.y * gridDim.z;
    unsigned sum, cnt, mine, sp = 0u;
    for (;;) {
        sum = 0u; cnt = 0u; mine = 0u;
#pragma unroll
        for (unsigned j = 0; j < 16; ++j) { const unsigned c = xb_ld(&bar[XB_XCNT(j)]); sum += c; cnt += (c > 0u) ? 1u : 0u; mine = (j == x) ? c : mine; }
        if (sum == G) break;
        __builtin_amdgcn_s_sleep(1);
        if ((++sp & 255u) == 0u) { if (xb_ld(&bar[XB_TMO])) break; if (sp > XB_SPIN_CAP) { atomicAdd(&bar[XB_TMO], 1u); break; } }
    }
    nloc = mine > 0u ? mine : 1u; nx = cnt > 0u ? cnt : 1u;
}
__device__ __forceinline__ void xcd_barrier(const XcdBarrier& b, bool t0) {
    asm volatile("s_waitcnt vmcnt(0)" ::: "memory");
    __syncthreads();
    if (t0) {
        unsigned* bar = b.bar;
        __builtin_amdgcn_s_waitcnt(0);
        unsigned nloc = b.st[0], nx = b.st[1];
        if (nloc == 0u) { xcd_barrier_complete(bar, b.x, nloc, nx); b.st[0] = nloc; b.st[1] = nx; }
        const unsigned old = xb_add(&bar[XB_XSUB(b.x)], 1u);
        const unsigned gen = old / nloc;
        if (old + 1u == (gen + 1u) * nloc) {
            __builtin_amdgcn_fence(__ATOMIC_RELEASE, "agent");
            asm volatile("s_waitcnt vmcnt(0)" ::: "memory");
            asm volatile("buffer_inv sc1" ::: "memory");
            const unsigned og = xb_add(&bar[XB_TOP], 1u);
            const unsigned tg = og / nx;
            if (og + 1u == (tg + 1u) * nx) xb_add(&bar[XB_TOPGEN], 1u);
            else XB_SPIN(xb_ld(&bar[XB_TOPGEN]) == tg, bar);
            xb_add(&bar[XB_XGEN(b.x)], 1u);
            asm volatile("s_waitcnt vmcnt(0)" ::: "memory");
        } else {
            asm volatile("buffer_inv sc1" ::: "memory");
            XB_SPIN(xb_ld(&bar[XB_XGEN(b.x)]) == gen, bar);
            asm volatile("s_waitcnt vmcnt(0)" ::: "memory");
        }
    }
    __syncthreads();
}

struct Args { const float* in[26]; float* out; unsigned char* ws; int ph_lo, ph_hi; };
struct Frame {
    LAS unsigned char* lds; int tid, lane, wave, G, bid;
    unsigned char* ws; float* out;
};
__device__ __forceinline__ const float* inp(const Frame& F, int i) {
    const LAS unsigned* t = (const LAS unsigned*)(F.lds + PTAB_OFF) + 2 * i;
    const unsigned lo = (unsigned)__builtin_amdgcn_readfirstlane((int)t[0]), hi = (unsigned)__builtin_amdgcn_readfirstlane((int)t[1]);
    return (const float*)(const GAS float*)(((unsigned long long)hi << 32) | lo);
}
__device__ __forceinline__ unsigned char* opq(unsigned char* p) { GAS unsigned char* g = (GAS unsigned char*)p; asm volatile("" : "+s"(g)); return (unsigned char*)g; }

enum { I_X = 0, I_C, I_CTX, I_CCTX, I_ADAW, I_ADAB, I_GMWIN, I_GMLNG, I_GMLNB, I_GMWS, I_GMBS, I_GMWOUT, I_MLWIN, I_MLCONV, I_MLGB, I_MLNG, I_MLWOUT,
       I_LN1G, I_LN1B, I_LN2G, I_LN2B, I_RW, I_RB, I_EXG, I_EXU, I_EXD };

__device__ __forceinline__ void p0_transpose_item(const float* W, int ldw, int Kout, bf16* WT, int out_row0, LAS float* scr, int k0, int n0, int lane) {
#pragma unroll 8
    for (int i = 0; i < 32; ++i) { const int kk = 2 * i + (lane >> 5); scr[kk * 33 + (lane & 31)] = W[(size_t)(k0 + kk) * ldw + n0 + (lane & 31)]; }
    LDS_WAIT(); asm volatile("" ::: "memory");
    const int c = lane & 7;
#pragma unroll
    for (int j = 0; j < 4; ++j) { const int n = (lane >> 3) + 8 * j; const LAS float* s = scr + (8 * c) * 33 + n;
        u32x4 o; o.x = pk2(s[0 * 33], s[1 * 33]); o.y = pk2(s[2 * 33], s[3 * 33]); o.z = pk2(s[4 * 33], s[5 * 33]); o.w = pk2(s[6 * 33], s[7 * 33]);
        *(u32x4*)(WT + (size_t)(out_row0 + n) * Kout + k0 + 8 * c) = o; }
    LDS_WAIT(); asm volatile("" ::: "memory");
}
constexpr int CV_B0 = 0, CV_B1 = 30720, CV_B2 = 63488, CV_B3 = 94208, CV_END = 126976;
constexpr int CV_GA0 = 4096, CV_GC0 = 18096, CV_M0 = 35096, CV_LA1 = 43696, CV_LC1 = 52696, CV_M1 = 69696, CV_GA2 = 78296, CV_GC2 = 92296, CV_M2 = 109296, CV_LA3 = 117896, CV_P0B = 126976;
struct CvItem { const float* src; bf16* dst; int ldw, kout; };
__device__ __forceinline__ CvItem cv_decode(const Frame& F, unsigned char* ws, int seq) {
    const int blk = seq >= CV_B3 ? 3 : (seq >= CV_B2 ? 2 : (seq >= CV_B1 ? 1 : 0)), idx = blk >> 1;
    int r = seq - (blk == 3 ? CV_B3 : (blk == 2 ? CV_B2 : (blk == 1 ? CV_B1 : 0)));
    const int n_in = (blk & 1) ? 6144 : 4096;
    const float* W; bf16* WT; int ldw, kout, orow, k0, n0;
    if (r < n_in) {
        if (blk & 1) { W = inp(F, I_MLWIN) + (size_t)idx * D * MLIN; ldw = MLIN; kout = D; WT = (bf16*)(ws + WS_WMIN) + (size_t)idx * 6400 * D; n0 = (r % 192) * 32; k0 = (r / 192) * 64; orow = n0; }
        else { W = inp(F, I_GMWIN) + (size_t)idx * D * 4096; ldw = 4096; kout = D; WT = (bf16*)(ws + WS_WGIN) + (size_t)idx * 4096 * D; n0 = (r & 127) * 32; k0 = (r >> 7) * 64; orow = n0; }
    } else if (r < n_in + 2048) { r -= n_in; W = inp(F, (blk & 1) ? I_MLWOUT : I_GMWOUT) + (size_t)idx * D * D; ldw = D; kout = D; WT = (bf16*)(ws + ((blk & 1) ? WS_WMOUT : WS_WGOUT)) + (size_t)idx * D * D; n0 = (r & 63) * 32; k0 = (r >> 6) * 64; orow = n0;
    } else { r -= n_in + 2048; const int which = r >> 13, rr = r & 8191, le = blk * 16 + (rr >> 9), q = rr & 511;
        if (which < 2) { n0 = (q & 15) * 32; k0 = (q >> 4) * 64; W = inp(F, which ? I_EXU : I_EXG) + (size_t)le * D * 512; ldw = 512; kout = D; WT = (bf16*)(ws + WS_WEGU) + (size_t)le * 1024 * D; orow = (n0 >> 7) * 256 + (n0 & 127) + which * 128; }
        else { n0 = (q & 63) * 32; k0 = (q >> 6) * 64; W = inp(F, I_EXD) + (size_t)le * 512 * D; ldw = D; kout = 512; WT = (bf16*)(ws + WS_WED) + (size_t)le * D * 512; orow = n0; } }
    CvItem it; it.src = W + (size_t)k0 * ldw + n0; it.dst = WT + (size_t)orow * kout + k0; it.ldw = ldw; it.kout = kout; return it;
}
__device__ __forceinline__ void cv_load(const CvItem& it, int lane, float (&v)[32]) {
    const float* p = it.src + (unsigned)((lane >> 5) * it.ldw + (lane & 31));
#pragma unroll
    for (int i = 0; i < 32; ++i) v[i] = __builtin_nontemporal_load(p + (unsigned)(2 * i * it.ldw));
}
__device__ __forceinline__ void cv_store(const CvItem& it, int lane, LAS float* scr, const float (&v)[32]) {
#pragma unroll
    for (int i = 0; i < 32; ++i) scr[(2 * i + (lane >> 5)) * 33 + (lane & 31)] = v[i];
    LDS_WAIT(); asm volatile("" ::: "memory");
    const int c = lane & 7;
#pragma unroll
    for (int j = 0; j < 4; ++j) { const int n = (lane >> 3) + 8 * j; const LAS float* s = scr + (8 * c) * 33 + n;
        u32x4 o; o.x = pk2(s[0 * 33], s[1 * 33]); o.y = pk2(s[2 * 33], s[3 * 33]); o.z = pk2(s[4 * 33], s[5 * 33]); o.w = pk2(s[6 * 33], s[7 * 33]);
        __builtin_nontemporal_store(o, (u32x4*)(it.dst + (unsigned)(n * it.kout + 8 * c))); }
    LDS_WAIT(); asm volatile("" ::: "memory");
}
template <class SeqFn> __device__ __forceinline__ void convert_items(const Frame& F0, int n, int rank, int nranks, SeqFn seqf) {
    Frame F = F0; F.wave = sopqi(F0.wave); F.lane = vopqi(lane_id());
    unsigned char* const ws = opq(F.ws);
    LAS float* scr = (LAS float*)(F.lds + F.wave * 8448);
    int i = rank * NWAVES + F.wave; const int step = nranks * NWAVES;
    if (i >= n) return;
    float cur[32], nxt[32]; CvItem ic = cv_decode(F, ws, seqf(i)), in_ = ic; cv_load(ic, F.lane, cur);
#pragma unroll 1
    for (; i < n; i += step) {
        const bool more = i + step < n;
        if (more) { in_ = cv_decode(F, ws, seqf(i + step)); cv_load(in_, F.lane, nxt); }
        cv_store(ic, F.lane, scr, cur);
        if (more) { ic = in_;
#pragma unroll
            for (int k = 0; k < 32; ++k) cur[k] = nxt[k]; }
    }
}
struct SeqRange { int lo; __device__ int operator()(int i) const { return lo + i; } };
struct SeqP0 { __device__ int operator()(int i) const { return i < CV_GA0 ? i : CV_P0B + (i - CV_GA0); } };
__device__ __forceinline__ void convert_range(const Frame& F, int lo, int hi, int rank, int nranks) { convert_items(F, hi - lo, rank, nranks, SeqRange{lo}); }
__device__ __forceinline__ void tail_convert(const Frame& F, int nunits, int lo, int hi) {
    const int rem = nunits % F.G;
    if (rem == 0) convert_range(F, lo, hi, F.bid, F.G);
    else if (F.bid >= rem) convert_range(F, lo, hi, F.bid - rem, F.G - rem);
}
__device__ __forceinline__ void p0_prologue(const Frame& F0) {
    Frame F = F0; F.wave = sopqi(F0.wave); F.lane = vopqi(lane_id()); F.tid = F.wave * 64 + F.lane; F.bid = sopqi(F0.bid);
    unsigned char* const ws = opq(F.ws);
    LAS float* cs = (LAS float*)F.lds;
    LAS float* red = (LAS float*)(F.lds + 65536);
    { const float* pc = inp(F, I_C); const float* pcc = inp(F, I_CCTX);
    for (int i = F.tid; i < 2048 * 8; i += 512) { const int k = i >> 3, j = i & 7; float v = 0.f;
        if (j < 4) v = siluf(pc[j * D + k]); else if (j == 4) v = siluf(pcc[k]); cs[i] = v; } }
    const float* adaw = inp(F, I_ADAW); const float* adab = inp(F, I_ADAB);
    __syncthreads();
    for (int u = F.bid; u < 256; u += F.G) {
        const int l = u >> 6, n0 = (u & 63) * 192;
        const float* W = adaw + (size_t)l * D * 12288 + n0 + 3 * F.lane;
        float acc[5][3];
#pragma unroll
        for (int j = 0; j < 5; ++j) { acc[j][0] = 0.f; acc[j][1] = 0.f; acc[j][2] = 0.f; }
        const int kb = F.wave * 256;
        for (int k0 = 0; k0 < 256; k0 += 8) {
            f32x3 w[8];
#pragma unroll
            for (int i = 0; i < 8; ++i) { const float* wp_ = W + (size_t)(kb + k0 + i) * 12288; w[i].x = __builtin_nontemporal_load(wp_); w[i].y = __builtin_nontemporal_load(wp_ + 1); w[i].z = __builtin_nontemporal_load(wp_ + 2); }
#pragma unroll
            for (int i = 0; i < 8; ++i) { const f32x4 c0 = *(const LAS f32x4*)(cs + (kb + k0 + i) * 8); const float c4 = cs[(kb + k0 + i) * 8 + 4];
                acc[0][0] += c0.x * w[i].x; acc[0][1] += c0.x * w[i].y; acc[0][2] += c0.x * w[i].z;
                acc[1][0] += c0.y * w[i].x; acc[1][1] += c0.y * w[i].y; acc[1][2] += c0.y * w[i].z;
                acc[2][0] += c0.z * w[i].x; acc[2][1] += c0.z * w[i].y; acc[2][2] += c0.z * w[i].z;
                acc[3][0] += c0.w * w[i].x; acc[3][1] += c0.w * w[i].y; acc[3][2] += c0.w * w[i].z;
                acc[4][0] += c4 * w[i].x;   acc[4][1] += c4 * w[i].y;   acc[4][2] += c4 * w[i].z; }
        }
#pragma unroll
        for (int j = 0; j < 5; ++j)
#pragma unroll
            for (int c = 0; c < 3; ++c) red[(F.wave * 64 + F.lane) * 15 + j * 3 + c] = acc[j][c];
        __syncthreads();
        for (int idx = F.tid; idx < 960; idx += 512) { const int ln = idx / 15, q = idx % 15, j = q / 3, cc = q % 3; float s = 0.f;
#pragma unroll
            for (int w = 0; w < 8; ++w) s += red[(w * 64 + ln) * 15 + q];
            const int n = n0 + 3 * ln + cc; ((float*)(ws + WS_MOD))[(size_t)(l * 5 + j) * 12288 + n] = s + adab[l * 12288 + n]; }
        __syncthreads();
    }
    __syncthreads();
    convert_items(F, CV_GA0 + (CV_END - CV_P0B), F.bid, F.G, SeqP0{});
    const float* p_mlwin = inp(F, I_MLWIN);
    for (int i = F.bid * 512 + F.tid; i < 2 * 256 * 2048; i += F.G * 512) { const int l = i >> 19, rr = (i >> 11) & 255, k = i & 2047;
        ((bf16*)(ws + WS_WMIN))[(size_t)(l * 6400 + 6144 + rr) * D + k] = (bf16)(rr < 16 ? f2bf(p_mlwin[(size_t)l * D * MLIN + (size_t)k * MLIN + 6144 + rr]) : 0u); }
    { const float* src = inp(F, I_GMWS); bf16* dst = (bf16*)(ws + WS_WSB);
      for (int i = F.bid * 512 + F.tid; i < 2 * 8 * 128 * 128 / 2; i += F.G * 512) ((unsigned*)dst)[i] = pk2(src[2 * i], src[2 * i + 1]); }
}

__device__ __forceinline__ const float* modp(unsigned char* ws, int l, int mi, int chunk) { return (const float*)(ws + WS_MOD) + ((size_t)(l * 5 + mi) * 6 + chunk) * D; }
__device__ __forceinline__ void load_row(const float* p, int lane, f32x4 (&v)[8]) {
    const f32x4* q = (const f32x4*)p + lane;
#pragma unroll
    for (int j = 0; j < 8; ++j) v[j] = q[64 * j];
}
__device__ __forceinline__ void load_row_bf16(const bf16* p, int lane, f32x4 (&v)[8]) {
    const u32x2* q = (const u32x2*)p + lane;
#pragma unroll
    for (int j = 0; j < 8; ++j) { const u32x2 w = q[64 * j]; v[j] = (f32x4){bflo(w.x), bfhi(w.x), bflo(w.y), bfhi(w.y)}; }
}
__device__ __forceinline__ void load_row_raw(const bf16* p, int lane, u32x2 (&r)[8]) {
    const u32x2* q = (const u32x2*)p + lane;
#pragma unroll
    for (int j = 0; j < 8; ++j) r[j] = q[64 * j];
}
__device__ __forceinline__ void cvt_row(const u32x2 (&r)[8], f32x4 (&v)[8]) {
#pragma unroll
    for (int j = 0; j < 8; ++j) v[j] = (f32x4){bflo(r[j].x), bfhi(r[j].x), bflo(r[j].y), bfhi(r[j].y)};
}
__device__ __forceinline__ void store_row(float* p, int lane, const f32x4 (&v)[8]) {
    f32x4* q = (f32x4*)p + lane;
#pragma unroll
    for (int j = 0; j < 8; ++j) q[64 * j] = v[j];
}
__device__ __forceinline__ void store_row_bf16(bf16* p, int lane, const f32x4 (&v)[8]) {
    u32x2* q = (u32x2*)p + lane;
#pragma unroll
    for (int j = 0; j < 8; ++j) { u32x2 o; o.x = pk2(v[j].x, v[j].y); o.y = pk2(v[j].z, v[j].w); q[64 * j] = o; }
}
__device__ __forceinline__ void layer_norm_row(f32x4 (&v)[8], const float* g, const float* b, int lane) {
    float s = 0.f;
#pragma unroll
    for (int j = 0; j < 8; ++j) s += (v[j].x + v[j].y) + (v[j].z + v[j].w);
    const float mean = wave_sum(s) * (1.f / D); float q = 0.f;
#pragma unroll
    for (int j = 0; j < 8; ++j) { v[j] = v[j] - mean; q += (v[j].x * v[j].x + v[j].y * v[j].y) + (v[j].z * v[j].z + v[j].w * v[j].w); }
    const float rstd = 1.f / sqrtf(wave_sum(q) * (1.f / D) + LN_EPS);
    const f32x4* gp = (const f32x4*)g + lane; const f32x4* bp = (const f32x4*)b + lane;
#pragma unroll
    for (int j = 0; j < 8; ++j) v[j] = v[j] * rstd * gp[64 * j] + bp[64 * j];
}
__device__ __forceinline__ void modulate_row(f32x4 (&v)[8], const float* sc, const float* sh, int lane) {
    const f32x4* cp = (const f32x4*)sc + lane; const f32x4* hp = (const f32x4*)sh + lane;
#pragma unroll
    for (int j = 0; j < 8; ++j) v[j] = v[j] * (cp[64 * j] + 1.0f) + hp[64 * j];
}
__device__ __forceinline__ int mod_index(int r) { return r < NLAT ? (r >> 11) : 4; }

__device__ __forceinline__ void p1_modulate0(const Frame& F0) {
    Frame F = F0; F.wave = sopqi(F0.wave); F.lane = vopqi(lane_id()); F.tid = F.wave * 64 + F.lane; F.bid = sopqi(F0.bid);
    unsigned char* const ws = opq(F.ws);
    const int gw = F.bid * NWAVES + F.wave, NGW = F.G * NWAVES;
    const float* xl = inp(F, I_X); const float* xc = inp(F, I_CTX);
#pragma unroll 1
    for (int sg = gw; sg < 2048 + 1024; sg += NGW) {
        const int row0 = sg < 2048 ? 4 * sg : NLAT + (sg - 2048), nrows = sg < 2048 ? 4 : 1;
        const int mi = mod_index(row0);
        f32x4 sc[8], sh[8], nx[8];
        { const f32x4* cp = (const f32x4*)modp(ws, 0, mi, 1) + F.lane; const f32x4* hp = (const f32x4*)modp(ws, 0, mi, 0) + F.lane;
#pragma unroll
          for (int j = 0; j < 8; ++j) { sc[j] = cp[64 * j] + 1.0f; sh[j] = hp[64 * j]; } }
        load_row(row0 < NLAT ? xl + (size_t)row0 * D : xc + (size_t)(row0 - NLAT) * D, F.lane, nx);
#pragma unroll 1
        for (int rr = 0; rr < nrows; ++rr) {
            const int r = row0 + rr;
            f32x4 v[8];
#pragma unroll
            for (int j = 0; j < 8; ++j) v[j] = nx[j];
            if (rr + 1 < nrows) load_row(xl + (size_t)(r + 1) * D, F.lane, nx);
            store_row_bf16((bf16*)(ws + WS_X) + (size_t)r * D, F.lane, v);
#pragma unroll
            for (int j = 0; j < 8; ++j) v[j] = v[j] * sc[j] + sh[j];
            store_row_bf16((bf16*)(ws + WS_HT) + (size_t)r * D, F.lane, v); }
    }
    { const float* rw = inp(F, I_RW); float* rc = (float*)(ws + WS_RC);
#pragma unroll 1
      for (int t = gw; t < DEPTH * 5 * 16 * 8; t += NGW) {
          const int j = t & 7, e = (t >> 3) & 15, lm = t >> 7, l = lm / 5;
          const int k = 256 * j + 4 * F.lane;
          const f32x4 gg = *(const f32x4*)(inp(F, I_LN1G) + l * D + k), bb = *(const f32x4*)(inp(F, I_LN1B) + l * D + k);
          const f32x4 s4 = *(const f32x4*)((const float*)(ws + WS_MOD) + ((size_t)lm * 6 + 4) * D + k) + 1.0f, h4 = *(const f32x4*)((const float*)(ws + WS_MOD) + ((size_t)lm * 6 + 3) * D + k);
          float r4[4];
#pragma unroll
          for (int i = 0; i < 4; ++i) r4[i] = rw[(k + i) * 16 + e];
          unsigned hi[4], lo[4]; float c1 = 0.f, c2 = 0.f;
#pragma unroll
          for (int i = 0; i < 4; ++i) { const float w = gg[i] * s4[i] * r4[i]; hi[i] = f2bf(w); lo[i] = f2bf(w - bf2f((unsigned short)hi[i]));
              c1 += bf2f((unsigned short)hi[i]) + bf2f((unsigned short)lo[i]); c2 += (bb[i] * s4[i] + h4[i]) * r4[i]; }
          bf16* whi = (bf16*)(ws + WS_WR) + (size_t)(lm * 32 + e) * D + k;
          *(u32x2*)whi = (u32x2){hi[0] | (hi[1] << 16), hi[2] | (hi[3] << 16)}; *(u32x2*)(whi + 16 * D) = (u32x2){lo[0] | (lo[1] << 16), lo[2] | (lo[3] << 16)};
          c1 = wave_sum(c1); c2 = wave_sum(c2);
          if (F.lane == 0) { rc[((lm * 2 + 0) * 8 + j) * 16 + e] = c1; rc[((lm * 2 + 1) * 8 + j) * 16 + e] = c2; } } }
}
__device__ __forceinline__ void ln1_phase(const Frame& F0, int layer, int Mrows) {
    Frame F = F0; F.wave = sopqi(F0.wave); F.lane = vopqi(lane_id()); F.tid = F.wave * 64 + F.lane; F.bid = sopqi(F0.bid);
    unsigned char* const ws = opq(F.ws);
    LAS float* lgl = (LAS float*)(F.lds + 131072); LAS float* lbl = (LAS float*)(F.lds + 139264);
    LAS unsigned* cntl = (LAS unsigned*)(F.lds + 147456 + 64); LAS unsigned* basel = cntl + 16;
    LAS int* rinfo = (LAS int*)(F.lds + 147456 + 256) + F.wave * 64;
    { const f32x4 a = ((const f32x4*)(inp(F, I_LN1G) + layer * D))[F.tid], b = ((const f32x4*)(inp(F, I_LN1B) + layer * D))[F.tid]; ((LAS f32x4*)lgl)[F.tid] = a; ((LAS f32x4*)lbl)[F.tid] = b; }
    if (F.tid < 16) cntl[F.tid] = 0u;
    LAS float* rcl = (LAS float*)(F.lds + 150016);
    if (F.tid < 160) { const int mi = F.tid >> 5, which = (F.tid >> 4) & 1, e = F.tid & 15; const float* p = (const float*)(ws + WS_RC) + ((layer * 5 + mi) * 2 + which) * 128 + e;
        float a = which ? inp(F, I_RB)[e] : 0.f; float pv[8];
#pragma unroll
        for (int j = 0; j < 8; ++j) pv[j] = p[j * 16];
        asm volatile("" : "+v"(pv[0]), "+v"(pv[1]), "+v"(pv[2]), "+v"(pv[3]), "+v"(pv[4]), "+v"(pv[5]), "+v"(pv[6]), "+v"(pv[7]));
#pragma unroll
        for (int j = 0; j < 8; ++j) a += pv[j];
        rcl[F.tid] = a; }
    __syncthreads();
    const int gw = F.bid * NWAVES + F.wave, NGW = F.G * NWAVES;
    bf16* X = (bf16*)(ws + WS_X); bf16* T = (bf16*)(ws + WS_HT);
    const float* RP = (const float*)(ws + WS_RP) + (F.lane & 31) * 16 + (F.lane >> 5) * 8;
    int nr = 0; const int perm = (layer & 1) ? ((layer >> 1) & 1) : 0;
#pragma unroll 1
    for (int sg = gw; sg < 2048 + 1024; sg += NGW) {
        const int row0 = sg < 2048 ? 4 * sg : NLAT + (sg - 2048), nrows = sg < 2048 ? 4 : 1;
        if (row0 >= Mrows) break;
        const int mi = mod_index(row0);
        f32x4 sc[8], sh[8];
        { const f32x4* cp = (const f32x4*)modp(ws, layer, mi, 4) + F.lane; const f32x4* hp = (const f32x4*)modp(ws, layer, mi, 3) + F.lane;
#pragma unroll
          for (int j = 0; j < 8; ++j) { sc[j] = cp[64 * j] + 1.0f; sh[j] = hp[64 * j]; } }
        const LAS float* rcp = rcl + mi * 32;
        u32x2 nx[8]; load_row_raw(X + (size_t)row0 * D, F.lane, nx);
        f32x4 pa = *(const f32x4*)(RP + (size_t)(perm ? permrow(row0) : row0) * 512), pb = *(const f32x4*)(RP + (size_t)(perm ? permrow(row0) : row0) * 512 + 4);
#pragma unroll 1
        for (int rr = 0; rr < nrows; ++rr) {
            const int r = row0 + rr;
            f32x4 v[8]; cvt_row(nx, v);
            float sp[8] = {pa.x, pa.y, pa.z, pa.w, pb.x, pb.y, pb.z, pb.w};
            if (rr + 1 < nrows) { load_row_raw(X + (size_t)(r + 1) * D, F.lane, nx); const int pr = perm ? permrow(r + 1) : r + 1; pa = *(const f32x4*)(RP + (size_t)pr * 512); pb = *(const f32x4*)(RP + (size_t)pr * 512 + 4); }
            float s = 0.f;
#pragma unroll
            for (int j = 0; j < 8; ++j) s += (v[j].x + v[j].y) + (v[j].z + v[j].w);
            const float mean = wave_sum(s) * (1.f / D); float q = 0.f;
#pragma unroll
            for (int j = 0; j < 8; ++j) { v[j] = v[j] - mean; q += (v[j].x * v[j].x + v[j].y * v[j].y) + (v[j].z * v[j].z + v[j].w * v[j].w); }
            const float rstd = 1.f / sqrtf(wave_sum(q) * (1.f / D) + LN_EPS);
            u32x2* xo = (u32x2*)(X + (size_t)r * D) + F.lane; u32x2* to = (u32x2*)(T + (size_t)r * D) + F.lane;
#pragma unroll
            for (int j = 0; j < 8; ++j) { const f32x4 g = *(const LAS f32x4*)(lgl + 256 * j + 4 * F.lane), b = *(const LAS f32x4*)(lbl + 256 * j + 4 * F.lane);
                const f32x4 xn = v[j] * rstd * g + b; { u32x2 ox; ox.x = pk2(xn.x, xn.y); ox.y = pk2(xn.z, xn.w); xo[64 * j] = ox; } v[j] = xn * sc[j] + sh[j];
                u32x2 o; o.x = pk2(v[j].x, v[j].y); o.y = pk2(v[j].z, v[j].w); to[64 * j] = o; }
            { const int zr = vopqi(0);
#pragma unroll
              for (int e = 0; e < 8; ++e) sp[e] += dppz<0x111, 0xf>(sp[e], zr);
#pragma unroll
              for (int e = 0; e < 8; ++e) sp[e] += dppz<0x112, 0xf>(sp[e], zr);
#pragma unroll
              for (int e = 0; e < 8; ++e) sp[e] += dppz<0x114, 0xf>(sp[e], zr);
#pragma unroll
              for (int e = 0; e < 8; ++e) sp[e] += dppz<0x118, 0xf>(sp[e], zr);
#pragma unroll
              for (int e = 0; e < 8; ++e) sp[e] += dppz<0x142, 0xa>(sp[e], zr); }
            float lg[16];
#pragma unroll
            for (int e = 0; e < 8; ++e) { lg[e] = __builtin_bit_cast(float, __builtin_amdgcn_readlane(__builtin_bit_cast(int, sp[e]), 31)); lg[e + 8] = __builtin_bit_cast(float, __builtin_amdgcn_readlane(__builtin_bit_cast(int, sp[e]), 63)); }
            float mx = -3.0e38f;
#pragma unroll
            for (int e = 0; e < 16; ++e) { lg[e] = rstd * (lg[e] - mean * rcp[e]) + rcp[16 + e]; mx = fmaxf(mx, lg[e]); }
#pragma unroll
            for (int e = 0; e < 16; ++e) lg[e] = __expf(lg[e] - mx);
            float best = -1.f; int gs = 0;
#pragma unroll
            for (int g = 0; g < 4; ++g) { const float a = lg[4 * g], b = lg[4 * g + 1], c = lg[4 * g + 2], d = lg[4 * g + 3];
                const float h1 = fmaxf(a, b), l1 = fminf(a, b), h2 = fmaxf(c, d), l2 = fminf(c, d);
                const float scr = fmaxf(h1, h2) + fmaxf(fminf(h1, h2), fmaxf(l1, l2)); if (scr > best) { best = scr; gs = g; } }
            float q0 = 0.f, q1 = 0.f, q2 = 0.f, q3 = 0.f;
#pragma unroll
            for (int g = 0; g < 4; ++g) if (g == gs) { q0 = lg[4 * g]; q1 = lg[4 * g + 1]; q2 = lg[4 * g + 2]; q3 = lg[4 * g + 3]; }
            int i1 = 0; float p1 = q0; if (q1 > p1) { p1 = q1; i1 = 1; } if (q2 > p1) { p1 = q2; i1 = 2; } if (q3 > p1) { p1 = q3; i1 = 3; }
            int i2 = 0; float p2 = -1.f;
            if (i1 != 0 && q0 > p2) { p2 = q0; i2 = 0; } if (i1 != 1 && q1 > p2) { p2 = q1; i2 = 1; } if (i1 != 2 && q2 > p2) { p2 = q2; i2 = 2; } if (i1 != 3 && q3 > p2) { p2 = q3; i2 = 3; }
            const float inv = 1.f / (p1 + p2);
            if (F.lane == 0 && nr < 10) { const int e0 = 4 * gs + i1, e1 = 4 * gs + i2;
                rinfo[nr * 6 + 0] = e0; rinfo[nr * 6 + 1] = e1;
                rinfo[nr * 6 + 2] = (int)atomicAdd((unsigned*)&cntl[e0], 1u); rinfo[nr * 6 + 3] = (int)atomicAdd((unsigned*)&cntl[e1], 1u);
                rinfo[nr * 6 + 4] = __builtin_bit_cast(int, p1 * inv); rinfo[nr * 6 + 5] = __builtin_bit_cast(int, p2 * inv); }
            ++nr;
        }
    }
    __syncthreads();
    unsigned* gcnt = (unsigned*)(ws + WS_CTL) + CW_CNT + layer * 1024;
    if (F.tid < 16) { const unsigned c = cntl[F.tid]; basel[F.tid] = c ? __hip_atomic_fetch_add(gcnt + 64 * F.tid, c, __ATOMIC_RELAXED, __HIP_MEMORY_SCOPE_AGENT) : 0u; }
    __syncthreads();
    int* tokl = (int*)(ws + WS_TOKL); float* wl = (float*)(ws + WS_WL);
    if (F.lane == 0) {
        int k = 0;
        for (int sg = gw; sg < 2048 + 1024; sg += NGW) {
            const int row0 = sg < 2048 ? 4 * sg : NLAT + (sg - 2048), nrows = sg < 2048 ? 4 : 1;
            if (row0 >= Mrows) break;
            for (int rr = 0; rr < nrows; ++rr, ++k) { if (k >= 10) break;
                const int r = row0 + rr, e0 = rinfo[k * 6 + 0], e1 = rinfo[k * 6 + 1];
                const int p0 = (int)basel[e0] + rinfo[k * 6 + 2], p1 = (int)basel[e1] + rinfo[k * 6 + 3];
                tokl[e0 * LCAP + p0] = r * 2; wl[e0 * LCAP + p0] = __builtin_bit_cast(float, rinfo[k * 6 + 4]);
                tokl[e1 * LCAP + p1] = r * 2 + 1; wl[e1 * LCAP + p1] = __builtin_bit_cast(float, rinfo[k * 6 + 5]); }
        }
    }
}
__device__ __forceinline__ void ln2_phase(const Frame& F0, int layer, int Mrows) {
    Frame F = F0; F.wave = sopqi(F0.wave); F.lane = vopqi(lane_id()); F.tid = F.wave * 64 + F.lane; F.bid = sopqi(F0.bid);
    unsigned char* const ws = opq(F.ws);
    const bool last = layer == DEPTH - 1; const int nl = last ? layer : layer + 1;
    LAS float* lgl = (LAS float*)F.lds; LAS float* lbl = lgl + 2048; LAS float* vec = lgl + 4096;
    bf16* X = (bf16*)(ws + WS_X); const bf16* YM = (const bf16*)(ws + WS_YM); bf16* H = (bf16*)(ws + WS_HT); float* const outp = F.out;
    const float* lng = inp(F, I_LN2G) + layer * D; const float* lnb = inp(F, I_LN2B) + layer * D;
#pragma unroll 1
    for (int vb = F.bid; vb < 256; vb += F.G) {
        __syncthreads();
        { const int mil = vb >> 6;
          f32x4 tv[8]; tv[0] = ((const f32x4*)lng)[F.tid]; tv[1] = ((const f32x4*)lnb)[F.tid];
#pragma unroll
          for (int kind = 0; kind < 2; ++kind) { const int mi = kind ? 4 : mil;
              tv[2 + 3 * kind] = ((const f32x4*)modp(ws, layer, mi, 5))[F.tid]; tv[3 + 3 * kind] = ((const f32x4*)modp(ws, nl, mi, 1))[F.tid]; tv[4 + 3 * kind] = ((const f32x4*)modp(ws, nl, mi, 0))[F.tid]; }
          asm volatile("" : "+v"(tv[0]), "+v"(tv[1]), "+v"(tv[2]), "+v"(tv[3]), "+v"(tv[4]), "+v"(tv[5]), "+v"(tv[6]), "+v"(tv[7]));
          ((LAS f32x4*)lgl)[F.tid] = tv[0]; ((LAS f32x4*)lbl)[F.tid] = tv[1];
#pragma unroll
          for (int kind = 0; kind < 2; ++kind) { LAS f32x4* d = (LAS f32x4*)(vec + kind * 6144);
              d[F.tid] = tv[2 + 3 * kind]; d[512 + F.tid] = tv[3 + 3 * kind] + 1.0f; d[1024 + F.tid] = tv[4 + 3 * kind]; } }
        __syncthreads();
        const int gwv = vb * NWAVES + F.wave;
#pragma unroll 1
        for (int kind = 0; kind < 2; ++kind) {
            const int row0 = kind ? NLAT + gwv : 4 * gwv, nrows = kind ? 1 : 4;
            if (kind && (gwv >= 1024 || row0 >= Mrows)) break;
            const LAS float* vg = vec + kind * 6144;
            u32x2 nx[8], na[8], nb[8];
            { load_row_raw(X + (size_t)row0 * D, F.lane, nx);
              const u32x2* y0 = (const u32x2*)(YM + (size_t)(2 * row0) * D) + F.lane; const u32x2* y1 = (const u32x2*)(YM + (size_t)(2 * row0 + 1) * D) + F.lane;
#pragma unroll
              for (int j = 0; j < 8; ++j) { na[j] = y0[64 * j]; nb[j] = y1[64 * j]; } }
#pragma unroll 1
            for (int rr = 0; rr < nrows; ++rr) {
                const int r = row0 + rr;
                f32x4 v[8];
#pragma unroll
                for (int j = 0; j < 8; ++j) { const u32x2 a = na[j], b = nb[j]; const f32x4 g2 = *(const LAS f32x4*)(vg + 256 * j + 4 * F.lane);
                    const f32x4 y = (f32x4){bflo(a.x) + bflo(b.x), bfhi(a.x) + bfhi(b.x), bflo(a.y) + bflo(b.y), bfhi(a.y) + bfhi(b.y)};
                    v[j] = (f32x4){bflo(nx[j].x), bfhi(nx[j].x), bflo(nx[j].y), bfhi(nx[j].y)} * ALPHA + g2 * y; }
                if (rr + 1 < nrows) { const int rn = r + 1; load_row_raw(X + (size_t)rn * D, F.lane, nx);
                    const u32x2* y0 = (const u32x2*)(YM + (size_t)(2 * rn) * D) + F.lane; const u32x2* y1 = (const u32x2*)(YM + (size_t)(2 * rn + 1) * D) + F.lane;
#pragma unroll
                    for (int j = 0; j < 8; ++j) { na[j] = y0[64 * j]; nb[j] = y1[64 * j]; } }
                float s = 0.f;
#pragma unroll
                for (int j = 0; j < 8; ++j) s += (v[j].x + v[j].y) + (v[j].z + v[j].w);
                const float mean = wave_sum(s) * (1.f / D); float q = 0.f;
#pragma unroll
                for (int j = 0; j < 8; ++j) { v[j] = v[j] - mean; q += (v[j].x * v[j].x + v[j].y * v[j].y) + (v[j].z * v[j].z + v[j].w * v[j].w); }
                const float rstd = 1.f / sqrtf(wave_sum(q) * (1.f / D) + LN_EPS);
                if (last) { f32x4* oo = (f32x4*)(outp + (size_t)r * D) + F.lane;
#pragma unroll
                    for (int j = 0; j < 8; ++j) { const f32x4 g = *(const LAS f32x4*)(lgl + 256 * j + 4 * F.lane), b = *(const LAS f32x4*)(lbl + 256 * j + 4 * F.lane); oo[64 * j] = v[j] * rstd * g + b; }
                } else { u32x2* xo = (u32x2*)(X + (size_t)r * D) + F.lane; u32x2* ho = (u32x2*)(H + (size_t)r * D) + F.lane;
#pragma unroll
                    for (int j = 0; j < 8; ++j) { const f32x4 g = *(const LAS f32x4*)(lgl + 256 * j + 4 * F.lane), b = *(const LAS f32x4*)(lbl + 256 * j + 4 * F.lane);
                        const f32x4 xn = v[j] * rstd * g + b; { u32x2 ox; ox.x = pk2(xn.x, xn.y); ox.y = pk2(xn.z, xn.w); xo[64 * j] = ox; }
                        const f32x4 hh = xn * *(const LAS f32x4*)(vg + 2048 + 256 * j + 4 * F.lane) + *(const LAS f32x4*)(vg + 4096 + 256 * j + 4 * F.lane);
                        u32x2 o; o.x = pk2(hh.x, hh.y); o.y = pk2(hh.z, hh.w); ho[64 * j] = o; } }
            }
        }
    }
}
__device__ __forceinline__ float wave_incl_sum(float v, int lane) {
#pragma unroll
    for (int o = 1; o < 64; o <<= 1) { const float t = shfl_lane(v, lane >= o ? lane - o : lane); if (lane >= o) v += t; }
    return v;
}
__device__ __forceinline__ float wave_incl_max(float v, int lane) {
#pragma unroll
    for (int o = 1; o < 64; o <<= 1) { const float t = shfl_lane(v, lane >= o ? lane - o : lane); if (lane >= o) v = fmaxf(v, t); }
    return v;
}
__device__ __forceinline__ float log_sigmoid(float x) { return fminf(x, 0.f) - log1pf(__expf(-fabsf(x))); }
__device__ __forceinline__ void conv_phase(const Frame& F0, int idx) {
    Frame F = F0; F.wave = sopqi(F0.wave); F.lane = vopqi(lane_id()); F.tid = F.wave * 64 + F.lane; F.bid = sopqi(F0.bid);
    unsigned char* const ws = opq(F.ws);
    const bf16* P = (const bf16*)(ws + WS_A1); bf16* Q = (bf16*)(ws + WS_A2); const float* cw = inp(F, I_MLCONV) + (size_t)idx * 3 * D;
    const int NIT = (NTOK / 8) * 256, cg = F.tid & 255, c0 = cg * 8;
    float w0[8], w1[8], w2[8];
    { const f32x4 a0 = *(const f32x4*)(cw + c0), a1 = *(const f32x4*)(cw + c0 + 4), b0 = *(const f32x4*)(cw + D + c0), b1 = *(const f32x4*)(cw + D + c0 + 4), d0 = *(const f32x4*)(cw + 2 * D + c0), d1 = *(const f32x4*)(cw + 2 * D + c0 + 4);
#pragma unroll
      for (int j = 0; j < 4; ++j) { w0[j] = a0[j]; w0[4 + j] = a1[j]; w1[j] = b0[j]; w1[4 + j] = b1[j]; w2[j] = d0[j]; w2[4 + j] = d1[j]; } }
    const float ksc = c0 >= 1024 ? 0.0625f : 1.0f;
    u32x4 nrow[10];
#define LB_LOAD(itx) do { const int r0_ = ((itx) >> 8) * 8; const int seqlen_ = r0_ < NLAT ? 2048 : 256, p0_ = r0_ < NLAT ? (r0_ & 2047) : ((r0_ - NLAT) & 255); \
        const bf16* pp_ = P + (unsigned)(r0_ * D + c0); \
        nrow[0] = *(const u32x4*)(pp_ - (p0_ > 0 ? D : 0)); nrow[9] = *(const u32x4*)(pp_ + (p0_ + 8 < seqlen_ ? 8 * D : 0)); \
        _Pragma("unroll") for (int i = 0; i < 8; ++i) nrow[i + 1] = *(const u32x4*)(pp_ + i * D); \
        if (!(p0_ > 0)) nrow[0] = (u32x4){0u, 0u, 0u, 0u}; if (!(p0_ + 8 < seqlen_)) nrow[9] = (u32x4){0u, 0u, 0u, 0u}; } while (0)
    int it = F.bid * 512 + F.tid;
    if (it < NIT) LB_LOAD(it);
#pragma unroll 1
    for (; it < NIT; it += F.G * 512) {
        const int r0 = (it >> 8) * 8;
        u32x4 rows[10];
#pragma unroll
        for (int i = 0; i < 10; ++i) rows[i] = nrow[i];
        if (it + F.G * 512 < NIT) LB_LOAD(it + F.G * 512);
#pragma unroll
        for (int i = 0; i < 8; ++i) {
            const u32x4 prev = rows[i], curv = rows[i + 1], nxtv = rows[i + 2];
            float o[8];
#pragma unroll
            for (int j = 0; j < 4; ++j) {
                const float a0 = bflo(prev[j]), a1 = bfhi(prev[j]), b0 = bflo(curv[j]), b1 = bfhi(curv[j]), d0 = bflo(nxtv[j]), d1 = bfhi(nxtv[j]);
                o[2 * j] = siluf(w0[2 * j] * a0 + w1[2 * j] * b0 + w2[2 * j] * d0) * ksc;
                o[2 * j + 1] = siluf(w0[2 * j + 1] * a1 + w1[2 * j + 1] * b1 + w2[2 * j + 1] * d1) * ksc; }
            u32x4 ov; ov.x = pk2(o[0], o[1]); ov.y = pk2(o[2], o[3]); ov.z = pk2(o[4], o[5]); ov.w = pk2(o[6], o[7]);
            *(u32x4*)(Q + (unsigned)((r0 + i) * D + c0)) = ov;
        }
    }
#undef LB_LOAD
    { const float* G = (const float*)(ws + WS_G); float* GS = (float*)(ws + WS_GS);
      for (int task = F.bid * NWAVES + F.wave; task < 72 * 8; task += F.G * NWAVES) {
        const int dir = task & 1, h = (task >> 1) & 3, base = (task >> 3) * 128, j0 = 2 * F.lane;
        const int ra = base + (dir ? 127 - j0 : j0), rb = base + (dir ? 126 - j0 : j0 + 1);
        const float i0 = G[ra * 16 + dir * 8 + h], f0 = log_sigmoid(G[ra * 16 + dir * 8 + 4 + h]), i1 = G[rb * 16 + dir * 8 + h], f1 = log_sigmoid(G[rb * 16 + dir * 8 + 4 + h]);
        const float incl = wave_incl_sum(f0 + f1, F.lane), b1 = incl, b0 = incl - f1;
        const float u0 = i0 - b0, u1 = i1 - b1;
        const float pin = wave_incl_max(fmaxf(u0, u1), F.lane); float pex = shfl_lane(pin, F.lane > 0 ? F.lane - 1 : 0); if (F.lane == 0) pex = -3.0e38f;
        float* o = GS + (size_t)task * 384 + j0;
        *(f32x2*)o = (f32x2){u0, u1}; *(f32x2*)(o + 128) = (f32x2){fmaxf(pex, u0), pin}; *(f32x2*)(o + 256) = (f32x2){b0, b1};
      } }
}
__device__ __forceinline__ void comb_phase(const Frame& F0, int idx, int Mrows) {
    Frame F = F0; F.wave = sopqi(F0.wave); F.lane = vopqi(lane_id()); F.tid = F.wave * 64 + F.lane; F.bid = sopqi(F0.bid);
    unsigned char* const ws = opq(F.ws);
    const bf16* HF = (const bf16*)(ws + WS_HSF); const bf16* HB = (const bf16*)(ws + WS_HSB); const bf16* PO = (const bf16*)(ws + WS_A4); bf16* ZL = (bf16*)(ws + WS_ZL);
    f32x4 ngv[8];
    { const f32x4* ng = (const f32x4*)(inp(F, I_MLNG) + (size_t)idx * D) + F.lane;
#pragma unroll
      for (int j = 0; j < 8; ++j) ngv[j] = ng[64 * j]; }
    const int gw = F.bid * NWAVES + F.wave, NGW = F.G * NWAVES;
    u32x2 pa[8], pb[8], pc[8];
    if (gw < Mrows) { const u32x2* hf = (const u32x2*)(HF + (size_t)gw * D) + F.lane; const u32x2* hb = (const u32x2*)(HB + (size_t)gw * D) + F.lane; const u32x2* po = (const u32x2*)(PO + (size_t)gw * D) + F.lane;
#pragma unroll
        for (int j = 0; j < 8; ++j) { pa[j] = hf[64 * j]; pb[j] = hb[64 * j]; pc[j] = po[64 * j]; } }
#pragma unroll 1
    for (int r = gw; r < Mrows; r += NGW) {
        f32x4 v[8]; u32x2 po[8];
#pragma unroll
        for (int j = 0; j < 8; ++j) { const u32x2 a = pa[j], b = pb[j]; po[j] = pc[j]; v[j] = (f32x4){bflo(a.x) + bflo(b.x), bfhi(a.x) + bfhi(b.x), bflo(a.y) + bflo(b.y), bfhi(a.y) + bfhi(b.y)}; }
        const int rn = r + NGW;
        if (rn < Mrows) { const u32x2* hf = (const u32x2*)(HF + (size_t)rn * D) + F.lane; const u32x2* hb = (const u32x2*)(HB + (size_t)rn * D) + F.lane; const u32x2* pq = (const u32x2*)(PO + (size_t)rn * D) + F.lane;
#pragma unroll
            for (int j = 0; j < 8; ++j) { pa[j] = hf[64 * j]; pb[j] = hb[64 * j]; pc[j] = pq[64 * j]; } }
#pragma unroll
        for (int h = 0; h < 4; ++h) { float q = 0.f;
#pragma unroll
            for (int jj = 0; jj < 2; ++jj) { const f32x4 x = v[2 * h + jj]; q += (x.x * x.x + x.y * x.y) + (x.z * x.z + x.w * x.w); }
            const float rs = 1.f / sqrtf(wave_sum(q) * (1.f / 512.f) + RMS_EPS);
#pragma unroll
            for (int jj = 0; jj < 2; ++jj) { const int j = 2 * h + jj; const u32x2 o = po[j]; const f32x4 sg = (f32x4){bflo(o.x), bfhi(o.x), bflo(o.y), bfhi(o.y)}; v[j] = v[j] * rs * ngv[j] * sg; } }
        store_row_bf16(ZL + (size_t)r * D, F.lane, v);
    }
}
__device__ __forceinline__ void gate_phase(const Frame& F0, int idx) {
    Frame F = F0; F.wave = sopqi(F0.wave); F.lane = vopqi(lane_id()); F.tid = F.wave * 64 + F.lane; F.bid = sopqi(F0.bid);
    unsigned char* const ws = opq(F.ws);
    constexpr int VT_STRIDE = 272, SS_STRIDE = 132, VT_OFF = 0, SS_OFF = 34816;
    const bf16* U = (const bf16*)(ws + WS_A1); const bf16* V = (const bf16*)(ws + WS_A2); bf16* Z = (bf16*)(ws + WS_A3);
    const float* vst = (const float*)(ws + WS_VST); const bf16* Wsb = (const bf16*)(ws + WS_WSB) + (size_t)idx * 8 * 128 * 128;
    const float* lg = inp(F, I_GMLNG) + (size_t)idx * D; const float* lb = inp(F, I_GMLNB) + (size_t)idx * D; const float* bs = inp(F, I_GMBS) + (size_t)idx * 8 * 128;
    const int fr = F.lane & 15, fq = F.lane >> 4, w = F.wave;
    LAS float* lgl = (LAS float*)(F.lds + 106496); LAS float* lbl = lgl + 2048;
    { const f32x4 ga_ = ((const f32x4*)lg)[F.tid], gb_ = ((const f32x4*)lb)[F.tid]; ((LAS f32x4*)lgl)[F.tid] = ga_; ((LAS f32x4*)lbl)[F.tid] = gb_; }
    u32x4 xvn[4], uvn[4]; f32x4 stn[4];
#define GB_PREFETCH(unx) do { const int n_ = (unx) >> 4, jb_ = (unx) & 15, R0_ = n_ * 128, C0_ = jb_ * 128, q_ = F.tid >> 2, seg_ = F.tid & 3; \
        const float* sp_ = vst + (unsigned)((R0_ + q_) * 64 + seg_ * 16); const bf16* vp_ = V + (unsigned)((R0_ + q_) * D + C0_ + seg_ * 32); \
        const bf16* up_ = U + (unsigned)((R0_ + 16 * w + (F.lane >> 2)) * D + C0_ + (F.lane & 3) * 32); \
        _Pragma("unroll") for (int i = 0; i < 4; ++i) { stn[i] = *(const f32x4*)(sp_ + 4 * i); xvn[i] = *(const u32x4*)(vp_ + 8 * i); uvn[i] = *(const u32x4*)(up_ + 8 * i); } } while (0)
    if (F.bid < 72 * 16) GB_PREFETCH(F.bid);
    bf16x8 af[4] = {}; float bsv[4] = {0.f, 0.f, 0.f, 0.f}; int gcur = -1;
    for (int un = F.bid; un < 72 * 16; un += F.G) {
        const int n = un >> 4, jb = un & 15, g = jb >> 1, R0 = n * 128, C0 = jb * 128;
        __syncthreads();
        u32x4 uv[4];
        {
            const int q = F.tid >> 2, seg = F.tid & 3;
            float s = 0.f, ss = 0.f;
#pragma unroll
            for (int i = 0; i < 4; ++i) { s += stn[i].x + stn[i].z; ss += stn[i].y + stn[i].w; uv[i] = uvn[i]; }
            s += dpp0<0xB1, 0xf>(s); ss += dpp0<0xB1, 0xf>(ss); s += dpp0<0x4E, 0xf>(s); ss += dpp0<0x4E, 0xf>(ss);
            const float mean = s * (1.f / D), rstd = 1.f / sqrtf(ss * (1.f / D) - mean * mean + LN_EPS);
#pragma unroll
            for (int i = 0; i < 4; ++i) { const u32x4 x = xvn[i]; const int c = seg * 32 + 8 * i;
                const f32x4 ga = *(const LAS f32x4*)(lgl + C0 + c), gb = *(const LAS f32x4*)(lgl + C0 + c + 4), ba = *(const LAS f32x4*)(lbl + C0 + c), bb_ = *(const LAS f32x4*)(lbl + C0 + c + 4);
#pragma unroll
                for (int j = 0; j < 4; ++j) { const f32x4 gg = (j >> 1) ? gb : ga, bb = (j >> 1) ? bb_ : ba;
                    const float a = (bflo(x[j]) - mean) * rstd * gg[2 * (j & 1)] + bb[2 * (j & 1)], b = (bfhi(x[j]) - mean) * rstd * gg[2 * (j & 1) + 1] + bb[2 * (j & 1) + 1];
                    *(LAS bf16*)(F.lds + VT_OFF + (c + 2 * j) * VT_STRIDE + q * 2) = (bf16)f2bf(a); *(LAS bf16*)(F.lds + VT_OFF + (c + 2 * j + 1) * VT_STRIDE + q * 2) = (bf16)f2bf(b); } }
        }
        if (un + F.G < 72 * 16) GB_PREFETCH(un + F.G);
        if (g != gcur) { gcur = g;
#pragma unroll
            for (int ks = 0; ks < 4; ++ks) af[ks] = *(const bf16x8*)(Wsb + ((size_t)g * 128 + 16 * w + fr) * 128 + 32 * ks + 8 * fq);
#pragma unroll
            for (int reg = 0; reg < 4; ++reg) bsv[reg] = bs[g * 128 + 16 * w + 4 * fq + reg]; }
        __syncthreads();
        f32x4 acc[8];
#pragma unroll
        for (int np = 0; np < 8; np += 2) {
            bf16x8 bfr[2][4];
#pragma unroll
            for (int q = 0; q < 2; ++q)
#pragma unroll
                for (int ks = 0; ks < 4; ++ks) bfr[q][ks] = *(const LAS bf16x8*)(F.lds + VT_OFF + (16 * (np + q) + fr) * VT_STRIDE + (32 * ks + 8 * fq) * 2);
            asm volatile("" : "+v"(bfr[0][0]), "+v"(bfr[0][1]), "+v"(bfr[0][2]), "+v"(bfr[0][3]), "+v"(bfr[1][0]), "+v"(bfr[1][1]), "+v"(bfr[1][2]), "+v"(bfr[1][3]));
#pragma unroll
            for (int q = 0; q < 2; ++q) { acc[np + q] = (f32x4){0.f, 0.f, 0.f, 0.f};
#pragma unroll
                for (int ks = 0; ks < 4; ++ks) acc[np + q] = __builtin_amdgcn_mfma_f32_16x16x32_bf16(af[ks], bfr[q][ks], acc[np + q], 0, 0, 0); } }
        LAS float* SS = (LAS float*)(F.lds + SS_OFF);
#pragma unroll
        for (int reg = 0; reg < 4; ++reg) { const int p = 16 * w + 4 * fq + reg; const float b = bsv[reg];
#pragma unroll
            for (int nt = 0; nt < 8; ++nt) SS[p * SS_STRIDE + 16 * nt + fr] = acc[nt][reg] + b; }
        LDS_WAIT(); asm volatile("" ::: "memory");
        {
            const int p = 16 * w + (F.lane >> 2), seg = F.lane & 3; bf16* zp = Z + (size_t)(R0 + p) * D + C0 + seg * 32;
#pragma unroll
            for (int i = 0; i < 4; ++i) { const u32x4 x = uv[i]; const LAS float* sp = SS + p * SS_STRIDE + seg * 32 + 8 * i;
                const f32x4 s0 = *(const LAS f32x4*)sp, s1 = *(const LAS f32x4*)(sp + 4);
                u32x4 o; o.x = pk2(bflo(x.x) * s0.x, bfhi(x.x) * s0.y); o.y = pk2(bflo(x.y) * s0.z, bfhi(x.y) * s0.w); o.z = pk2(bflo(x.z) * s1.x, bfhi(x.z) * s1.y); o.w = pk2(bflo(x.w) * s1.z, bfhi(x.w) * s1.w);
                *(u32x4*)(zp + 8 * i) = o; }
        }
    }
}
__device__ __forceinline__ void scan_phase(const Frame& F0, int write_ctx, unsigned long long& pacc) {
    unsigned long long spt = 0ull; (void)spt;
#define SPB() do { if (PROBE_MASK >> 16) spt = __builtin_amdgcn_s_memrealtime(); } while (0)
#define SPE(k) do { if ((PROBE_MASK >> (16 + (k))) & 1) pacc += __builtin_amdgcn_s_memrealtime() - spt; } while (0)
    Frame F = F0; F.wave = sopqi(F0.wave); F.lane = vopqi(lane_id()); F.tid = F.wave * 64 + F.lane; F.bid = sopqi(F0.bid);
    unsigned char* const ws = opq(F.ws);
    constexpr int KS_OFF = 0, KS_STRIDE = 528, VT_OFF = 67584, VT_STRIDE = 272, R1_OFF = 89344, CT_STRIDE = 528, SP_STRIDE = 272, GU_OFF = 131584, HST_OFF = 135680;
    static_assert(HST_OFF + 8 * 16 * 144 <= MISC_OFF, "scan LDS map");
    const bf16* QK = (const bf16*)(ws + WS_A2); const bf16* PV = (const bf16*)(ws + WS_A3); const float* GS = (const float*)(ws + WS_GS);
    const int w = F.wave, tid0 = F.tid;
#define IDS const int tid = vopqi(tid0), lane = tid & 63, fr = lane & 15, fq = lane >> 4; (void)tid; (void)lane; (void)fr; (void)fq
    const int tau = w < 4 ? w : 11 - w;
    for (int uid = F.bid; uid < 256; uid += F.G) {
        const int sl = uid & 7, dir = (uid >> 3) & 1, h = (uid >> 4) & 3, b = uid >> 6;
        bf16* HS = (bf16*)(ws + (dir ? WS_HSB : WS_HSF));
        __syncthreads();
        { IDS;
        for (int i = tid; i < 16 * 128; i += 512) { const int e = 64 + (i >> 7), s = i & 127; *(LAS bf16*)(F.lds + VT_OFF + e * VT_STRIDE + s * 2) = (bf16)(e == 64 ? 0x3f80u : 0u); }
        for (int i = tid; i < 80 * 128; i += 512) { const int e = i >> 7, d4 = i & 127; *(LAS unsigned*)(F.lds + R1_OFF + e * CT_STRIDE + d4 * 4) = 0u; } }
        f32x4 Cst[2][5];
#pragma unroll
        for (int mt = 0; mt < 2; ++mt)
#pragma unroll
            for (int nt = 0; nt < 5; ++nt) Cst[mt][nt] = (f32x4){0.f, 0.f, 0.f, 0.f};
        float m_prev = 0.f;
#define CHUNK_BASE(ci) ((ci) < 2 ? (NLAT + b * 256 + (dir ? 1 - (ci) : (ci)) * 128) : (b * 2048 + (dir ? 17 - (ci) : (ci) - 2) * 128))
#define ROW_OF(base, j) ((base) + (dir ? 127 - (j) : (j)))
        u32x4 kpre[8], vpre[2]; float gi = 0.f, gf = 0.f, gb_ = 0.f; bf16x8 Qf[8];
        {   IDS; const int base = CHUNK_BASE(0);
#pragma unroll
            for (int i = 0; i < 8; ++i) { const int p = tid + 512 * i, j = p >> 5, c16 = p & 31; kpre[i] = *(const u32x4*)(QK + (unsigned)(ROW_OF(base, j) * D + 1024 + h * 256 + c16 * 8)); }
#pragma unroll
            for (int i = 0; i < 2; ++i) { const int p = tid + 512 * i, j = p >> 3, e8 = p & 7; vpre[i] = *(const u32x4*)(PV + (unsigned)(ROW_OF(base, j) * D + h * 512 + sl * 64 + e8 * 8)); }
            if (tid < 128) { const float* gp = GS + (unsigned)((((base >> 7) * 4 + h) * 2 + dir) * 384 + tid); gi = gp[0]; gf = gp[128]; gb_ = gp[256]; }
#pragma unroll
            for (int ks = 0; ks < 8; ++ks) Qf[ks] = *(const bf16x8*)(QK + (unsigned)(ROW_OF(base, 16 * tau + fr) * D + h * 256 + 32 * ks + 8 * fq));
        }
        for (int ci = 0; ci < 18; ++ci) {
            const int base = CHUNK_BASE(ci);
            SPB();
            { IDS; LAS unsigned char* const L = vopq(F.lds);
#pragma unroll
            for (int i = 0; i < 8; ++i) { const int p = tid + 512 * i, j = p >> 5, c16 = p & 31; *(LAS u32x4*)(L + KS_OFF + j * KS_STRIDE + c16 * 16) = kpre[i]; }
#pragma unroll
            for (int i = 0; i < 2; ++i) { const int p = tid + 512 * i, j = p >> 3, e8 = p & 7;
#pragma unroll
                for (int q = 0; q < 4; ++q) { *(LAS bf16*)(L + VT_OFF + (e8 * 8 + 2 * q) * VT_STRIDE + j * 2) = (bf16)(vpre[i][q] & 0xffffu); *(LAS bf16*)(L + VT_OFF + (e8 * 8 + 2 * q + 1) * VT_STRIDE + j * 2) = (bf16)(vpre[i][q] >> 16); } }
            if (tid < 128) { LAS float* tt = (LAS float*)(L + GU_OFF); tt[tid] = gi; tt[512 + tid] = gf; tt[640 + tid] = gb_; } }
            __syncthreads();
            SPE(0); SPB();
            if (ci + 1 < 18) {
                IDS; const int nb = CHUNK_BASE(ci + 1);
#pragma unroll
                for (int i = 0; i < 8; ++i) { const int p = tid + 512 * i, j = p >> 5, c16 = p & 31; kpre[i] = *(const u32x4*)(QK + (unsigned)(ROW_OF(nb, j) * D + 1024 + h * 256 + c16 * 8)); }
#pragma unroll
                for (int i = 0; i < 2; ++i) { const int p = tid + 512 * i, j = p >> 3, e8 = p & 7; vpre[i] = *(const u32x4*)(PV + (unsigned)(ROW_OF(nb, j) * D + h * 512 + sl * 64 + e8 * 8)); }
                if (tid < 128) { const float* gp = GS + (unsigned)((((nb >> 7) * 4 + h) * 2 + dir) * 384 + tid); gi = gp[0]; gf = gp[128]; gb_ = gp[256]; }
            }
            if (tid0 < 128) { IDS; LAS float* const gu = (LAS float*)(vopq(F.lds) + GU_OFF);
                const float pm127 = gu[512 + 127], bL = gu[640 + 127], M127 = fmaxf(m_prev, pm127), u = gu[tid], pm = gu[512 + tid], bb = gu[640 + tid];
                gu[128 + tid] = fmaxf(m_prev, pm); gu[256 + tid] = bb; gu[384 + tid] = __expf(u - M127);
                if (tid == 0) { gu[768] = bL + M127; gu[769] = __expf(m_prev - M127); } }
            f32x4 acc3[5];
#pragma unroll
            for (int nt = 0; nt < 5; ++nt) acc3[nt] = (f32x4){0.f, 0.f, 0.f, 0.f};
            { IDS; LAS unsigned char* L = vopq(F.lds) + R1_OFF + fr * CT_STRIDE + fq * 16;
#pragma unroll
            for (int ks = 0; ks < 8; ++ks)
            {
#pragma unroll
                for (int nt = 0; nt < 5; ++nt) { const bf16x8 bfr = *(const LAS bf16x8*)(L + 16 * nt * CT_STRIDE + 64 * ks);
                    acc3[nt] = __builtin_amdgcn_mfma_f32_16x16x32_bf16(Qf[ks], bfr, acc3[nt], 0, 0, 0);
                    if (nt == 0) asm volatile("" : "+v"(L) : "v"(acc3[0])); }
            } }
            __syncthreads();
            SPE(1); SPB();
            float m_new, a_dec, Mt[4], bt[4];
            { IDS; LAS float* const gu = (LAS float*)(vopq(F.lds) + GU_OFF); m_new = gu[768]; a_dec = gu[769];
#pragma unroll
            for (int reg = 0; reg < 4; ++reg) { Mt[reg] = gu[128 + 16 * tau + 4 * fq + reg]; bt[reg] = gu[256 + 16 * tau + 4 * fq + reg]; } }
#pragma unroll 1
            for (int nt = 0; nt < 8; ++nt) {
                IDS; const int s = 16 * nt + fr; LAS unsigned char* const L = vopq(F.lds);
                if (nt <= tau) {
                    f32x4 a = (f32x4){0.f, 0.f, 0.f, 0.f};
#pragma unroll
                    for (int ks = 0; ks < 8; ++ks) { const bf16x8 kf = *(const LAS bf16x8*)(L + KS_OFF + s * KS_STRIDE + (32 * ks + 8 * fq) * 2);
                        a = __builtin_amdgcn_mfma_f32_16x16x32_bf16(Qf[ks], kf, a, 0, 0, 0); }
                    const float us = ((const LAS float*)(L + GU_OFF))[s];
#pragma unroll
                    for (int reg = 0; reg < 4; ++reg) { const int t = 16 * tau + 4 * fq + reg; const float val = (s <= t) ? a[reg] * __expf(us - Mt[reg]) : 0.f;
                        *(LAS bf16*)(L + R1_OFF + t * SP_STRIDE + s * 2) = (bf16)f2bf(val); }
                } else {
#pragma unroll
                    for (int reg = 0; reg < 4; ++reg) { const int t = 16 * tau + 4 * fq + reg; *(LAS bf16*)(L + R1_OFF + t * SP_STRIDE + s * 2) = (bf16)0u; }
                }
            }
            if (ci + 1 < 18) { IDS; const int nb = CHUNK_BASE(ci + 1);
#pragma unroll
                for (int ks = 0; ks < 8; ++ks) Qf[ks] = *(const bf16x8*)(QK + (unsigned)(ROW_OF(nb, 16 * tau + fr) * D + h * 256 + 32 * ks + 8 * fq)); }
            LDS_WAIT(); asm volatile("" ::: "memory");
            __syncthreads();
            SPE(2); SPB();
            f32x4 acc2[5];
#pragma unroll
            for (int nt = 0; nt < 5; ++nt) acc2[nt] = (f32x4){0.f, 0.f, 0.f, 0.f};
#pragma unroll 1
            for (int ks = 0; ks < 4; ++ks) if (2 * ks <= tau) {
                IDS; LAS unsigned char* const L = vopq(F.lds);
                const bf16x8 af = *(const LAS bf16x8*)(L + R1_OFF + (16 * tau + fr) * SP_STRIDE + (32 * ks + 8 * fq) * 2);
#pragma unroll
                for (int nt = 0; nt < 5; ++nt) { const bf16x8 bfr = *(const LAS bf16x8*)(L + VT_OFF + (16 * nt + fr) * VT_STRIDE + (32 * ks + 8 * fq) * 2);
                    acc2[nt] = __builtin_amdgcn_mfma_f32_16x16x32_bf16(af, bfr, acc2[nt], 0, 0, 0); } }
            __syncthreads();
            SPE(3); SPB();
            {
                IDS; const bool wr_out = (ci >= 2) || write_ctx;
                LAS unsigned char* const hst = vopq(F.lds) + HST_OFF + w * (16 * 144);
#pragma unroll
                for (int reg = 0; reg < 4; ++reg) {
                    const float dec = __expf(m_prev - Mt[reg]);
                    float den = dec * acc3[4][reg] + acc2[4][reg]; den = __shfl(den, lane & 48);
                    const float dn = fmaxf(fabsf(den), __expf(-(bt[reg] + Mt[reg]))), inv = 1.f / dn;
#pragma unroll
                    for (int nt = 0; nt < 4; ++nt) *(LAS bf16*)(hst + (4 * fq + reg) * 144 + (16 * nt + fr) * 2) = (bf16)f2bf((dec * acc3[nt][reg] + acc2[nt][reg]) * inv);
                }
                LDS_WAIT(); asm volatile("" ::: "memory");
                if (wr_out) { const int tl = lane >> 2, c = lane & 3, t = 16 * tau + tl;
                    const u32x4 v0 = *(const LAS u32x4*)(hst + tl * 144 + c * 32), v1 = *(const LAS u32x4*)(hst + tl * 144 + c * 32 + 16);
                    bf16* hp = HS + (unsigned)(ROW_OF(base, t) * D + h * 512 + sl * 64 + c * 16);
                    *(u32x4*)hp = v0; *(u32x4*)(hp + 8) = v1; }
            }
            SPE(4); SPB();
#pragma unroll
            for (int mt = 0; mt < 2; ++mt)
#pragma unroll
                for (int nt = 0; nt < 5; ++nt) Cst[mt][nt] = Cst[mt][nt] * a_dec;
#pragma unroll 1
            for (int ks = 0; ks < 4; ++ks) {
                IDS; LAS unsigned char* const L = vopq(F.lds);
                float wv8[8];
#pragma unroll
                for (int j = 0; j < 8; ++j) wv8[j] = ((const LAS float*)(L + GU_OFF))[384 + 32 * ks + 8 * fq + j];
                bf16x8 afr[2];
#pragma unroll
                for (int mt = 0; mt < 2; ++mt) { const int d = 32 * w + 16 * mt + fr; unsigned pk[4];
#pragma unroll
                    for (int j = 0; j < 4; ++j) { const float k0 = bf2f(*(const LAS bf16*)(L + KS_OFF + (32 * ks + 8 * fq + 2 * j) * KS_STRIDE + d * 2)) * wv8[2 * j];
                        const float k1 = bf2f(*(const LAS bf16*)(L + KS_OFF + (32 * ks + 8 * fq + 2 * j + 1) * KS_STRIDE + d * 2)) * wv8[2 * j + 1]; pk[j] = pk2(k0, k1); }
                    afr[mt] = __builtin_bit_cast(bf16x8, (u32x4){pk[0], pk[1], pk[2], pk[3]}); }
#pragma unroll
                for (int nt = 0; nt < 5; ++nt) { const bf16x8 bfr = *(const LAS bf16x8*)(L + VT_OFF + (16 * nt + fr) * VT_STRIDE + (32 * ks + 8 * fq) * 2);
#pragma unroll
                    for (int mt = 0; mt < 2; ++mt) Cst[mt][nt] = __builtin_amdgcn_mfma_f32_16x16x32_bf16(afr[mt], bfr, Cst[mt][nt], 0, 0, 0); }
                __builtin_amdgcn_sched_barrier(0);
            }
            __syncthreads();
            SPE(5); SPB();
            { IDS; LAS unsigned char* const L = vopq(F.lds);
#pragma unroll
            for (int mt = 0; mt < 2; ++mt)
#pragma unroll
                for (int nt = 0; nt < 5; ++nt) { const int e = 16 * nt + fr, d0 = 32 * w + 16 * mt + 4 * fq; u32x2 o; o.x = pk2(Cst[mt][nt][0], Cst[mt][nt][1]); o.y = pk2(Cst[mt][nt][2], Cst[mt][nt][3]);
                    *(LAS u32x2*)(L + R1_OFF + e * CT_STRIDE + d0 * 2) = o; } }
            m_prev = m_new;
            SPE(6);
        }
#undef CHUNK_BASE
#undef ROW_OF
#undef IDS
#undef SPB
#undef SPE
    }
}

constexpr int NSLOT = 10, NPH = 2 + NSLOT * DEPTH;
constexpr int PL_TILE = 0, PL_READY = 128, PL_LATE = 256, PL_T = 384, PL_NREADY = 385, PL_NLATE = 386, PL_WCNT = 400;
constexpr int CW_DONE = 24576;
__device__ __forceinline__ void moe_plan(const LAS int* cl, LAS int* plan, int NX, int slots, int lane) {
    int n[16], t0[16], T = 0;
#pragma unroll
    for (int e = 0; e < 16; ++e) { n[e] = __builtin_amdgcn_readfirstlane(cl[e]); t0[e] = T; T += (n[e] + 255) >> 8; }
    int cpx1 = (4 * T + NX - 1) / NX; cpx1 = cpx1 < 1 ? 1 : cpx1;
    int nready = 0, nlate = 0;
#pragma unroll
    for (int pass = 0; pass < 2; ++pass) {
        const int tau = lane + 64 * pass; const bool valid = tau < T;
        int e = 0, base = 0, ne = n[0];
#pragma unroll
        for (int k = 1; k < 16; ++k) if (tau >= t0[k]) { e = k; base = t0[k]; ne = n[k]; }
        const int rt = tau - base; int nv = ne - 256 * rt; nv = nv > 256 ? 256 : (nv < 0 ? 0 : nv);
        const unsigned L0 = 4u * (unsigned)tau, q = L0 / (unsigned)cpx1; const int r = (int)(L0 - q * (unsigned)cpx1); bool late = false;
#pragma unroll
        for (int j = 0; j < 4; ++j) { int rj = r + j; if (rj >= cpx1) rj -= cpx1; late = late || (rj >= slots); }
        const int info = e | (rt << 4) | (nv << 11) | (tau << 20);
        if (valid) plan[PL_TILE + tau] = info;
        const unsigned long long mr = __ballot(valid && !late), ml = __ballot(valid && late), below = (1ull << lane) - 1ull;
        if (valid && !late) plan[PL_READY + nready + __popcll(mr & below)] = info;
        if (valid && late) plan[PL_LATE + nlate + __popcll(ml & below)] = info;
        nready += __popcll(mr); nlate += __popcll(ml);
    }
    if (lane == 0) { plan[PL_T] = T; plan[PL_NREADY] = nready; plan[PL_NLATE] = nlate; plan[PL_WCNT] = 0; }
}
__host__ __device__ inline bool phase_exists(int id) { if (id < 2) return true; const int L = (id - 2) / NSLOT, s = (id - 2) % NSLOT; return !(((L & 1) == 0 && (s == 3 || s == 4)) || s == 7 || s == 8); }

__global__ void __launch_bounds__(NWAVES * 64, 2) fwd(Args args) {
    extern __shared__ __attribute__((aligned(16))) unsigned char lds_raw[];
    Frame F;
    F.lds = (LAS unsigned char*)lds_raw; F.tid = threadIdx.x; F.lane = F.tid & 63; F.wave = __builtin_amdgcn_readfirstlane(F.tid >> 6); F.G = gridDim.x; F.bid = blockIdx.x;
    F.ws = args.ws; F.out = args.out;
    if (F.tid < 26) { const unsigned long long pv = (unsigned long long)args.in[F.tid]; LAS unsigned* t = (LAS unsigned*)(F.lds + PTAB_OFF) + 2 * F.tid; t[0] = (unsigned)pv; t[1] = (unsigned)(pv >> 32); }
    volatile LAS unsigned* MISC = (volatile LAS unsigned*)(F.lds + MISC_OFF);
    if (F.tid < 64) MISC[F.tid] = 0u;
    __syncthreads();
    unsigned* ctl = (unsigned*)(F.ws + WS_CTL);
    XcdBarrier bar; bar.bar = ctl + CW_BAR; bar.x = 0; bar.st = nullptr;
    const int lo = args.ph_lo, hi = args.ph_hi;
    const bool multi = (hi - lo) > 1;
    if (multi) bar = xcd_barrier_post(ctl + CW_BAR, MISC + 8, F.tid == 0);
#define IN(k) (lo <= (k) && (k) < hi)
#define RT() __builtin_amdgcn_s_memrealtime()
    unsigned long long pacc = 0ull, pt0 = 0ull; (void)pacc; (void)pt0;
#define PB() do { if (PROBE_MASK) pt0 = RT(); } while (0)
#define PE(ty) do { if ((PROBE_MASK >> (ty)) & 1) pacc += RT() - pt0; } while (0)
#define SEAM(k) do { if ((k) + 1 < hi) { if ((PROBE_MASK >> 14) & 3) pt0 = RT(); { XcdBarrier bq = bar; bq.bar = (unsigned*)opq((unsigned char*)bar.bar); xcd_barrier(bq, F.wave == 0 && lane_id() == 0); } if (((PROBE_MASK >> 14) & 1) && ((PROBE_SEAMSEL >> ((k) < 2 ? 10 + (k) : ((k) - 2) % NSLOT)) & 1)) pacc += RT() - pt0; \
    if ((PROBE_MASK >> 15) & 1) { if (F.wave == 0 && lane_id() == 0) atomicMax((unsigned*)(opq(F.ws) + WS_CTL) + 2048 + (k), (1u << 20) - (unsigned)(RT() - pt0)); } } } while (0)

    if (PHON(0) && IN(0)) { PB(); p0_prologue(F); PE(0); SEAM(0); }
    if (PHON(1) && IN(1)) { PB(); p1_modulate0(F); PE(1); SEAM(1); }
    for (int layer = 0; layer < DEPTH; ++layer) {
        const int pb = 2 + NSLOT * layer, idx = layer >> 1; const bool last = layer == DEPTH - 1;
        const int Mpost = last ? NLAT : NTOK;
        if ((layer & 1) == 0) {
            if (PHON(2) && IN(pb + 0)) {
                unsigned char* const ws = opq(F.ws);
                pg8::Gemm g{(const bf16*)(ws + WS_HT), (const bf16*)(ws + WS_WGIN) + (size_t)idx * 4096 * D, D, 0, nullptr};
                pg8::StaticOrder S; S.init(Mpost, 4096, F.G, sopqi(F.bid));
                EpiGA E{(bf16*)(ws + WS_A1), (bf16*)(ws + WS_A2), (float*)(ws + WS_VST)};
                PB(); pg8::gemm_phase<EpiGA, pg8::StaticOrder, 0>(F.lds, g, S, E, F.wave); tail_convert(F, (Mpost / 256) * 16, layer == 0 ? CV_GA0 : CV_GA2, layer == 0 ? CV_GC0 : CV_GC2); PE(2); SEAM(pb + 0); }
            if (PHON(3) && IN(pb + 1)) { PB(); gate_phase(F, idx); PE(3); SEAM(pb + 1); }
            if (PHON(4) && IN(pb + 2)) {
                unsigned char* const ws = opq(F.ws);
                const float* g1base = (const float*)(ws + WS_MOD) + (size_t)layer * 5 * 12288 + 2 * D;
                pg8::Gemm g{(const bf16*)(ws + WS_A3), (const bf16*)(ws + WS_WGOUT) + (size_t)idx * D * D, D, 0, nullptr};
                pg8::StaticOrder S; S.init(Mpost, D, F.G, sopqi(F.bid));
                EpiRes E{(bf16*)(ws + WS_X), g1base, 0, (const bf16*)(ws + WS_WR) + (size_t)layer * 5 * 32 * D, (float*)(ws + WS_RP)};
                PB(); pg8::gemm_phase<EpiRes, pg8::StaticOrder, 0>(F.lds, g, S, E, F.wave); tail_convert(F, (Mpost / 256) * 8, layer == 0 ? CV_GC0 : CV_GC2, layer == 0 ? CV_M0 : CV_M2); PE(4); SEAM(pb + 2); }
        } else {
            const int perm = (idx & 1);
            if (PHON(5) && IN(pb + 0)) {
                unsigned char* const ws = opq(F.ws);
                pg8::Gemm g{(const bf16*)(ws + WS_HT), (const bf16*)(ws + WS_WMIN) + (size_t)idx * 6400 * D, D, 0, nullptr};
                pg8::StaticOrder S; S.init(NTOK, 6400, F.G, sopqi(F.bid));
                EpiLA E{ws, inp(F, I_MLGB) + idx * 16, perm};
                PB(); pg8::gemm_phase<EpiLA, pg8::StaticOrder, 0>(F.lds, g, S, E, F.wave); tail_convert(F, (NTOK / 256) * 25, layer == 1 ? CV_LA1 : CV_LA3, layer == 1 ? CV_LC1 : CV_P0B); PE(5); SEAM(pb + 0); }
            if (PHON(6) && IN(pb + 1)) { PB(); conv_phase(F, idx); PE(6); SEAM(pb + 1); }
            if (PHON(7) && IN(pb + 2)) { PB(); scan_phase(F, last ? 0 : 1, pacc); PE(7); SEAM(pb + 2); }
            if (PHON(8) && IN(pb + 3)) { PB(); comb_phase(F, idx, Mpost); PE(8); SEAM(pb + 3); }
            if (PHON(9) && IN(pb + 4)) {
                unsigned char* const ws = opq(F.ws);
                const float* g1base = (const float*)(ws + WS_MOD) + (size_t)layer * 5 * 12288 + 2 * D;
                pg8::Gemm g{(const bf16*)(ws + WS_ZL), (const bf16*)(ws + WS_WMOUT) + (size_t)idx * D * D, D, 0, nullptr};
                pg8::StaticOrder S; S.init(Mpost, D, F.G, sopqi(F.bid));
                EpiRes E{(bf16*)(ws + WS_X), g1base, perm, (const bf16*)(ws + WS_WR) + (size_t)layer * 5 * 32 * D, (float*)(ws + WS_RP)};
                PB(); pg8::gemm_phase<EpiRes, pg8::StaticOrder, 0>(F.lds, g, S, E, F.wave); if (layer == 1) tail_convert(F, (Mpost / 256) * 8, CV_LC1, CV_M1); PE(9); SEAM(pb + 4); }
        }
        if (PHON(10) && IN(pb + 5)) { PB(); ln1_phase(F, layer, Mpost); PE(10); SEAM(pb + 5); }
        if (IN(pb + 6)) {
            unsigned char* const ws = opq(F.ws);
            LAS int* const cl = (LAS int*)(F.lds + pg8::STAGE_BYTES + 1024); LAS int* const plan = (LAS int*)(F.lds + pg8::STAGE_BYTES + 2048);
            unsigned* const done = (unsigned*)(ws + WS_CTL) + CW_DONE + layer * 2048;
            const int bidq = sopqi(F.bid), NX = (F.G & 7) == 0 ? 8 : 1, slots = F.G / NX, xg = bidq % NX, slot = bidq / NX;
            if (F.wave == 0) { const int l_ = lane_id();
                if (l_ < 16) cl[l_] = (int)__hip_atomic_load((unsigned*)(ws + WS_CTL) + CW_CNT + layer * 1024 + 64 * l_, __ATOMIC_RELAXED, __HIP_MEMORY_SCOPE_AGENT);
                LDS_WAIT(); moe_plan(cl, plan, NX, slots, l_); }
            __syncthreads();
            const int T = __builtin_amdgcn_readfirstlane(plan[PL_T]), nready = __builtin_amdgcn_readfirstlane(plan[PL_NREADY]), nlate = __builtin_amdgcn_readfirstlane(plan[PL_NLATE]);
            int cpx1 = (4 * T + NX - 1) / NX; cpx1 = cpx1 < 1 ? 1 : cpx1;
            int s2 = cpx1 - slots; s2 = s2 < 0 ? 0 : s2; if (s2 >= slots) s2 = 0;
            if (PHON(11)) {
                pg8::Gemm g{(const bf16*)(ws + WS_HT), (const bf16*)(ws + WS_WEGU) + (size_t)layer * 16 * 1024 * D, D, (size_t)1024 * D * 2, (const int*)(ws + WS_TOKL)};
                pg8::PlanOrderSig S{plan + PL_TILE, 4 * T, 2, slots, slot, xg, cpx1, done, (LAS unsigned*)(plan + PL_WCNT)};
                EpiMoE1 E{(bf16*)(ws + WS_HM), (const float*)(ws + WS_WL)};
                PB(); pg8::gemm_phase<EpiMoE1, pg8::PlanOrderSig, 1>(F.lds, g, S, E, F.wave); PE(11); }
            if (PHON(12)) {
#pragma unroll 1
                for (int call = 0; call < 2; ++call) {
                    const int N = 8 * (call ? nlate : nready), W = call ? slots : slots - s2, sl = call ? slot : slot - s2;
                    pg8::PlanOrder S{plan + (call ? PL_LATE : PL_READY), N, 3, W, sl, xg, (N + NX - 1) / NX, nullptr, nullptr};
                    PB();
                    if (F.wave == 0) { unsigned* const bw = (unsigned*)opq((unsigned char*)bar.bar);
                        for (int i = lane_id(); ; i += 64) { const int pm = S.tile_at(i); if (pm < 0) break; XB_SPIN(xb_ld(done + 16 * pm) < 4u, bw); }
                        __builtin_amdgcn_fence(__ATOMIC_ACQUIRE, "agent"); asm volatile("s_waitcnt vmcnt(0)" ::: "memory"); }
                    __syncthreads();
                    pg8::Gemm g{(const bf16*)(ws + WS_HM), (const bf16*)(ws + WS_WED) + (size_t)layer * 16 * D * 512, 512, (size_t)D * 512 * 2, nullptr};
                    EpiMoE2 E{(bf16*)(ws + WS_YM), (const int*)(ws + WS_TOKL)};
                    pg8::gemm_phase<EpiMoE2, pg8::PlanOrder, 0>(F.lds, g, S, E, F.wave); PE(12); }
            }
            if (layer < 3) {
                const int cpxL = (8 * nlate + NX - 1) / NX;
                const bool all = cpxL >= slots;
                if (all || slot >= cpxL) convert_range(F, layer == 0 ? CV_M0 : (layer == 1 ? CV_M1 : CV_M2), layer == 0 ? CV_LA1 : (layer == 1 ? CV_GA2 : CV_LA3), all ? bidq : (slot - cpxL) * NX + xg, all ? F.G : (slots - cpxL) * NX); }
            SEAM(pb + 6);
        }
        if (PHON(13) && IN(pb + 9)) { PB(); ln2_phase(F, layer, Mpost); PE(13); SEAM(pb + 9); }
    }
    if ((PROBE_MASK >> 15) & 1) { XcdBarrier bq = bar; bq.bar = (unsigned*)opq((unsigned char*)bar.bar); xcd_barrier(bq, F.wave == 0 && lane_id() == 0);
        if (F.bid == PROBE_BID) { unsigned* pm_ = (unsigned*)(opq(F.ws) + WS_CTL) + 2048; for (int k = 0; k < NPH; ++k) { const unsigned v = __hip_atomic_load(pm_ + k, __ATOMIC_RELAXED, __HIP_MEMORY_SCOPE_AGENT); if (v) pacc += (1u << 20) - v; } } }
    if (PROBE_MASK && F.bid == PROBE_BID) { const unsigned long long tgt = RT() + (unsigned long long)PROBE_AMP * pacc; while (RT() < tgt) __builtin_amdgcn_s_sleep(16); }
#undef IN
#undef SEAM
}

extern "C" void kernel_launch(void* const* d_in, const int* in_sizes, int n_in, void* d_out, int out_size, void* d_ws, size_t ws_size, hipStream_t stream) {
    static int grid = 0;
    if (grid == 0) {
        if (n_in != 26 || out_size != NLAT * D || ws_size < WS_END) { fprintf(stderr, "kernel_launch: unexpected problem: n_in %d out %d ws %zu (need %zu)\n", n_in, out_size, ws_size, (size_t)WS_END); grid = -1; return; }
        int dev = 0, cus = 0, per_cu = 0;
        if (hipGetDevice(&dev) != hipSuccess || hipDeviceGetAttribute(&cus, hipDeviceAttributeMultiprocessorCount, dev) != hipSuccess) { grid = -1; return; }
        if (hipFuncSetAttribute((const void*)fwd, hipFuncAttributeMaxDynamicSharedMemorySize, LDS_BYTES) != hipSuccess) { fprintf(stderr, "kernel_launch: hipFuncSetAttribute failed\n"); grid = -1; return; }
        if (hipOccupancyMaxActiveBlocksPerMultiprocessor(&per_cu, (const void*)fwd, NWAVES * 64, LDS_BYTES) != hipSuccess || per_cu < 1) fprintf(stderr, "kernel_launch: occupancy query says %d\n", per_cu);
        (void)hipGetLastError();
        grid = cus;
    }
    if (grid < 0) return;
    if (hipMemsetAsync((char*)d_ws + WS_CTL, 0, CTL_ZERO_BYTES, stream) != hipSuccess) return;
    Args a{};
    for (int i = 0; i < 26; ++i) a.in[i] = (const float*)d_in[i];
    a.out = (float*)d_out; a.ws = (unsigned char*)d_ws;
#if MK_ONE_LAUNCH
    a.ph_lo = 0; a.ph_hi = NPH;
    hipLaunchKernelGGL(fwd, dim3(grid), dim3(NWAVES * 64), LDS_BYTES, stream, a);
#else
    for (int p = 0; p < NPH; ++p) { if (!phase_exists(p)) continue; a.ph_lo = p; a.ph_hi = p + 1; hipLaunchKernelGGL(fwd, dim3(grid), dim3(NWAVES * 64), LDS_BYTES, stream, a); }
#endif
}
```
